# Optimizing an MI355X kernel written in HIP

```python
import math
import jax, jax.numpy as jnp
from jax import lax
import numpy as np

D_MODEL = 2048
BATCH = 8
SEQ = 2048
DEPTH = 1
DEC_BATCH = 4
DEC_SEQ = 2048
PAST_LEN = 128

HEAD_DIM = 128
N_HEADS = 8
N_KV_HEADS = 2
ATTN_WIDTH = N_HEADS * HEAD_DIM
KV_WIDTH = N_KV_HEADS * HEAD_DIM
N_SGU_GROUPS = 8
SGU_GROUP_DIM = 128
SGU_WIDTH = N_SGU_GROUPS * SGU_GROUP_DIM
MIX_WIDTH = ATTN_WIDTH + SGU_WIDTH
IN_WIDTH = ATTN_WIDTH + 2 * KV_WIDTH + 2 * SGU_WIDTH
BLOCK = 128
WINDOW = 128
D_FF = int(math.ceil(8 * D_MODEL / 3 / 256) * 256)
LN_EPS = 1e-5
NEG_INF = -1e30
DEEPNORM_ALPHA = (2.0 * DEPTH) ** 0.25
DEEPNORM_BETA = (8.0 * DEPTH) ** -0.25

kernel_name = "hybrid_sgu_window_gqa_deepnorm_encoder"


def _layer_norm(x, g, b):
    xf = x.astype(jnp.float32)
    mu = jnp.mean(xf, axis=-1, keepdims=True)
    xc = xf - mu
    var = jnp.mean(xc * xc, axis=-1, keepdims=True)
    y = xc * lax.rsqrt(var + LN_EPS) * g.astype(jnp.float32) + b.astype(jnp.float32)
    return y.astype(x.dtype)


def _alibi_slopes():
    h = np.arange(1, N_HEADS + 1, dtype=np.float32)
    return jnp.asarray(2.0 ** (-8.0 * h / N_HEADS), dtype=jnp.float32)


def _window_attention(q, k, v, sink):
    B, S, H, D = q.shape
    Hkv = k.shape[2]
    G = H // Hkv
    NC = S // BLOCK
    qb = q.reshape(B, NC, BLOCK, Hkv, G, D)
    pad = ((0, 0), (BLOCK, BLOCK), (0, 0), (0, 0))
    kp = jnp.pad(k, pad).reshape(B, NC + 2, BLOCK, Hkv, D)
    vp = jnp.pad(v, pad).reshape(B, NC + 2, BLOCK, Hkv, D)
    kb = jnp.concatenate([kp[:, :-2], kp[:, 1:-1], kp[:, 2:]], axis=2)
    vb = jnp.concatenate([vp[:, :-2], vp[:, 1:-1], vp[:, 2:]], axis=2)
    scale = 1.0 / math.sqrt(D)
    s = jnp.einsum('bcqhgd,bckhd->bchgqk', qb, kb,
                   preferred_element_type=jnp.float32) * scale
    rel = jnp.arange(3 * BLOCK)[None, :] - BLOCK - jnp.arange(BLOCK)[:, None]
    dist = jnp.abs(rel)
    kpos = jnp.arange(NC)[:, None] * BLOCK - BLOCK + jnp.arange(3 * BLOCK)[None, :]
    valid = (dist <= WINDOW)[None] & ((kpos >= 0) & (kpos < S))[:, None, :]
    slopes = _alibi_slopes().reshape(Hkv, G)
    s = s - slopes[:, :, None, None] * dist.astype(jnp.float32)
    s = jnp.where(valid[None, :, None, None], s, NEG_INF)
    sk = sink.astype(jnp.float32).reshape(Hkv, G)[None, None, :, :, None]
    m = jnp.maximum(jnp.max(s, axis=-1), sk)
    p = jnp.exp(s - m[..., None])
    den = jnp.sum(p, axis=-1) + jnp.exp(sk - m)
    w = (p / den[..., None]).astype(v.dtype)
    o = jnp.einsum('bchgqk,bckhd->bcqhgd', w, vb)
    return o.reshape(B, S, H * D)


def _chunk_sgu(z, ln_g, ln_b, w_s, b_s):
    B, S, _ = z.shape
    NC = S // BLOCK
    u, gv = z[..., :SGU_WIDTH], z[..., SGU_WIDTH:]
    gv = _layer_norm(gv, ln_g, ln_b)
    gv = gv.reshape(B, NC, BLOCK, N_SGU_GROUPS, SGU_GROUP_DIM)
    mixed = jnp.einsum('gts,bcsgd->bctgd', w_s.astype(gv.dtype), gv) + b_s.T[:, :, None].astype(gv.dtype)
    return u * mixed.reshape(B, S, SGU_WIDTH)


def _layer(x, w_in, ln_sgu_g, ln_sgu_b, w_s, b_s, attn_sink, w_o,
           ln1_g, ln1_b, w_gate, w_up, w_down, ln2_g, ln2_b):
    B, S, _ = x.shape
    h = x @ w_in
    o0 = ATTN_WIDTH
    o1 = o0 + KV_WIDTH
    o2 = o1 + KV_WIDTH
    q = h[..., :o0].reshape(B, S, N_HEADS, HEAD_DIM)
    k = h[..., o0:o1].reshape(B, S, N_KV_HEADS, HEAD_DIM)
    v = h[..., o1:o2].reshape(B, S, N_KV_HEADS, HEAD_DIM)
    attn = _window_attention(q, k, v, attn_sink)
    sgu = _chunk_sgu(jax.nn.gelu(h[..., o2:]), ln_sgu_g, ln_sgu_b, w_s, b_s)
    mix = jnp.concatenate([attn, sgu], axis=-1) @ w_o
    x = _layer_norm(DEEPNORM_ALPHA * x + mix, ln1_g, ln1_b)
    ff = (jax.nn.silu(x @ w_gate) * (x @ w_up)) @ w_down
    x = _layer_norm(DEEPNORM_ALPHA * x + ff, ln2_g, ln2_b)
    return x


def setup_inputs(seed: int = 0) -> dict:
    key = jax.random.key(seed)
    ks = jax.random.split(key, 16)
    f32 = jnp.float32
    nrm = lambda k, shape, s: jax.random.normal(k, shape, f32) * s
    return {
        "x_prompt": jax.random.normal(ks[0], (BATCH, SEQ, D_MODEL), f32),
        "x_sample": jax.random.normal(ks[1], (DEC_BATCH, DEC_SEQ, D_MODEL), f32),
        "w_in": nrm(ks[2], (DEPTH, D_MODEL, IN_WIDTH), D_MODEL ** -0.5),
        "ln_sgu_g": 1.0 + nrm(ks[3], (DEPTH, SGU_WIDTH), 0.01),
        "ln_sgu_b": nrm(ks[4], (DEPTH, SGU_WIDTH), 0.01),
        "w_s": nrm(ks[5], (DEPTH, N_SGU_GROUPS, BLOCK, BLOCK), BLOCK ** -0.5),
        "b_s": 1.0 + nrm(ks[6], (DEPTH, N_SGU_GROUPS, BLOCK), 0.01),
        "attn_sink": nrm(ks[7], (DEPTH, N_HEADS), 0.5),
        "w_o": nrm(ks[8], (DEPTH, MIX_WIDTH, D_MODEL), MIX_WIDTH ** -0.5 * DEEPNORM_BETA),
        "ln1_g": 1.0 + nrm(ks[9], (DEPTH, D_MODEL), 0.01),
        "ln1_b": nrm(ks[10], (DEPTH, D_MODEL), 0.01),
        "w_gate": nrm(ks[11], (DEPTH, D_MODEL, D_FF), D_MODEL ** -0.5),
        "w_up": nrm(ks[12], (DEPTH, D_MODEL, D_FF), D_MODEL ** -0.5),
        "w_down": nrm(ks[13], (DEPTH, D_FF, D_MODEL), D_FF ** -0.5 * DEEPNORM_BETA),
        "ln2_g": 1.0 + nrm(ks[14], (DEPTH, D_MODEL), 0.01),
        "ln2_b": nrm(ks[15], (DEPTH, D_MODEL), 0.01),
    }


def reference(x_prompt, x_sample, w_in, ln_sgu_g, ln_sgu_b, w_s, b_s, attn_sink, w_o,
              ln1_g, ln1_b, w_gate, w_up, w_down, ln2_g, ln2_b):
    y_prompt = x_prompt
    y_sample = x_sample
    for l in range(DEPTH):
        p = (w_in[l], ln_sgu_g[l], ln_sgu_b[l], w_s[l], b_s[l], attn_sink[l], w_o[l],
             ln1_g[l], ln1_b[l], w_gate[l], w_up[l], w_down[l], ln2_g[l], ln2_b[l])
        y_prompt = _layer(y_prompt, *p)
        y_sample = _layer(y_sample, *p)
    return (y_prompt, y_sample)
```

```cpp
#include <hip/hip_runtime.h>
#include <hip/hip_cooperative_groups.h>
#include <cstdio>
#include <cstdint>
namespace cg = cooperative_groups;

namespace pg8 {
#define PG8_LAS __attribute__((address_space(3)))
typedef unsigned short bf16_t;
typedef short bf16x8 __attribute__((ext_vector_type(8)));
typedef float f32x4 __attribute__((ext_vector_type(4)));
typedef unsigned u32x4 __attribute__((ext_vector_type(4)));
constexpr int BM = 256, BK = 64, HALF = 128, HTB = HALF * BK * 2  , STAGE_BYTES = 8 * HTB, NXCD = 8, WGM = 8;

__host__ __device__ __forceinline__ int lds_byte(int r, int c) { const int st = (r >> 4) * 2 + (c >> 5), rr = r & 15, cc = c & 31, ob = rr * 64 + cc * 2; return st * 1024 + (ob ^ (((ob >> 9) & 1) << 5)); }
__host__ __device__ __forceinline__ void stage_rc(int b, int& R, int& C) { const int st = b / 1024, sb = b % 1024, swz = sb ^ (((sb >> 9) & 1) << 5); R = (st >> 1) * 16 + swz / 64; C = (st & 1) * 32 + (swz % 64) / 2; }
__host__ __device__ __forceinline__ int perm32(int rho) { const int n = rho >> 4, i = rho & 15; return 8 * (i >> 2) + 4 * n + (i & 3); }

struct Unit { int pm, pn; };
struct Gemm { const bf16_t* A; const bf16_t* Bt; int M, N, K; };

struct StaticOrder {
    int nM, nN, nwg, G, c;
    __host__ __device__ void init(int M, int N, int G_, int c_) { nM = M / BM; nN = N / BM; nwg = nM * nN; G = G_; c = c_; }
    __host__ __device__ bool next(int i, Unit& u) const {
        const long L = (long)i * G + c; if (L >= nwg) return false;
        int wgid = (int)L; { const int q = nwg / NXCD, r = nwg % NXCD, xcd = wgid % NXCD, off = wgid / NXCD; wgid = (xcd < r ? xcd * (q + 1) : r * (q + 1) + (xcd - r) * q) + off; }
        const int nig = WGM * nN, gid = wgid / nig, fm = gid * WGM, gsz = (nM - fm) < WGM ? (nM - fm) : WGM;
        u.pm = fm + ((wgid % nig) % gsz); u.pn = (wgid % nig) / gsz; return true;
    }
    __device__ __forceinline__ void a_ready(const Unit&) const {}
    __device__ __forceinline__ void done(const Unit&) const {}
};

__device__ __forceinline__ unsigned cvt_pk_bf16(float lo, float hi) { unsigned r; asm("v_cvt_pk_bf16_f32 %0, %1, %2" : "=v"(r) : "v"(lo), "v"(hi)); return r; }

template <class Epi, class Sched, bool ALIGN_EPI = false, bool SP2 = false>
__device__ __forceinline__ void gemm_phase(PG8_LAS unsigned char* lds, const Gemm g, const Sched& S, const Epi& E) {
    int tid_ = threadIdx.x; asm volatile("" : "+v"(tid_));
    const int tid = tid_, wid = __builtin_amdgcn_readfirstlane(tid >> 6), lane = tid & 63, wr = wid >> 2, wc = wid & 3, fr = lane & 15, fq = lane >> 4;
    const int K = g.K, nt = K / BK;
    unsigned voffA[2], voffB[2];
#pragma unroll
    for (int i = 0; i < 2; ++i) { int R, C; stage_rc(tid * 16 + i * 8192, R, C); const int Rb = Epi::PERM ? ((R & ~31) + perm32(R & 31)) : R;
        voffA[i] = (unsigned)(R * K + C) * 2u; voffB[i] = (unsigned)(Rb * K + C) * 2u; }
    const size_t kstep = (size_t)(BK * 2);
    const size_t hstep = (size_t)HALF * K * 2;
    const size_t tstep = 2 * hstep;
    const unsigned ldsw = (unsigned)wid * 1024u;
    const int aoff = lds_byte(wr * 64 + fr, fq * 8), boff = lds_byte(wc * 32 + fr, fq * 8);
#define PG8_SA(b, h) (((b) * 2 + (h)) * HTB)
#define PG8_SB(b, h) ((4 + (b) * 2 + (h)) * HTB)
#define PG8_STAGE(bufoff, gbase, voff) do { _Pragma("unroll") for (int _i = 0; _i < 2; ++_i) \
        __builtin_amdgcn_global_load_lds((const unsigned*)((const char*)(gbase) + (voff)[_i]), (PG8_LAS unsigned*)(lds + (bufoff) + ldsw + _i * 8192), 16, 0, 0); } while (0)
#define PG8_LDA(dst, b, h) do { _Pragma("unroll") for (int m = 0; m < 4; ++m) _Pragma("unroll") for (int k = 0; k < 2; ++k) dst[m][k] = *(const PG8_LAS bf16x8*)(lds + PG8_SA(b, h) + aoff + m * 2048 + k * 1024); } while (0)
#define PG8_LDB(dst, b, h) do { _Pragma("unroll") for (int n = 0; n < 2; ++n) _Pragma("unroll") for (int k = 0; k < 2; ++k) dst[n][k] = *(const PG8_LAS bf16x8*)(lds + PG8_SB(b, h) + boff + n * 2048 + k * 1024); } while (0)
#define PG8_MMA(ai, bj, At, Bt) do { __builtin_amdgcn_s_setprio(1); _Pragma("unroll") for (int m = 0; m < 4; ++m) _Pragma("unroll") for (int n = 0; n < 2; ++n) _Pragma("unroll") for (int k = 0; k < 2; ++k) \
        acc[ai][bj][m][n] = __builtin_amdgcn_mfma_f32_16x16x32_bf16(Bt[n][k], At[m][k], acc[ai][bj][m][n], 0, 0, 0); __builtin_amdgcn_s_setprio(0); } while (0)
#define PG8_WAIT_V(n) asm volatile("s_waitcnt vmcnt(" #n ")" ::: "memory")
#define PG8_WAIT_L(n) asm volatile("s_waitcnt lgkmcnt(" #n ")" ::: "memory")
#define PG8_BAR __builtin_amdgcn_s_barrier()
#define PG8_SCHED __builtin_amdgcn_sched_barrier(0)
    Unit cur, nxt; int ui = 0;
    if (!S.next(0, cur)) return;
    f32x4 acc[2][2][4][2];
#pragma unroll
    for (int a = 0; a < 2; ++a)
#pragma unroll
        for (int b = 0; b < 2; ++b)
#pragma unroll
            for (int m = 0; m < 4; ++m)
#pragma unroll
                for (int n = 0; n < 2; ++n) acc[a][b][m][n] = (f32x4){0.f, 0.f, 0.f, 0.f};
    bf16x8 At[4][2], B0[2][2], B1[2][2];
    const char* cA = (const char*)g.A + (size_t)cur.pm * tstep; const char* cB = (const char*)g.Bt + (size_t)cur.pn * tstep;
    S.a_ready(cur);
    if constexpr (SP2) {
        PG8_STAGE(PG8_SB(0, 0), cB, voffB); PG8_STAGE(PG8_SB(0, 1), cB + hstep, voffB); PG8_STAGE(PG8_SA(0, 0), cA, voffA); PG8_STAGE(PG8_SA(0, 1), cA + hstep, voffA);
        if (wr == 1) PG8_BAR;
        PG8_WAIT_V(2); PG8_BAR;
        PG8_STAGE(PG8_SB(1, 0), cB + kstep, voffB); PG8_STAGE(PG8_SA(1, 0), cA + kstep, voffA); PG8_STAGE(PG8_SB(1, 1), cB + hstep + kstep, voffB);
        PG8_WAIT_V(6); PG8_BAR;
    } else {
        PG8_STAGE(PG8_SB(0, 0), cB, voffB); PG8_STAGE(PG8_SA(0, 0), cA, voffA); PG8_STAGE(PG8_SB(0, 1), cB + hstep, voffB); PG8_STAGE(PG8_SA(0, 1), cA + hstep, voffA);
        if (wr == 1) PG8_BAR;
        PG8_WAIT_V(4); PG8_BAR;
        PG8_STAGE(PG8_SB(1, 0), cB + kstep, voffB); PG8_STAGE(PG8_SA(1, 0), cA + kstep, voffA); PG8_STAGE(PG8_SB(1, 1), cB + hstep + kstep, voffB);
        PG8_WAIT_V(6); PG8_BAR;
    }
    for (;;) {
        const bool has_next = S.next(ui + 1, nxt);
        const char* nA = has_next ? (const char*)g.A + (size_t)nxt.pm * tstep : cA; const char* nB = has_next ? (const char*)g.Bt + (size_t)nxt.pn * tstep : cB;
        for (int t = 0; t < nt; t += 2) {
            const bool last = (t == nt - 2);
            const char* a1 = cA + (size_t)(t + 1) * kstep;
            const char* a2 = last ? nA : cA + (size_t)(t + 2) * kstep; const char* b2 = last ? nB : cB + (size_t)(t + 2) * kstep;
            const char* a3 = a2 + kstep; const char* b3 = b2 + kstep;
            if (last && has_next) S.a_ready(nxt);
            if constexpr (SP2) {
            PG8_LDB(B0, 0, 0); PG8_LDB(B1, 0, 1); PG8_SCHED; PG8_LDA(At, 0, 0); PG8_STAGE(PG8_SA(1, 1), a1 + hstep, voffA);
            PG8_WAIT_V(8); PG8_WAIT_L(0); PG8_BAR; PG8_MMA(0, 0, At, B0); PG8_MMA(0, 1, At, B1); PG8_BAR; PG8_SCHED;
            PG8_LDA(At, 0, 1); PG8_STAGE(PG8_SB(0, 0), b2, voffB); PG8_STAGE(PG8_SB(0, 1), b2 + hstep, voffB); PG8_STAGE(PG8_SA(0, 0), a2, voffA);
            PG8_WAIT_V(8); PG8_WAIT_L(0); PG8_BAR; PG8_MMA(1, 0, At, B0); PG8_MMA(1, 1, At, B1); PG8_BAR; PG8_SCHED;
            PG8_LDB(B0, 1, 0); PG8_LDB(B1, 1, 1); PG8_SCHED; PG8_LDA(At, 1, 0); PG8_STAGE(PG8_SA(0, 1), a2 + hstep, voffA);
            PG8_WAIT_V(8); PG8_WAIT_L(0); PG8_BAR; PG8_MMA(0, 0, At, B0); PG8_MMA(0, 1, At, B1); PG8_BAR; PG8_SCHED;
            PG8_LDA(At, 1, 1); PG8_STAGE(PG8_SB(1, 0), b3, voffB); PG8_STAGE(PG8_SB(1, 1), b3 + hstep, voffB); PG8_STAGE(PG8_SA(1, 0), a3, voffA);
            PG8_WAIT_V(8); PG8_WAIT_L(0); PG8_BAR; PG8_MMA(1, 0, At, B0); PG8_MMA(1, 1, At, B1); PG8_BAR; PG8_SCHED;
            } else {
            PG8_LDB(B0, 0, 0); PG8_SCHED; PG8_LDA(At, 0, 0); PG8_STAGE(PG8_SA(1, 1), a1 + hstep, voffA);
            PG8_WAIT_L(8); PG8_BAR; PG8_WAIT_L(0); PG8_MMA(0, 0, At, B0); PG8_BAR; PG8_SCHED;
            PG8_LDB(B1, 0, 1); PG8_STAGE(PG8_SB(0, 0), b2, voffB);
            PG8_BAR; PG8_WAIT_L(0); PG8_MMA(0, 1, At, B1); PG8_BAR;
            PG8_LDA(At, 0, 1); PG8_STAGE(PG8_SA(0, 0), a2, voffA);
            PG8_BAR; PG8_WAIT_L(0); PG8_MMA(1, 0, At, B0); PG8_BAR; PG8_SCHED;
            PG8_STAGE(PG8_SB(0, 1), b2 + hstep, voffB);
            PG8_WAIT_V(6); PG8_BAR; PG8_MMA(1, 1, At, B1); PG8_BAR;
            PG8_LDB(B0, 1, 0); PG8_SCHED; PG8_LDA(At, 1, 0); PG8_STAGE(PG8_SA(0, 1), a2 + hstep, voffA);
            PG8_WAIT_L(8); PG8_BAR; PG8_WAIT_L(0); PG8_MMA(0, 0, At, B0); PG8_BAR; PG8_SCHED;
            PG8_LDB(B1, 1, 1); PG8_STAGE(PG8_SB(1, 0), b3, voffB);
            PG8_BAR; PG8_WAIT_L(0); PG8_MMA(0, 1, At, B1); PG8_BAR;
            PG8_LDA(At, 1, 1); PG8_STAGE(PG8_SA(1, 0), a3, voffA);
            PG8_BAR; PG8_WAIT_L(0); PG8_MMA(1, 0, At, B0); PG8_BAR; PG8_SCHED;
            PG8_STAGE(PG8_SB(1, 1), b3 + hstep, voffB);
            PG8_WAIT_V(6); PG8_BAR; PG8_MMA(1, 1, At, B1); PG8_BAR;
            }
        }
        if constexpr (ALIGN_EPI) { if (wr == 0) PG8_BAR; }
        E(acc, cur, wr, wc, fr, fq); S.done(cur);
        if (!has_next) break;
#pragma unroll
        for (int a = 0; a < 2; ++a)
#pragma unroll
            for (int b = 0; b < 2; ++b)
#pragma unroll
                for (int m = 0; m < 4; ++m)
#pragma unroll
                    for (int n = 0; n < 2; ++n) acc[a][b][m][n] = (f32x4){0.f, 0.f, 0.f, 0.f};
        cur = nxt; cA = nA; cB = nB; ++ui;
        if constexpr (ALIGN_EPI) { if (wr == 1) PG8_BAR; }
    }
    PG8_WAIT_V(0);
    if constexpr (!ALIGN_EPI) { if (wr == 0) PG8_BAR; }
    PG8_BAR;
#undef PG8_SA
#undef PG8_SB
#undef PG8_STAGE
#undef PG8_LDA
#undef PG8_LDB
#undef PG8_MMA
#undef PG8_WAIT_V
#undef PG8_WAIT_L
#undef PG8_BAR
#undef PG8_SCHED
}
}

constexpr int NWAVES = 8, NTHR = 512;
constexpr int M = 24576, MP = 16384, DM = 2048, NIN = 3584, DFF = 5632;
constexpr int COL_K = 1024, COL_V = 1280, COL_U = 1536, COL_GV = 2560;
constexpr int NGC = 192;
constexpr float LN_EPS = 1e-5f;
constexpr float ALPHA = 1.189207115002721f;
constexpr float LOG2E = 1.4426950408889634f;

constexpr size_t MiB = 1u << 20;
constexpr size_t WS_WIN = 1 * MiB, WS_WO = 15 * MiB, WS_W13 = 23 * MiB, WS_W2 = 67 * MiB, WS_ST1 = 89 * MiB;
constexpr size_t WS_XB = 90 * MiB;
constexpr size_t WS_H = 186 * MiB;
constexpr size_t WS_MIX = 354 * MiB;
constexpr size_t WS_HID = 186 * MiB;
constexpr size_t WS_END = 450 * MiB;
static_assert(WS_H + (size_t)M * NIN * 2 == WS_MIX && WS_MIX + (size_t)M * DM * 2 == WS_END && WS_HID + (size_t)M * DFF * 2 == WS_END, "ws map");

constexpr int LDS_BYTES = 131072 + 4096;

#define GAS __attribute__((address_space(1)))
#define LAS __attribute__((address_space(3)))
typedef unsigned short bf16;
typedef unsigned v4u __attribute__((ext_vector_type(4)));
typedef unsigned v2u __attribute__((ext_vector_type(2)));
typedef float f32x4 __attribute__((ext_vector_type(4)));
typedef float f32x2 __attribute__((ext_vector_type(2)));
typedef short bf16x8 __attribute__((ext_vector_type(8)));
using pg8::cvt_pk_bf16;
#define LDS_WAIT() asm volatile("s_waitcnt lgkmcnt(0)" ::: "memory")
__device__ __forceinline__ float bf_lo(unsigned w) { return __uint_as_float(w << 16); }
__device__ __forceinline__ float bf_hi(unsigned w) { return __uint_as_float(w & 0xffff0000u); }
__device__ __forceinline__ float wave_sum(float v) {
#pragma unroll
    for (int o = 1; o < 64; o <<= 1) v += __shfl_xor(v, o);
    return v;
}
__device__ __forceinline__ float gelu_tanh(float x) {
    const float t = x * (-2.3022082f + (-0.10294324f) * x * x);
    return x * __builtin_amdgcn_rcpf(1.0f + __builtin_amdgcn_exp2f(t));
}
__device__ __forceinline__ float silu_f(float x) { return x * __builtin_amdgcn_rcpf(1.0f + __builtin_amdgcn_exp2f(-LOG2E * x)); }

struct EpiH {
    static constexpr bool PERM = true;
    bf16* O;
    __device__ __forceinline__ void operator()(const f32x4 (&acc)[2][2][4][2], const pg8::Unit& u, int wr, int wc, int fr, int fq) const {
        const int row0 = u.pm * 256 + wr * 64 + fr, col0 = u.pn * 256 + wc * 32 + 8 * fq;
        const bool act = u.pn >= 6;
#pragma unroll
        for (int ai = 0; ai < 2; ++ai)
#pragma unroll
            for (int m = 0; m < 4; ++m) { bf16* rowp = O + (size_t)(row0 + ai * 128 + m * 16) * NIN + col0;
#pragma unroll
                for (int bj = 0; bj < 2; ++bj) { f32x4 v0 = acc[ai][bj][m][0], v1 = acc[ai][bj][m][1];
                    if (act) {
#pragma unroll
                        for (int i = 0; i < 4; ++i) { v0[i] = gelu_tanh(v0[i]); v1[i] = gelu_tanh(v1[i]); } }
                    v4u w; w.x = cvt_pk_bf16(v0[0], v0[1]); w.y = cvt_pk_bf16(v0[2], v0[3]); w.z = cvt_pk_bf16(v1[0], v1[1]); w.w = cvt_pk_bf16(v1[2], v1[3]);
                    *(v4u*)(rowp + bj * 128) = w; } }
    }
};
struct EpiY1 {
    static constexpr bool PERM = false;
    const float* xp; const float* xs; float* Y;
    __device__ __forceinline__ void operator()(const f32x4 (&acc)[2][2][4][2], const pg8::Unit& u, int wr, int wc, int fr, int fq) const {
        const int row0 = u.pm * 256 + wr * 64 + fr, col0 = u.pn * 256 + wc * 32 + 4 * fq;
        const float* xb = (u.pm < MP / 256) ? xp : xs - (size_t)MP * DM;
#pragma unroll
        for (int ai = 0; ai < 2; ++ai)
#pragma unroll
            for (int m = 0; m < 4; ++m) { const size_t off = (size_t)(row0 + ai * 128 + m * 16) * DM + col0;
#pragma unroll
                for (int bj = 0; bj < 2; ++bj)
#pragma unroll
                    for (int n = 0; n < 2; ++n) { const f32x4 xv = *(const f32x4*)(xb + off + bj * 128 + n * 16);
                        *(f32x4*)(Y + off + bj * 128 + n * 16) = xv * ALPHA + acc[ai][bj][m][n]; } }
    }
};
struct EpiHid {
    static constexpr bool PERM = true;
    bf16* O;
    __device__ __forceinline__ void operator()(const f32x4 (&acc)[2][2][4][2], const pg8::Unit& u, int wr, int wc, int fr, int fq) const {
        const int row0 = u.pm * 256 + wr * 64 + fr, col0 = u.pn * 128 + wc * 32 + 8 * fq;
#pragma unroll
        for (int ai = 0; ai < 2; ++ai)
#pragma unroll
            for (int m = 0; m < 4; ++m) {
                const f32x4 g0 = acc[ai][0][m][0], g1 = acc[ai][0][m][1], u0 = acc[ai][1][m][0], u1 = acc[ai][1][m][1];
                float h[8];
#pragma unroll
                for (int i = 0; i < 4; ++i) { h[i] = silu_f(g0[i]) * u0[i]; h[4 + i] = silu_f(g1[i]) * u1[i]; }
                v4u w; w.x = cvt_pk_bf16(h[0], h[1]); w.y = cvt_pk_bf16(h[2], h[3]); w.z = cvt_pk_bf16(h[4], h[5]); w.w = cvt_pk_bf16(h[6], h[7]);
                *(v4u*)(O + (size_t)(row0 + ai * 128 + m * 16) * DFF + col0) = w; }
    }
};
struct EpiY2 {
    static constexpr bool PERM = false;
    float* Y; const float* st1; const float* g1; const float* b1;
    __device__ __forceinline__ void operator()(const f32x4 (&acc)[2][2][4][2], const pg8::Unit& u, int wr, int wc, int fr, int fq) const {
        const int row0 = u.pm * 256 + wr * 64 + fr, col0 = u.pn * 256 + wc * 32 + 4 * fq;
        f32x4 gv[2][2], bv[2][2];
#pragma unroll
        for (int bj = 0; bj < 2; ++bj)
#pragma unroll
            for (int n = 0; n < 2; ++n) { gv[bj][n] = *(const f32x4*)(g1 + col0 + bj * 128 + n * 16) * ALPHA; bv[bj][n] = *(const f32x4*)(b1 + col0 + bj * 128 + n * 16) * ALPHA; }
#pragma unroll
        for (int ai = 0; ai < 2; ++ai)
#pragma unroll
            for (int m = 0; m < 4; ++m) { const int r = row0 + ai * 128 + m * 16; const size_t off = (size_t)r * DM + col0;
                const f32x2 st = *(const f32x2*)(st1 + 2 * r);
#pragma unroll
                for (int bj = 0; bj < 2; ++bj)
#pragma unroll
                    for (int n = 0; n < 2; ++n) { const f32x4 yv = *(const f32x4*)(Y + off + bj * 128 + n * 16);
                        *(f32x4*)(Y + off + bj * 128 + n * 16) = ((yv - st.x) * st.y) * gv[bj][n] + bv[bj][n] + acc[ai][bj][m][n]; } }
    }
};

__device__ __forceinline__ void p0_transpose_item(const float* W, int K, int N, bf16* WT, int drow0, int k0, int n0, LAS float* scr, int lane) {
#pragma unroll 8
    for (int i = 0; i < 32; ++i) { const int kk = 2 * i + (lane >> 5); scr[kk * 33 + (lane & 31)] = W[(size_t)(k0 + kk) * N + n0 + (lane & 31)]; }
    LDS_WAIT(); asm volatile("" ::: "memory");
    const int c = lane & 7;
#pragma unroll
    for (int j = 0; j < 4; ++j) { const int n = (lane >> 3) + 8 * j; const LAS float* s = scr + (8 * c) * 33 + n;
        v4u o; o.x = cvt_pk_bf16(s[0 * 33], s[1 * 33]); o.y = cvt_pk_bf16(s[2 * 33], s[3 * 33]); o.z = cvt_pk_bf16(s[4 * 33], s[5 * 33]); o.w = cvt_pk_bf16(s[6 * 33], s[7 * 33]);
        *(v4u*)(WT + (size_t)(drow0 + n) * K + k0 + 8 * c) = o; }
    LDS_WAIT(); asm volatile("" ::: "memory");
}

struct Args { const float* in[16]; float* out; unsigned char* ws; };

template <bool FINAL>
__device__ __forceinline__ void ln_rows(const float* src, float* dstf, bf16* dstb, float* stats, const float* g, const float* b, int gw, int NGW, int lane) {
    f32x4 gg[8], bb[8];
#pragma unroll
    for (int j = 0; j < 8; ++j) { gg[j] = ((const f32x4*)g)[lane + 64 * j]; bb[j] = ((const f32x4*)b)[lane + 64 * j]; }
    for (int m = gw; m < M; m += NGW) {
        const f32x4* xr = (const f32x4*)(src + (size_t)m * DM) + lane;
        f32x4 v[8]; float s = 0.f;
#pragma unroll
        for (int j = 0; j < 8; ++j) { v[j] = xr[64 * j]; s += (v[j].x + v[j].y) + (v[j].z + v[j].w); }
        const float mean = wave_sum(s) * (1.f / DM); float s2 = 0.f;
#pragma unroll
        for (int j = 0; j < 8; ++j) { v[j] = v[j] - mean; s2 += (v[j].x * v[j].x + v[j].y * v[j].y) + (v[j].z * v[j].z + v[j].w * v[j].w); }
        const float rstd = 1.f / sqrtf(wave_sum(s2) * (1.f / DM) + LN_EPS);
        if (FINAL) {
            f32x4* o = (f32x4*)(dstf + (size_t)m * DM) + lane;
#pragma unroll
            for (int j = 0; j < 8; ++j) o[64 * j] = (v[j] * rstd) * gg[j] + bb[j];
        } else {
            v2u* o = (v2u*)(dstb + (size_t)m * DM) + lane;
#pragma unroll
            for (int j = 0; j < 8; ++j) { const f32x4 y = (v[j] * rstd) * gg[j] + bb[j]; v2u w; w.x = cvt_pk_bf16(y.x, y.y); w.y = cvt_pk_bf16(y.z, y.w); o[64 * j] = w; }
            if (lane == 0) { stats[2 * m] = mean; stats[2 * m + 1] = rstd; }
        }
    }
}

constexpr int VT_PITCH = 784;
__device__ __forceinline__ void attn_unit(LAS unsigned char* lds, const bf16* H, bf16* MIX, const float* sink, int gc, int h, int tid, int wave, int lane) {
    const int c = gc & 15, kv = h >> 2, fr = lane & 15, fq = lane >> 4;
    const int rowq0 = gc * 128, roww0 = rowq0 - 128;
    const bool v0 = (c != 0), v2 = (c != 15);
    __syncthreads();
    {
        const bf16* Kg = H + COL_K + 128 * kv;
#pragma unroll
        for (int it = 0; it < 12; ++it) { const int ch = tid + it * NTHR, row = ch >> 4, cc = ch & 15, kb = row >> 7;
            const int grow = roww0 + row + ((kb == 0 && !v0) ? 128 : 0) - ((kb == 2 && !v2) ? 128 : 0);
            const v4u v = *(const v4u*)(Kg + (size_t)grow * NIN + cc * 8);
            const int g = (((row >> 3) & 3) << 2) | (row & 3);
            *(LAS v4u*)(lds + row * 256 + ((cc ^ g) << 4)) = v; }
    }
    bf16x8 qf[4];
    { const bf16* Qg = H + (size_t)(rowq0 + 16 * wave + fr) * NIN + 128 * h + 8 * fq;
#pragma unroll
      for (int ks = 0; ks < 4; ++ks) qf[ks] = *(const bf16x8*)(Qg + 32 * ks); }
    __syncthreads();
    f32x4 S[24];
#pragma unroll
    for (int j = 0; j < 24; ++j) {
        S[j] = (f32x4){0.f, 0.f, 0.f, 0.f};
        const int krow = 32 * (j >> 1) + 8 * (fr >> 2) + 4 * (j & 1) + (fr & 3);
#pragma unroll
        for (int ks = 0; ks < 4; ++ks) { const bf16x8 kf = *(const LAS bf16x8*)(lds + krow * 256 + (((4 * ks + fq) ^ fr) << 4));
            S[j] = __builtin_amdgcn_mfma_f32_16x16x32_bf16(kf, qf[ks], S[j], 0, 0, 0); }
        if (j & 1) __builtin_amdgcn_sched_barrier(0);
    }
    const float sc2 = 0.08838834764831845f * LOG2E, slope2 = __builtin_amdgcn_exp2f(-(float)(h + 1)) * LOG2E, sink2 = sink[h] * LOG2E;
    const int qi = 16 * wave + fr;
    float mx = sink2;
    const float pen0 = v0 ? 0.f : -1e30f, pen2 = v2 ? 0.f : -1e30f;
    int rel0 = 8 * fq - 128 - qi;
    asm volatile("" : "+v"(rel0));
#pragma unroll
    for (int j = 0; j < 24; ++j) { const int kb = j >> 3; const float pen = kb == 0 ? pen0 : (kb == 2 ? pen2 : 0.f);
#pragma unroll
        for (int i = 0; i < 4; ++i) { const int rel = rel0 + (32 * (j >> 1) + 4 * (j & 1) + i); const int dist = __builtin_abs(rel); const int over = max(dist - 128, 0);
            const float s = (S[j][i] * sc2 - slope2 * (float)dist) - 1e30f * (float)over + pen;
            S[j][i] = s; mx = fmaxf(mx, s); } }
    mx = fmaxf(mx, __shfl_xor(mx, 16)); mx = fmaxf(mx, __shfl_xor(mx, 32));
    float sum = 0.f;
#pragma unroll
    for (int j = 0; j < 24; ++j)
#pragma unroll
        for (int i = 0; i < 4; ++i) { const float p = __builtin_amdgcn_exp2f(S[j][i] - mx); S[j][i] = p; sum += p; }
    sum += __shfl_xor(sum, 16); sum += __shfl_xor(sum, 32);
    const float inv = 1.0f / (sum + __builtin_amdgcn_exp2f(sink2 - mx));
    v4u pf[12];
#pragma unroll
    for (int p = 0; p < 12; ++p) { pf[p].x = cvt_pk_bf16(S[2 * p][0], S[2 * p][1]); pf[p].y = cvt_pk_bf16(S[2 * p][2], S[2 * p][3]);
        pf[p].z = cvt_pk_bf16(S[2 * p + 1][0], S[2 * p + 1][1]); pf[p].w = cvt_pk_bf16(S[2 * p + 1][2], S[2 * p + 1][3]); }
    __syncthreads();
    {
        const bf16* Vg = H + COL_V + 128 * kv;
        for (int blk = tid; blk < 768; blk += NTHR) { const int kb = blk >> 8, r = blk & 255, sblk = r >> 4, dblk = r & 15;
            const int key0 = 128 * kb + 8 * sblk;
            const int grow = roww0 + key0 + ((kb == 0 && !v0) ? 128 : 0) - ((kb == 2 && !v2) ? 128 : 0);
            v4u in[8];
#pragma unroll
            for (int jj = 0; jj < 8; ++jj) in[jj] = *(const v4u*)(Vg + (size_t)(grow + jj) * NIN + 8 * dblk);
#pragma unroll
            for (int i = 0; i < 8; ++i) { v4u o;
#pragma unroll
                for (int t = 0; t < 4; ++t) { const unsigned a = in[2 * t][i >> 1], b = in[2 * t + 1][i >> 1];
                    o[t] = (i & 1) ? ((a >> 16) | (b & 0xffff0000u)) : ((a & 0xffffu) | (b << 16)); }
                *(LAS v4u*)(lds + (8 * dblk + i) * VT_PITCH + key0 * 2) = o; } }
    }
    __syncthreads();
    bf16* Og = MIX + (size_t)(rowq0 + 16 * wave + fr) * DM + 128 * h + 4 * fq;
#pragma unroll
    for (int dt = 0; dt < 8; ++dt) {
        f32x4 o = (f32x4){0.f, 0.f, 0.f, 0.f};
#pragma unroll
        for (int p = 0; p < 12; ++p) {
            const bf16x8 vf = *(const LAS bf16x8*)(lds + (16 * dt + fr) * VT_PITCH + (32 * p + 8 * fq) * 2);
            o = __builtin_amdgcn_mfma_f32_16x16x32_bf16(vf, __builtin_bit_cast(bf16x8, pf[p]), o, 0, 0, 0); }
        v2u w; w.x = cvt_pk_bf16(o[0] * inv, o[1] * inv); w.y = cvt_pk_bf16(o[2] * inv, o[3] * inv);
        *(v2u*)(Og + 16 * dt) = w;
        __builtin_amdgcn_sched_barrier(0);
    }
}

constexpr int GT_PITCH = 272, GT_BYTES = 128 * GT_PITCH;
__device__ __forceinline__ void sgu_unit(LAS unsigned char* lds, const bf16* H, bf16* MIX, const float* lng, const float* lnb, const float* w_s, const float* b_s, int gc, int tid, int wave, int lane) {
    const int r0 = gc * 128, fr = lane & 15, fq = lane >> 4;
    LAS f32x2* ST = (LAS f32x2*)lds;
    LAS unsigned char* GT = lds + 1024;
    __syncthreads();
    {
        const int l16 = lane & 15;
#pragma unroll 1
        for (int it = 0; it < 4; ++it) { const int row = 16 * wave + 4 * it + (lane >> 4);
            const bf16* p = H + (size_t)(r0 + row) * NIN + COL_GV + 8 * l16;
            v4u x[8]; float s = 0.f;
#pragma unroll
            for (int jj = 0; jj < 8; ++jj) { x[jj] = *(const v4u*)(p + 128 * jj);
#pragma unroll
                for (int t = 0; t < 4; ++t) s += bf_lo(x[jj][t]) + bf_hi(x[jj][t]); }
            s += __shfl_xor(s, 1); s += __shfl_xor(s, 2); s += __shfl_xor(s, 4); s += __shfl_xor(s, 8);
            const float mean = s * (1.f / 1024.f); float q = 0.f;
#pragma unroll
            for (int jj = 0; jj < 8; ++jj)
#pragma unroll
                for (int t = 0; t < 4; ++t) { const float a = bf_lo(x[jj][t]) - mean, b = bf_hi(x[jj][t]) - mean; q += a * a + b * b; }
            q += __shfl_xor(q, 1); q += __shfl_xor(q, 2); q += __shfl_xor(q, 4); q += __shfl_xor(q, 8);
            if (l16 == 0) ST[row] = (f32x2){mean, 1.f / sqrtf(q * (1.f / 1024.f) + LN_EPS)}; }
    }
    __syncthreads();
#pragma unroll 1
    for (int gp = 0; gp < 4; ++gp) {
        { const int gsel = tid >> 8, r = tid & 255, sblk = r >> 4, dblk = r & 15, g = 2 * gp + gsel, ch0 = 128 * g + 8 * dblk;
          const f32x4 ga = *(const f32x4*)(lng + ch0), gb = *(const f32x4*)(lng + ch0 + 4), ba = *(const f32x4*)(lnb + ch0), bb = *(const f32x4*)(lnb + ch0 + 4);
          const float gam[8] = {ga.x, ga.y, ga.z, ga.w, gb.x, gb.y, gb.z, gb.w}, bet[8] = {ba.x, ba.y, ba.z, ba.w, bb.x, bb.y, bb.z, bb.w};
          v4u in[8];
#pragma unroll
          for (int jj = 0; jj < 8; ++jj) in[jj] = *(const v4u*)(H + (size_t)(r0 + 8 * sblk + jj) * NIN + COL_GV + ch0);
          f32x2 st[8];
#pragma unroll
          for (int jj = 0; jj < 8; ++jj) st[jj] = ST[8 * sblk + jj];
#pragma unroll
          for (int i = 0; i < 8; ++i) { v4u o;
#pragma unroll
              for (int t = 0; t < 4; ++t) { const unsigned a = in[2 * t][i >> 1], b = in[2 * t + 1][i >> 1];
                  const float xa = (i & 1) ? bf_hi(a) : bf_lo(a), xb = (i & 1) ? bf_hi(b) : bf_lo(b);
                  o[t] = cvt_pk_bf16((xa - st[2 * t].x) * st[2 * t].y * gam[i] + bet[i], (xb - st[2 * t + 1].x) * st[2 * t + 1].y * gam[i] + bet[i]); }
              *(LAS v4u*)(GT + gsel * GT_BYTES + (8 * dblk + i) * GT_PITCH + 16 * sblk) = o; } }
        __syncthreads();
        { const int gsel = wave >> 2, tq = wave & 3, g = 2 * gp + gsel;
          bf16x8 wf[2][4];
#pragma unroll
          for (int tt = 0; tt < 2; ++tt)
#pragma unroll
              for (int ks = 0; ks < 4; ++ks) { const float* wp = w_s + (size_t)(g * 128 + 32 * tq + 16 * tt + fr) * 128 + 32 * ks + 8 * fq;
                  const f32x4 a = *(const f32x4*)wp, b = *(const f32x4*)(wp + 4);
                  v4u w; w.x = cvt_pk_bf16(a.x, a.y); w.y = cvt_pk_bf16(a.z, a.w); w.z = cvt_pk_bf16(b.x, b.y); w.w = cvt_pk_bf16(b.z, b.w);
                  wf[tt][ks] = __builtin_bit_cast(bf16x8, w); }
          const LAS unsigned char* Gb = GT + gsel * GT_BYTES + fr * GT_PITCH + 16 * fq;
#pragma unroll
          for (int dt = 0; dt < 8; ++dt) {
              f32x4 a0 = (f32x4){0.f, 0.f, 0.f, 0.f}, a1 = a0;
#pragma unroll
              for (int ks = 0; ks < 4; ++ks) { const bf16x8 gf = *(const LAS bf16x8*)(Gb + 16 * dt * GT_PITCH + 64 * ks);
                  a0 = __builtin_amdgcn_mfma_f32_16x16x32_bf16(gf, wf[0][ks], a0, 0, 0, 0);
                  a1 = __builtin_amdgcn_mfma_f32_16x16x32_bf16(gf, wf[1][ks], a1, 0, 0, 0); }
#pragma unroll
              for (int tt = 0; tt < 2; ++tt) { const int t = 32 * tq + 16 * tt + fr; const float bias = b_s[g * 128 + t]; const f32x4 a = tt ? a1 : a0;
                  const v2u uu = *(const v2u*)(H + (size_t)(r0 + t) * NIN + COL_U + 128 * g + 16 * dt + 4 * fq);
                  v2u w; w.x = cvt_pk_bf16(bf_lo(uu.x) * (a[0] + bias), bf_hi(uu.x) * (a[1] + bias)); w.y = cvt_pk_bf16(bf_lo(uu.y) * (a[2] + bias), bf_hi(uu.y) * (a[3] + bias));
                  *(v2u*)(MIX + (size_t)(r0 + t) * DM + 1024 + 128 * g + 16 * dt + 4 * fq) = w; }
          } }
        __syncthreads();
    }
}

#ifndef PH_MASK
#define PH_MASK 0xff
#endif
__global__ void __launch_bounds__(NTHR, 2) fwd_megakernel(Args args) {
    extern __shared__ __attribute__((aligned(16))) unsigned char lds_raw[];
    cg::grid_group grid = cg::this_grid();
    LAS unsigned char* lds = (LAS unsigned char*)lds_raw;
    const int tid = threadIdx.x, lane = tid & 63, wave = __builtin_amdgcn_readfirstlane(tid >> 6);
    const int G = gridDim.x, bx = blockIdx.x;
    const int vcu = (G % 8 == 0) ? (bx % 8) * (G / 8) + bx / 8 : bx;
    unsigned char* ws = args.ws;
    const float* xp = args.in[0]; const float* xs = args.in[1];
    const float* w_in = args.in[2]; const float* ln_sgu_g = args.in[3]; const float* ln_sgu_b = args.in[4]; const float* w_s = args.in[5]; const float* b_s = args.in[6];
    const float* sink = args.in[7]; const float* w_o = args.in[8]; const float* ln1_g = args.in[9]; const float* ln1_b = args.in[10];
    const float* w_gate = args.in[11]; const float* w_up = args.in[12]; const float* w_down = args.in[13]; const float* ln2_g = args.in[14]; const float* ln2_b = args.in[15];
    float* out = args.out;
    bf16* WIN_T = (bf16*)(ws + WS_WIN); bf16* WO_T = (bf16*)(ws + WS_WO); bf16* W13_T = (bf16*)(ws + WS_W13); bf16* W2_T = (bf16*)(ws + WS_W2);
    float* ST1 = (float*)(ws + WS_ST1);
    bf16* XB = (bf16*)(ws + WS_XB); bf16* Hb = (bf16*)(ws + WS_H); bf16* MIX = (bf16*)(ws + WS_MIX); bf16* HID = (bf16*)(ws + WS_HID);
    const int gw = vcu * NWAVES + wave, NGW = G * NWAVES;

    if constexpr ((PH_MASK & 1) != 0) {
        LAS float* scr = (LAS float*)(lds + wave * 16384);
        constexpr int I_IN = (DM / 64) * (NIN / 32), I_O = (DM / 64) * (DM / 32), I_G = (DM / 64) * (DFF / 32), I_D = (DFF / 64) * (DM / 32);
        constexpr int NITEMS = I_IN + I_O + 2 * I_G + I_D;
        for (int it = gw; it < NITEMS; it += NGW) {
            int r = it;
            if (r < I_IN) { const int nb = r % (NIN / 32), kb = r / (NIN / 32); p0_transpose_item(w_in, DM, NIN, WIN_T, 32 * nb, 64 * kb, 32 * nb, scr, lane); continue; } r -= I_IN;
            if (r < I_O) { const int nb = r % (DM / 32), kb = r / (DM / 32); p0_transpose_item(w_o, DM, DM, WO_T, 32 * nb, 64 * kb, 32 * nb, scr, lane); continue; } r -= I_O;
            if (r < 2 * I_G) { const int up = r >= I_G ? 1 : 0; if (up) r -= I_G; const int nb = r % (DFF / 32), kb = r / (DFF / 32), n0 = 32 * nb;
                p0_transpose_item(up ? w_up : w_gate, DM, DFF, W13_T, (n0 >> 7) * 256 + up * 128 + (n0 & 127), 64 * kb, n0, scr, lane); continue; } r -= 2 * I_G;
            { const int nb = r % (DM / 32), kb = r / (DM / 32); p0_transpose_item(w_down, DFF, DM, W2_T, 32 * nb, 64 * kb, 32 * nb, scr, lane); }
        }
        const size_t n8 = (size_t)M * DM / 8, nthr = (size_t)G * NTHR;
        for (size_t i = (size_t)bx * NTHR + tid; i < n8; i += nthr) { const size_t e = i * 8;
            const float* src = (e < (size_t)MP * DM) ? xp + e : xs + (e - (size_t)MP * DM);
            const f32x4 a = *(const f32x4*)src, b = *(const f32x4*)(src + 4);
            v4u w; w.x = cvt_pk_bf16(a.x, a.y); w.y = cvt_pk_bf16(a.z, a.w); w.z = cvt_pk_bf16(b.x, b.y); w.w = cvt_pk_bf16(b.z, b.w);
            *(v4u*)(XB + e) = w; }
    }
    grid.sync();
    if constexpr ((PH_MASK & 2) != 0) { pg8::Gemm g{XB, WIN_T, M, NIN, DM}; pg8::StaticOrder S; S.init(M, NIN, G, bx); EpiH E{Hb};
      pg8::gemm_phase<EpiH, pg8::StaticOrder, true, true>(lds, g, S, E); }
    grid.sync();
    if constexpr ((PH_MASK & 4) != 0) { int tid2 = threadIdx.x; asm volatile("" : "+v"(tid2)); const int tid = tid2, lane = tid & 63, wave = __builtin_amdgcn_readfirstlane(tid >> 6);
      for (int it = vcu; it < NGC + NGC * 8; it += G) {
#ifndef NO_SGU
        if (it < NGC) sgu_unit(lds, Hb, MIX, ln_sgu_g, ln_sgu_b, w_s, b_s, it, tid, wave, lane);
#endif
#ifndef NO_ATTN
        if (it >= NGC) { const int a = it - NGC; attn_unit(lds, Hb, MIX, sink, a >> 3, a & 7, tid, wave, lane); }
#endif
    } }
    grid.sync();
    if constexpr ((PH_MASK & 8) != 0) { pg8::Gemm g{MIX, WO_T, M, DM, DM}; pg8::StaticOrder S; S.init(M, DM, G, bx); EpiY1 E{xp, xs, out};
      pg8::gemm_phase<EpiY1, pg8::StaticOrder, true, true>(lds, g, S, E); }
    grid.sync();
    if constexpr ((PH_MASK & 16) != 0) ln_rows<false>(out, nullptr, XB, ST1, ln1_g, ln1_b, gw, NGW, lane);
    grid.sync();
    if constexpr ((PH_MASK & 32) != 0) { pg8::Gemm g{XB, W13_T, M, 2 * DFF, DM}; pg8::StaticOrder S; S.init(M, 2 * DFF, G, bx); EpiHid E{HID};
      pg8::gemm_phase<EpiHid, pg8::StaticOrder, true, true>(lds, g, S, E); }
    grid.sync();
    if constexpr ((PH_MASK & 64) != 0) { pg8::Gemm g{HID, W2_T, M, DM, DFF}; pg8::StaticOrder S; S.init(M, DM, G, bx); EpiY2 E{out, ST1, ln1_g, ln1_b};
      pg8::gemm_phase<EpiY2, pg8::StaticOrder, true, true>(lds, g, S, E); }
    grid.sync();
    if constexpr ((PH_MASK & 128) != 0) ln_rows<true>(out, out, nullptr, nullptr, ln2_g, ln2_b, gw, NGW, lane);
}

extern "C" void kernel_launch(void* const* d_in, const int* in_sizes, int n_in, void* d_out, int out_size, void* d_ws, size_t ws_size, hipStream_t stream) {
    static int grid = 0;
    if (grid == 0) {
        if (n_in != 16 || out_size != M * DM || ws_size < WS_END) { fprintf(stderr, "kernel_launch: unexpected shapes (n_in %d, out %d, ws %zu)\n", n_in, out_size, ws_size); grid = -1; return; }
        int dev = 0, cus = 0, per_cu = 0;
        hipGetDevice(&dev);
        hipDeviceGetAttribute(&cus, hipDeviceAttributeMultiprocessorCount, dev);
        if (hipFuncSetAttribute((const void*)fwd_megakernel, hipFuncAttributeMaxDynamicSharedMemorySize, LDS_BYTES) != hipSuccess) { fprintf(stderr, "kernel_launch: hipFuncSetAttribute failed\n"); grid = -1; return; }
        if (hipOccupancyMaxActiveBlocksPerMultiprocessor(&per_cu, (const void*)fwd_megakernel, NTHR, LDS_BYTES) != hipSuccess || per_cu < 1) { fprintf(stderr, "kernel_launch: occupancy query says %d\n", per_cu); per_cu = 1; }
        (void)hipGetLastError();
        grid = cus;
        fprintf(stderr, "kernel_launch: grid %d (cus %d, per_cu %d)\n", grid, cus, per_cu);
    }
    if (grid < 0) return;
    Args a{};
    for (int i = 0; i < 16; ++i) a.in[i] = (const float*)d_in[i];
    a.out = (float*)d_out; a.ws = (unsigned char*)d_ws;
    void* kargs[] = {&a};
    hipError_t e = hipLaunchCooperativeKernel((const void*)fwd_megakernel, dim3(grid), dim3(NTHR), kargs, LDS_BYTES, stream);
    if (e != hipSuccess) fprintf(stderr, "kernel_launch: cooperative launch failed: %s (grid %d)\n", hipGetErrorString(e), grid);
}
```

```cpp
#include <hip/hip_runtime.h>
#include <hip/hip_cooperative_groups.h>
#include <cstdio>
#include <cstdint>
namespace cg = cooperative_groups;

namespace pg8 {
#define PG8_LAS __attribute__((address_space(3)))
typedef unsigned short bf16_t;
typedef short bf16x8 __attribute__((ext_vector_type(8)));
typedef float f32x4 __attribute__((ext_vector_type(4)));
typedef unsigned u32x4 __attribute__((ext_vector_type(4)));
constexpr int BM = 256, BK = 64, HALF = 128, HTB = HALF * BK * 2  , STAGE_BYTES = 8 * HTB, NXCD = 8, WGM = 8;

__host__ __device__ __forceinline__ int lds_byte(int r, int c) { const int st = (r >> 4) * 2 + (c >> 5), rr = r & 15, cc = c & 31, ob = rr * 64 + cc * 2; return st * 1024 + (ob ^ (((ob >> 9) & 1) << 5)); }
__host__ __device__ __forceinline__ void stage_rc(int b, int& R, int& C) { const int st = b / 1024, sb = b % 1024, swz = sb ^ (((sb >> 9) & 1) << 5); R = (st >> 1) * 16 + swz / 64; C = (st & 1) * 32 + (swz % 64) / 2; }
__host__ __device__ __forceinline__ int perm32(int rho) { const int n = rho >> 4, i = rho & 15; return 8 * (i >> 2) + 4 * n + (i & 3); }

struct Unit { int pm, pn; };
struct Gemm { const bf16_t* A; const bf16_t* Bt; int M, N, K; };

struct StaticOrder {
    int nM, nN, nwg, G, c;
    __host__ __device__ void init(int M, int N, int G_, int c_) { nM = M / BM; nN = N / BM; nwg = nM * nN; G = G_; c = c_; }
    __host__ __device__ bool next(int i, Unit& u) const {
        const long L = (long)i * G + c; if (L >= nwg) return false;
        int wgid = (int)L; { const int q = nwg / NXCD, r = nwg % NXCD, xcd = wgid % NXCD, off = wgid / NXCD; wgid = (xcd < r ? xcd * (q + 1) : r * (q + 1) + (xcd - r) * q) + off; }
        const int nig = WGM * nN, gid = wgid / nig, fm = gid * WGM, gsz = (nM - fm) < WGM ? (nM - fm) : WGM;
        u.pm = fm + ((wgid % nig) % gsz); u.pn = (wgid % nig) / gsz; return true;
    }
    __device__ __forceinline__ void a_ready(const Unit&) const {}
    __device__ __forceinline__ void done(const Unit&) const {}
};

__device__ __forceinline__ unsigned cvt_pk_bf16(float lo, float hi) { unsigned r; asm("v_cvt_pk_bf16_f32 %0, %1, %2" : "=v"(r) : "v"(lo), "v"(hi)); return r; }

template <class Epi, class Sched, bool ALIGN_EPI = false, bool SP2 = false>
__device__ __forceinline__ void gemm_phase(PG8_LAS unsigned char* lds, const Gemm g, const Sched& S, const Epi& E) {
    int tid_ = threadIdx.x; asm volatile("" : "+v"(tid_));
    const int tid = tid_, wid = __builtin_amdgcn_readfirstlane(tid >> 6), lane = tid & 63, wr = wid >> 2, wc = wid & 3, fr = lane & 15, fq = lane >> 4;
    const int K = g.K, nt = K / BK;
    unsigned voffA[2], voffB[2];
#pragma unroll
    for (int i = 0; i < 2; ++i) { int R, C; stage_rc(tid * 16 + i * 8192, R, C); const int Rb = Epi::PERM ? ((R & ~31) + perm32(R & 31)) : R;
        voffA[i] = (unsigned)(R * K + C) * 2u; voffB[i] = (unsigned)(Rb * K + C) * 2u; }
    const size_t kstep = (size_t)(BK * 2);
    const size_t hstep = (size_t)HALF * K * 2;
    const size_t tstep = 2 * hstep;
    const unsigned ldsw = (unsigned)wid * 1024u;
    const int aoff = lds_byte(wr * 64 + fr, fq * 8), boff = lds_byte(wc * 32 + fr, fq * 8);
#define PG8_SA(b, h) (((b) * 2 + (h)) * HTB)
#define PG8_SB(b, h) ((4 + (b) * 2 + (h)) * HTB)
#define PG8_STAGE(bufoff, gbase, voff) do { _Pragma("unroll") for (int _i = 0; _i < 2; ++_i) \
        __builtin_amdgcn_global_load_lds((const unsigned*)((const char*)(gbase) + (voff)[_i]), (PG8_LAS unsigned*)(lds + (bufoff) + ldsw + _i * 8192), 16, 0, 0); } while (0)
#define PG8_LDA(dst, b, h) do { _Pragma("unroll") for (int m = 0; m < 4; ++m) _Pragma("unroll") for (int k = 0; k < 2; ++k) dst[m][k] = *(const PG8_LAS bf16x8*)(lds + PG8_SA(b, h) + aoff + m * 2048 + k * 1024); } while (0)
#define PG8_LDB(dst, b, h) do { _Pragma("unroll") for (int n = 0; n < 2; ++n) _Pragma("unroll") for (int k = 0; k < 2; ++k) dst[n][k] = *(const PG8_LAS bf16x8*)(lds + PG8_SB(b, h) + boff + n * 2048 + k * 1024); } while (0)
#define PG8_MMA(ai, bj, At, Bt) do { __builtin_amdgcn_s_setprio(1); _Pragma("unroll") for (int m = 0; m < 4; ++m) _Pragma("unroll") for (int n = 0; n < 2; ++n) _Pragma("unroll") for (int k = 0; k < 2; ++k) \
        acc[ai][bj][m][n] = __builtin_amdgcn_mfma_f32_16x16x32_bf16(Bt[n][k], At[m][k], acc[ai][bj][m][n], 0, 0, 0); __builtin_amdgcn_s_setprio(0); } while (0)
#define PG8_WAIT_V(n) asm volatile("s_waitcnt vmcnt(" #n ")" ::: "memory")
#define PG8_WAIT_L(n) asm volatile("s_waitcnt lgkmcnt(" #n ")" ::: "memory")
#define PG8_BAR __builtin_amdgcn_s_barrier()
#define PG8_SCHED __builtin_amdgcn_sched_barrier(0)
    Unit cur, nxt; int ui = 0;
    if (!S.next(0, cur)) return;
    f32x4 acc[2][2][4][2];
#pragma unroll
    for (int a = 0; a < 2; ++a)
#pragma unroll
        for (int b = 0; b < 2; ++b)
#pragma unroll
            for (int m = 0; m < 4; ++m)
#pragma unroll
                for (int n = 0; n < 2; ++n) acc[a][b][m][n] = (f32x4){0.f, 0.f, 0.f, 0.f};
    bf16x8 At[4][2], B0[2][2], B1[2][2];
    const char* cA = (const char*)g.A + (size_t)cur.pm * tstep; const char* cB = (const char*)g.Bt + (size_t)cur.pn * tstep;
    S.a_ready(cur);
    if constexpr (SP2) {
        PG8_STAGE(PG8_SB(0, 0), cB, voffB); PG8_STAGE(PG8_SB(0, 1), cB + hstep, voffB); PG8_STAGE(PG8_SA(0, 0), cA, voffA); PG8_STAGE(PG8_SA(0, 1), cA + hstep, voffA);
        if (wr == 1) PG8_BAR;
        PG8_WAIT_V(2); PG8_BAR;
        PG8_STAGE(PG8_SB(1, 0), cB + kstep, voffB); PG8_STAGE(PG8_SA(1, 0), cA + kstep, voffA); PG8_STAGE(PG8_SB(1, 1), cB + hstep + kstep, voffB);
        PG8_WAIT_V(6); PG8_BAR;
    } else {
        PG8_STAGE(PG8_SB(0, 0), cB, voffB); PG8_STAGE(PG8_SA(0, 0), cA, voffA); PG8_STAGE(PG8_SB(0, 1), cB + hstep, voffB); PG8_STAGE(PG8_SA(0, 1), cA + hstep, voffA);
        if (wr == 1) PG8_BAR;
        PG8_WAIT_V(4); PG8_BAR;
        PG8_STAGE(PG8_SB(1, 0), cB + kstep, voffB); PG8_STAGE(PG8_SA(1, 0), cA + kstep, voffA); PG8_STAGE(PG8_SB(1, 1), cB + hstep + kstep, voffB);
        PG8_WAIT_V(6); PG8_BAR;
    }
    for (;;) {
        const bool has_next = S.next(ui + 1, nxt);
        const char* nA = has_next ? (const char*)g.A + (size_t)nxt.pm * tstep : cA; const char* nB = has_next ? (const char*)g.Bt + (size_t)nxt.pn * tstep : cB;
        for (int t = 0; t < nt; t += 2) {
            const bool last = (t == nt - 2);
            const char* a1 = cA + (size_t)(t + 1) * kstep;
            const char* a2 = last ? nA : cA + (size_t)(t + 2) * kstep; const char* b2 = last ? nB : cB + (size_t)(t + 2) * kstep;
            const char* a3 = a2 + kstep; const char* b3 = b2 + kstep;
            if (last && has_next) S.a_ready(nxt);
            if constexpr (SP2) {
            PG8_LDB(B0, 0, 0); PG8_LDB(B1, 0, 1); PG8_SCHED; PG8_LDA(At, 0, 0); PG8_STAGE(PG8_SA(1, 1), a1 + hstep, voffA);
            PG8_WAIT_V(8); PG8_WAIT_L(0); PG8_BAR; PG8_MMA(0, 0, At, B0); PG8_MMA(0, 1, At, B1); PG8_BAR; PG8_SCHED;
            PG8_LDA(At, 0, 1); PG8_STAGE(PG8_SB(0, 0), b2, voffB); PG8_STAGE(PG8_SB(0, 1), b2 + hstep, voffB); PG8_STAGE(PG8_SA(0, 0), a2, voffA);
            PG8_WAIT_V(8); PG8_WAIT_L(0); PG8_BAR; PG8_MMA(1, 0, At, B0); PG8_MMA(1, 1, At, B1); PG8_BAR; PG8_SCHED;
            PG8_LDB(B0, 1, 0); PG8_LDB(B1, 1, 1); PG8_SCHED; PG8_LDA(At, 1, 0); PG8_STAGE(PG8_SA(0, 1), a2 + hstep, voffA);
            PG8_WAIT_V(8); PG8_WAIT_L(0); PG8_BAR; PG8_MMA(0, 0, At, B0); PG8_MMA(0, 1, At, B1); PG8_BAR; PG8_SCHED;
            PG8_LDA(At, 1, 1); PG8_STAGE(PG8_SB(1, 0), b3, voffB); PG8_STAGE(PG8_SB(1, 1), b3 + hstep, voffB); PG8_STAGE(PG8_SA(1, 0), a3, voffA);
            PG8_WAIT_V(8); PG8_WAIT_L(0); PG8_BAR; PG8_MMA(1, 0, At, B0); PG8_MMA(1, 1, At, B1); PG8_BAR; PG8_SCHED;
            } else {
            PG8_LDB(B0, 0, 0); PG8_SCHED; PG8_LDA(At, 0, 0); PG8_STAGE(PG8_SA(1, 1), a1 + hstep, voffA);
            PG8_WAIT_L(8); PG8_BAR; PG8_WAIT_L(0); PG8_MMA(0, 0, At, B0); PG8_BAR; PG8_SCHED;
            PG8_LDB(B1, 0, 1); PG8_STAGE(PG8_SB(0, 0), b2, voffB);
            PG8_BAR; PG8_WAIT_L(0); PG8_MMA(0, 1, At, B1); PG8_BAR;
            PG8_LDA(At, 0, 1); PG8_STAGE(PG8_SA(0, 0), a2, voffA);
            PG8_BAR; PG8_WAIT_L(0); PG8_MMA(1, 0, At, B0); PG8_BAR; PG8_SCHED;
            PG8_STAGE(PG8_SB(0, 1), b2 + hstep, voffB);
            PG8_WAIT_V(6); PG8_BAR; PG8_MMA(1, 1, At, B1); PG8_BAR;
            PG8_LDB(B0, 1, 0); PG8_SCHED; PG8_LDA(At, 1, 0); PG8_STAGE(PG8_SA(0, 1), a2 + hstep, voffA);
            PG8_WAIT_L(8); PG8_BAR; PG8_WAIT_L(0); PG8_MMA(0, 0, At, B0); PG8_BAR; PG8_SCHED;
            PG8_LDB(B1, 1, 1); PG8_STAGE(PG8_SB(1, 0), b3, voffB);
            PG8_BAR; PG8_WAIT_L(0); PG8_MMA(0, 1, At, B1); PG8_BAR;
            PG8_LDA(At, 1, 1); PG8_STAGE(PG8_SA(1, 0), a3, voffA);
            PG8_BAR; PG8_WAIT_L(0); PG8_MMA(1, 0, At, B0); PG8_BAR; PG8_SCHED;
            PG8_STAGE(PG8_SB(1, 1), b3 + hstep, voffB);
            PG8_WAIT_V(6); PG8_BAR; PG8_MMA(1, 1, At, B1); PG8_BAR;
            }
        }
        if constexpr (ALIGN_EPI) { if (wr == 0) PG8_BAR; }
        E(acc, cur, wr, wc, fr, fq); S.done(cur);
        if (!has_next) break;
#pragma unroll
        for (int a = 0; a < 2; ++a)
#pragma unroll
            for (int b = 0; b < 2; ++b)
#pragma unroll
                for (int m = 0; m < 4; ++m)
#pragma unroll
                    for (int n = 0; n < 2; ++n) acc[a][b][m][n] = (f32x4){0.f, 0.f, 0.f, 0.f};
        cur = nxt; cA = nA; cB = nB; ++ui;
        if constexpr (ALIGN_EPI) { if (wr == 1) PG8_BAR; }
    }
    PG8_WAIT_V(0);
    if constexpr (!ALIGN_EPI) { if (wr == 0) PG8_BAR; }
    PG8_BAR;
#undef PG8_SA
#undef PG8_SB
#undef PG8_STAGE
#undef PG8_LDA
#undef PG8_LDB
#undef PG8_MMA
#undef PG8_WAIT_V
#undef PG8_WAIT_L
#undef PG8_BAR
#undef PG8_SCHED
}
}

constexpr int NWAVES = 8, NTHR = 512;
constexpr int M = 24576, MP = 16384, DM = 2048, NIN = 3584, DFF = 5632;
constexpr int COL_K = 1024, COL_V = 1280, COL_U = 1536, COL_GV = 2560;
constexpr int NGC = 192;
constexpr float LN_EPS = 1e-5f;
constexpr float ALPHA = 1.189207115002721f;
constexpr float LOG2E = 1.4426950408889634f;

constexpr size_t MiB = 1u << 20;
constexpr size_t WS_WSB = 0, WS_GST = 512 * 1024;
constexpr size_t WS_WIN = 1 * MiB, WS_WO = 15 * MiB, WS_W13 = 23 * MiB, WS_W2 = 67 * MiB, WS_ST1 = 89 * MiB;
constexpr size_t WS_XB = 90 * MiB;
constexpr size_t WS_H = 186 * MiB;
constexpr size_t WS_MIX = 354 * MiB;
constexpr size_t WS_HID = 186 * MiB;
constexpr size_t WS_END = 450 * MiB;
static_assert(WS_H + (size_t)M * NIN * 2 == WS_MIX && WS_MIX + (size_t)M * DM * 2 == WS_END && WS_HID + (size_t)M * DFF * 2 == WS_END, "ws map");

constexpr int LDS_BYTES = 131072 + 4096;

#define GAS __attribute__((address_space(1)))
#define LAS __attribute__((address_space(3)))
typedef unsigned short bf16;
typedef unsigned v4u __attribute__((ext_vector_type(4)));
typedef unsigned v2u __attribute__((ext_vector_type(2)));
typedef float f32x4 __attribute__((ext_vector_type(4)));
typedef float f32x2 __attribute__((ext_vector_type(2)));
typedef short bf16x8 __attribute__((ext_vector_type(8)));
using pg8::cvt_pk_bf16;
#define LDS_WAIT() asm volatile("s_waitcnt lgkmcnt(0)" ::: "memory")
__device__ __forceinline__ float bf_lo(unsigned w) { return __uint_as_float(w << 16); }
__device__ __forceinline__ float bf_hi(unsigned w) { return __uint_as_float(w & 0xffff0000u); }
__device__ __forceinline__ float wave_sum(float v) {
#pragma unroll
    for (int o = 1; o < 64; o <<= 1) v += __shfl_xor(v, o);
    return v;
}
__device__ __forceinline__ float gelu_tanh(float x) {
    const float t = x * (-2.3022082f + (-0.10294324f) * x * x);
    return x * __builtin_amdgcn_rcpf(1.0f + __builtin_amdgcn_exp2f(t));
}
__device__ __forceinline__ float silu_f(float x) { return x * __builtin_amdgcn_rcpf(1.0f + __builtin_amdgcn_exp2f(-LOG2E * x)); }

struct EpiH {
    static constexpr bool PERM = true;
    bf16* O; float* gst;
    __device__ __forceinline__ void operator()(const f32x4 (&acc)[2][2][4][2], const pg8::Unit& u, int wr, int wc, int fr, int fq) const {
        const int row0 = u.pm * 256 + wr * 64 + fr, col0 = u.pn * 256 + wc * 32 + 8 * fq;
        const bool act = u.pn >= 6, stat = u.pn >= 10;
#pragma unroll
        for (int ai = 0; ai < 2; ++ai)
#pragma unroll
            for (int m = 0; m < 4; ++m) { bf16* rowp = O + (size_t)(row0 + ai * 128 + m * 16) * NIN + col0;
                float rs = 0.f, rq = 0.f;
#pragma unroll
                for (int bj = 0; bj < 2; ++bj) { f32x4 v0 = acc[ai][bj][m][0], v1 = acc[ai][bj][m][1];
                    if (act) {
#pragma unroll
                        for (int i = 0; i < 4; ++i) { v0[i] = gelu_tanh(v0[i]); v1[i] = gelu_tanh(v1[i]); } }
                    v4u w; w.x = cvt_pk_bf16(v0[0], v0[1]); w.y = cvt_pk_bf16(v0[2], v0[3]); w.z = cvt_pk_bf16(v1[0], v1[1]); w.w = cvt_pk_bf16(v1[2], v1[3]);
                    *(v4u*)(rowp + bj * 128) = w;
                    if (stat) {
#pragma unroll
                        for (int t = 0; t < 4; ++t) { const float a = bf_lo(w[t]), b = bf_hi(w[t]); rs += a + b; rq += a * a + b * b; } } }
                if (stat) { rs += __shfl_xor(rs, 16); rs += __shfl_xor(rs, 32); rq += __shfl_xor(rq, 16); rq += __shfl_xor(rq, 32);
                    if (fq == 0) { float* gp = gst + 2 * (size_t)(row0 + ai * 128 + m * 16); unsafeAtomicAdd(gp, rs); unsafeAtomicAdd(gp + 1, rq); } } }
    }
};
struct EpiY1 {
    static constexpr bool PERM = false;
    const float* xp; const float* xs; float* Y;
    __device__ __forceinline__ void operator()(const f32x4 (&acc)[2][2][4][2], const pg8::Unit& u, int wr, int wc, int fr, int fq) const {
        const int row0 = u.pm * 256 + wr * 64 + fr, col0 = u.pn * 256 + wc * 32 + 4 * fq;
        const float* xb = (u.pm < MP / 256) ? xp : xs - (size_t)MP * DM;
#pragma unroll
        for (int ai = 0; ai < 2; ++ai)
#pragma unroll
            for (int m = 0; m < 4; ++m) { const size_t off = (size_t)(row0 + ai * 128 + m * 16) * DM + col0;
#pragma unroll
                for (int bj = 0; bj < 2; ++bj)
#pragma unroll
                    for (int n = 0; n < 2; ++n) { const f32x4 xv = *(const f32x4*)(xb + off + bj * 128 + n * 16);
                        *(f32x4*)(Y + off + bj * 128 + n * 16) = xv * ALPHA + acc[ai][bj][m][n]; } }
    }
};
struct EpiHid {
    static constexpr bool PERM = true;
    bf16* O;
    __device__ __forceinline__ void operator()(const f32x4 (&acc)[2][2][4][2], const pg8::Unit& u, int wr, int wc, int fr, int fq) const {
        const int row0 = u.pm * 256 + wr * 64 + fr, col0 = u.pn * 128 + wc * 32 + 8 * fq;
#pragma unroll
        for (int ai = 0; ai < 2; ++ai)
#pragma unroll
            for (int m = 0; m < 4; ++m) {
                const f32x4 g0 = acc[ai][0][m][0], g1 = acc[ai][0][m][1], u0 = acc[ai][1][m][0], u1 = acc[ai][1][m][1];
                float h[8];
#pragma unroll
                for (int i = 0; i < 4; ++i) { h[i] = silu_f(g0[i]) * u0[i]; h[4 + i] = silu_f(g1[i]) * u1[i]; }
                v4u w; w.x = cvt_pk_bf16(h[0], h[1]); w.y = cvt_pk_bf16(h[2], h[3]); w.z = cvt_pk_bf16(h[4], h[5]); w.w = cvt_pk_bf16(h[6], h[7]);
                *(v4u*)(O + (size_t)(row0 + ai * 128 + m * 16) * DFF + col0) = w; }
    }
};
struct EpiY2 {
    static constexpr bool PERM = false;
    float* Y; const float* st1; const float* g1; const float* b1;
    __device__ __forceinline__ void operator()(const f32x4 (&acc)[2][2][4][2], const pg8::Unit& u, int wr, int wc, int fr, int fq) const {
        const int row0 = u.pm * 256 + wr * 64 + fr, col0 = u.pn * 256 + wc * 32 + 4 * fq;
        f32x4 gv[2][2], bv[2][2];
#pragma unroll
        for (int bj = 0; bj < 2; ++bj)
#pragma unroll
            for (int n = 0; n < 2; ++n) { gv[bj][n] = *(const f32x4*)(g1 + col0 + bj * 128 + n * 16) * ALPHA; bv[bj][n] = *(const f32x4*)(b1 + col0 + bj * 128 + n * 16) * ALPHA; }
#pragma unroll
        for (int ai = 0; ai < 2; ++ai)
#pragma unroll
            for (int m = 0; m < 4; ++m) { const int r = row0 + ai * 128 + m * 16; const size_t off = (size_t)r * DM + col0;
                const f32x2 st = *(const f32x2*)(st1 + 2 * r);
#pragma unroll
                for (int bj = 0; bj < 2; ++bj)
#pragma unroll
                    for (int n = 0; n < 2; ++n) { const f32x4 yv = *(const f32x4*)(Y + off + bj * 128 + n * 16);
                        *(f32x4*)(Y + off + bj * 128 + n * 16) = ((yv - st.x) * st.y) * gv[bj][n] + bv[bj][n] + acc[ai][bj][m][n]; } }
    }
};

__device__ __forceinline__ void p0_transpose_item(const float* W, int K, int N, bf16* WT, int drow0, int k0, int n0, LAS float* scr, int lane) {
#pragma unroll 8
    for (int i = 0; i < 32; ++i) { const int kk = 2 * i + (lane >> 5); scr[kk * 33 + (lane & 31)] = W[(size_t)(k0 + kk) * N + n0 + (lane & 31)]; }
    LDS_WAIT(); asm volatile("" ::: "memory");
    const int c = lane & 7;
#pragma unroll
    for (int j = 0; j < 4; ++j) { const int n = (lane >> 3) + 8 * j; const LAS float* s = scr + (8 * c) * 33 + n;
        v4u o; o.x = cvt_pk_bf16(s[0 * 33], s[1 * 33]); o.y = cvt_pk_bf16(s[2 * 33], s[3 * 33]); o.z = cvt_pk_bf16(s[4 * 33], s[5 * 33]); o.w = cvt_pk_bf16(s[6 * 33], s[7 * 33]);
        *(v4u*)(WT + (size_t)(drow0 + n) * K + k0 + 8 * c) = o; }
    LDS_WAIT(); asm volatile("" ::: "memory");
}

struct Args { const float* in[16]; float* out; unsigned char* ws; };

template <bool FINAL>
__device__ __forceinline__ void ln_rows(const float* src, float* dstf, bf16* dstb, float* stats, const float* g, const float* b, int gw, int NGW, int lane) {
    f32x4 gg[8], bb[8];
#pragma unroll
    for (int j = 0; j < 8; ++j) { gg[j] = ((const f32x4*)g)[lane + 64 * j]; bb[j] = ((const f32x4*)b)[lane + 64 * j]; }
    for (int m = gw; m < M; m += NGW) {
        const f32x4* xr = (const f32x4*)(src + (size_t)m * DM) + lane;
        f32x4 v[8]; float s = 0.f;
#pragma unroll
        for (int j = 0; j < 8; ++j) { v[j] = xr[64 * j]; s += (v[j].x + v[j].y) + (v[j].z + v[j].w); }
        const float mean = wave_sum(s) * (1.f / DM); float s2 = 0.f;
#pragma unroll
        for (int j = 0; j < 8; ++j) { v[j] = v[j] - mean; s2 += (v[j].x * v[j].x + v[j].y * v[j].y) + (v[j].z * v[j].z + v[j].w * v[j].w); }
        const float rstd = 1.f / sqrtf(wave_sum(s2) * (1.f / DM) + LN_EPS);
        if (FINAL) {
            f32x4* o = (f32x4*)(dstf + (size_t)m * DM) + lane;
#pragma unroll
            for (int j = 0; j < 8; ++j) o[64 * j] = (v[j] * rstd) * gg[j] + bb[j];
        } else {
            v2u* o = (v2u*)(dstb + (size_t)m * DM) + lane;
#pragma unroll
            for (int j = 0; j < 8; ++j) { const f32x4 y = (v[j] * rstd) * gg[j] + bb[j]; v2u w; w.x = cvt_pk_bf16(y.x, y.y); w.y = cvt_pk_bf16(y.z, y.w); o[64 * j] = w; }
            if (lane == 0) { stats[2 * m] = mean; stats[2 * m + 1] = rstd; }
        }
    }
}

constexpr int VT_PITCH = 784;
__device__ __forceinline__ void attn_head_scores(const LAS unsigned char* kbase, const bf16x8 (&qf)[4], int swz, int p0, float rel0f, float nslope2, float sink2, float pen0, float pen2, v4u (&pf)[9], float& inv) {
    f32x4 S[18];
#pragma unroll
    for (int j = 0; j < 18; ++j) {
        S[j] = (f32x4){0.f, 0.f, 0.f, 0.f};
#pragma unroll
        for (int ks = 0; ks < 4; ++ks) { const bf16x8 kf = *(const LAS bf16x8*)(kbase + (j >> 1) * 8192 + (j & 1) * 1024 + (((4 * ks) ^ swz) << 4));
            S[j] = __builtin_amdgcn_mfma_f32_16x16x32_bf16(kf, qf[ks], S[j], 0, 0, 0); }
        if (j & 1) __builtin_amdgcn_sched_barrier(0);
    }
    const float sc2 = 0.08838834764831845f * LOG2E;
    float mx = sink2;
    asm volatile("" : "+v"(rel0f));
#pragma unroll
    for (int t = 0; t < 9; ++t) { const int p = p0 + t; const float pen = p < 4 ? pen0 : (p >= 8 ? pen2 : 0.f);
#pragma unroll
        for (int e = 0; e < 2; ++e)
#pragma unroll
            for (int i = 0; i < 4; ++i) { const float relf = rel0f + (float)(32 * t + 4 * e + i);
                float sv = __builtin_fmaf(S[2 * t + e][i], sc2, __builtin_fmaf(__builtin_fabsf(relf), nslope2, pen));
                if (t == 0 || t == 8) sv = (__builtin_fabsf(relf) > 128.f) ? -1e30f : sv;
                S[2 * t + e][i] = sv; mx = fmaxf(mx, sv); } }
    mx = fmaxf(mx, __shfl_xor(mx, 16)); mx = fmaxf(mx, __shfl_xor(mx, 32));
    float sum = 0.f;
#pragma unroll
    for (int j = 0; j < 18; ++j)
#pragma unroll
        for (int i = 0; i < 4; ++i) { const float p = __builtin_amdgcn_exp2f(S[j][i] - mx); S[j][i] = p; sum += p; }
    sum += __shfl_xor(sum, 16); sum += __shfl_xor(sum, 32);
    inv = 1.0f / (sum + __builtin_amdgcn_exp2f(sink2 - mx));
#pragma unroll
    for (int t = 0; t < 9; ++t) { pf[t].x = cvt_pk_bf16(S[2 * t][0], S[2 * t][1]); pf[t].y = cvt_pk_bf16(S[2 * t][2], S[2 * t][3]);
        pf[t].z = cvt_pk_bf16(S[2 * t + 1][0], S[2 * t + 1][1]); pf[t].w = cvt_pk_bf16(S[2 * t + 1][2], S[2 * t + 1][3]); }
}
__device__ __forceinline__ void attn_head_pv(const LAS unsigned char* vbase, const v4u (&pf)[9], float inv, bf16* Og) {
#pragma unroll
    for (int dt = 0; dt < 8; ++dt) {
        f32x4 o = (f32x4){0.f, 0.f, 0.f, 0.f};
#pragma unroll
        for (int t = 0; t < 9; ++t) { const bf16x8 vf = *(const LAS bf16x8*)(vbase + 16 * dt * VT_PITCH + 64 * t);
            o = __builtin_amdgcn_mfma_f32_16x16x32_bf16(vf, __builtin_bit_cast(bf16x8, pf[t]), o, 0, 0, 0); }
        v2u w; w.x = cvt_pk_bf16(o[0] * inv, o[1] * inv); w.y = cvt_pk_bf16(o[2] * inv, o[3] * inv);
        *(v2u*)(Og + 16 * dt) = w;
        __builtin_amdgcn_sched_barrier(0);
    }
}
__device__ __forceinline__ void vt_write(LAS unsigned char* lds, const v4u (&in)[8], int dblk, int key0) {
#pragma unroll
    for (int i = 0; i < 8; ++i) { v4u o;
#pragma unroll
        for (int t = 0; t < 4; ++t) { const unsigned a = in[2 * t][i >> 1], b = in[2 * t + 1][i >> 1];
            o[t] = (i & 1) ? ((a >> 16) | (b & 0xffff0000u)) : ((a & 0xffffu) | (b << 16)); }
        *(LAS v4u*)(lds + (8 * dblk + i) * VT_PITCH + key0 * 2) = o; }
}
__device__ __forceinline__ void attn_unit(LAS unsigned char* lds, const bf16* H, bf16* MIX, const float* sink, int gc, int kv, int hp) {
    int tid_ = threadIdx.x; asm volatile("" : "+v"(tid_));
    const int tid = tid_, lane = tid & 63, wave = __builtin_amdgcn_readfirstlane(tid >> 6);
    const int c = gc & 15, fr = lane & 15, fq = lane >> 4, hA = 4 * kv + 2 * hp, hB = hA + 1;
    const int rowq0 = gc * 128, roww0 = rowq0 - 128;
    const bool v0 = (c != 0), v2 = (c != 15);
    const int p0 = wave >> 1;
    __syncthreads();
    {
        const bf16* Kg = H + COL_K + 128 * kv;
#pragma unroll
        for (int it = 0; it < 12; ++it) { const int ch = tid + it * NTHR, row = ch >> 4, cc = ch & 15, kb = row >> 7;
            const int grow = roww0 + row + ((kb == 0 && !v0) ? 128 : 0) - ((kb == 2 && !v2) ? 128 : 0);
            const v4u v = *(const v4u*)(Kg + (size_t)grow * NIN + cc * 8);
            const int g = (((row >> 3) & 3) << 2) | (row & 3);
            *(LAS v4u*)(lds + row * 256 + ((cc ^ g) << 4)) = v; }
    }
    bf16x8 qfA[4], qfB[4];
    { const bf16* Qg = H + (size_t)(rowq0 + 16 * wave + fr) * NIN + 128 * hA + 8 * fq;
#pragma unroll
      for (int ks = 0; ks < 4; ++ks) { qfA[ks] = *(const bf16x8*)(Qg + 32 * ks); qfB[ks] = *(const bf16x8*)(Qg + 128 + 32 * ks); } }
    const int r = tid & 255, sblk = r >> 4, dblk = r & 15;
    v4u vin0[8], vin1[8];
    { const bf16* Vg = H + COL_V + 128 * kv + 8 * dblk;
      const int kb = tid >> 8, key0 = 128 * kb + 8 * sblk, grow = roww0 + key0 + ((kb == 0 && !v0) ? 128 : 0);
#pragma unroll
      for (int jj = 0; jj < 8; ++jj) vin0[jj] = *(const v4u*)(Vg + (size_t)(grow + jj) * NIN);
      if (wave < 4) { const int grow2 = roww0 + 256 + 8 * sblk - (v2 ? 0 : 128);
#pragma unroll
          for (int jj = 0; jj < 8; ++jj) vin1[jj] = *(const v4u*)(Vg + (size_t)(grow2 + jj) * NIN); } }
    __syncthreads();
    const int qi = 16 * wave + fr;
    float rel0f = (float)(32 * p0 + 8 * fq - 128 - qi);
    asm volatile("" : "+v"(rel0f));
    const float pen0 = v0 ? 0.f : -1e30f, pen2 = v2 ? 0.f : -1e30f;
    const LAS unsigned char* kbase = lds + (32 * p0 + 8 * (fr >> 2) + (fr & 3)) * 256;
    const int swz = fq ^ fr;
    v4u pfA[9], pfB[9]; float invA, invB;
    attn_head_scores(kbase, qfA, swz, p0, rel0f, -__builtin_amdgcn_exp2f(-(float)(hA + 1)) * LOG2E, sink[hA] * LOG2E, pen0, pen2, pfA, invA);
    attn_head_scores(kbase, qfB, swz, p0, rel0f, -__builtin_amdgcn_exp2f(-(float)(hB + 1)) * LOG2E, sink[hB] * LOG2E, pen0, pen2, pfB, invB);
    __syncthreads();
    vt_write(lds, vin0, dblk, 128 * (tid >> 8) + 8 * sblk);
    if (wave < 4) vt_write(lds, vin1, dblk, 256 + 8 * sblk);
    __syncthreads();
    const LAS unsigned char* vbase = lds + fr * VT_PITCH + 64 * p0 + 16 * fq;
    bf16* Og = MIX + (size_t)(rowq0 + 16 * wave + fr) * DM + 128 * hA + 4 * fq;
    attn_head_pv(vbase, pfA, invA, Og);
    attn_head_pv(vbase, pfB, invB, Og + 128);
}

constexpr int GT_PITCH = 272, GT_BYTES = 128 * GT_PITCH;
__device__ __forceinline__ void sgu_pair(LAS unsigned char* lds, const bf16* H, bf16* MIX, const float* lng, const float* lnb, const bf16* wsb, const float* b_s, const float* gst, int gc, int gp) {
    int tid_ = threadIdx.x; asm volatile("" : "+v"(tid_));
    const int tid = tid_, lane = tid & 63, wave = __builtin_amdgcn_readfirstlane(tid >> 6);
    const int r0 = gc * 128, fr = lane & 15, fq = lane >> 4;
    __syncthreads();
    { const int gsel = tid >> 8, r = tid & 255, sblk = r >> 4, dblk = r & 15, g = 2 * gp + gsel, ch0 = 128 * g + 8 * dblk;
      const f32x4 ga = *(const f32x4*)(lng + ch0), gb = *(const f32x4*)(lng + ch0 + 4), ba = *(const f32x4*)(lnb + ch0), bb = *(const f32x4*)(lnb + ch0 + 4);
      const float gam[8] = {ga.x, ga.y, ga.z, ga.w, gb.x, gb.y, gb.z, gb.w}, bet[8] = {ba.x, ba.y, ba.z, ba.w, bb.x, bb.y, bb.z, bb.w};
      v4u in[8]; f32x2 st[8];
#pragma unroll
      for (int jj = 0; jj < 8; ++jj) { in[jj] = *(const v4u*)(H + (size_t)(r0 + 8 * sblk + jj) * NIN + COL_GV + ch0); st[jj] = *(const f32x2*)(gst + 2 * (size_t)(r0 + 8 * sblk + jj)); }
#pragma unroll
      for (int jj = 0; jj < 8; ++jj) { const float mean = st[jj].x * (1.f / 1024.f), var = fmaxf(st[jj].y * (1.f / 1024.f) - mean * mean, 0.f); st[jj].x = mean; st[jj].y = 1.f / sqrtf(var + LN_EPS); }
#pragma unroll
      for (int i = 0; i < 8; ++i) { v4u o;
#pragma unroll
          for (int t = 0; t < 4; ++t) { const unsigned a = in[2 * t][i >> 1], b = in[2 * t + 1][i >> 1];
              const float xa = (i & 1) ? bf_hi(a) : bf_lo(a), xb = (i & 1) ? bf_hi(b) : bf_lo(b);
              o[t] = cvt_pk_bf16((xa - st[2 * t].x) * st[2 * t].y * gam[i] + bet[i], (xb - st[2 * t + 1].x) * st[2 * t + 1].y * gam[i] + bet[i]); }
          *(LAS v4u*)(lds + gsel * GT_BYTES + (8 * dblk + i) * GT_PITCH + 16 * sblk) = o; } }
    const int gsel = wave >> 2, tq = wave & 3, g = 2 * gp + gsel;
    bf16x8 wf[2][4];
#pragma unroll
    for (int tt = 0; tt < 2; ++tt)
#pragma unroll
        for (int ks = 0; ks < 4; ++ks) wf[tt][ks] = *(const bf16x8*)(wsb + (size_t)(g * 128 + 32 * tq + 16 * tt + fr) * 128 + 32 * ks + 8 * fq);
    __syncthreads();
    const LAS unsigned char* Gb = lds + gsel * GT_BYTES + fr * GT_PITCH + 16 * fq;
    const float bias0 = b_s[g * 128 + 32 * tq + fr], bias1 = b_s[g * 128 + 32 * tq + 16 + fr];
#pragma unroll
    for (int dt = 0; dt < 8; ++dt) {
        f32x4 a0 = (f32x4){0.f, 0.f, 0.f, 0.f}, a1 = a0;
#pragma unroll
        for (int ks = 0; ks < 4; ++ks) { const bf16x8 gf = *(const LAS bf16x8*)(Gb + 16 * dt * GT_PITCH + 64 * ks);
            a0 = __builtin_amdgcn_mfma_f32_16x16x32_bf16(gf, wf[0][ks], a0, 0, 0, 0);
            a1 = __builtin_amdgcn_mfma_f32_16x16x32_bf16(gf, wf[1][ks], a1, 0, 0, 0); }
#pragma unroll
        for (int tt = 0; tt < 2; ++tt) { const int t = 32 * tq + 16 * tt + fr; const float bias = tt ? bias1 : bias0; const f32x4 a = tt ? a1 : a0;
            const v2u uu = *(const v2u*)(H + (size_t)(r0 + t) * NIN + COL_U + 128 * g + 16 * dt + 4 * fq);
            v2u w; w.x = cvt_pk_bf16(bf_lo(uu.x) * (a[0] + bias), bf_hi(uu.x) * (a[1] + bias)); w.y = cvt_pk_bf16(bf_lo(uu.y) * (a[2] + bias), bf_hi(uu.y) * (a[3] + bias));
            *(v2u*)(MIX + (size_t)(r0 + t) * DM + 1024 + 128 * g + 16 * dt + 4 * fq) = w; }
    }
}

#ifndef PH_MASK
#define PH_MASK 0xff
#endif
#ifndef DUP_MASK
#define DUP_MASK 0
#endif
#define REP(k) for (int rep_ = 0; rep_ < (((DUP_MASK >> (k)) & 1) ? 2 : 1); ++rep_, (rep_ < (((DUP_MASK >> (k)) & 1) ? 2 : 1) ? grid.sync() : (void)0))
__global__ void __launch_bounds__(NTHR, 2) fwd_megakernel(Args args) {
    extern __shared__ __attribute__((aligned(16))) unsigned char lds_raw[];
    cg::grid_group grid = cg::this_grid();
    LAS unsigned char* lds = (LAS unsigned char*)lds_raw;
    const int tid = threadIdx.x, lane = tid & 63, wave = __builtin_amdgcn_readfirstlane(tid >> 6);
    const int G = gridDim.x, bx = blockIdx.x;
    const int vcu = (G % 8 == 0) ? (bx % 8) * (G / 8) + bx / 8 : bx;
    unsigned char* ws = args.ws;
    const float* xp = args.in[0]; const float* xs = args.in[1];
    const float* w_in = args.in[2]; const float* ln_sgu_g = args.in[3]; const float* ln_sgu_b = args.in[4]; const float* w_s = args.in[5]; const float* b_s = args.in[6];
    const float* sink = args.in[7]; const float* w_o = args.in[8]; const float* ln1_g = args.in[9]; const float* ln1_b = args.in[10];
    const float* w_gate = args.in[11]; const float* w_up = args.in[12]; const float* w_down = args.in[13]; const float* ln2_g = args.in[14]; const float* ln2_b = args.in[15];
    float* out = args.out;
    bf16* WIN_T = (bf16*)(ws + WS_WIN); bf16* WO_T = (bf16*)(ws + WS_WO); bf16* W13_T = (bf16*)(ws + WS_W13); bf16* W2_T = (bf16*)(ws + WS_W2);
    float* ST1 = (float*)(ws + WS_ST1); float* GST = (float*)(ws + WS_GST); bf16* WSB = (bf16*)(ws + WS_WSB);
    bf16* XB = (bf16*)(ws + WS_XB); bf16* Hb = (bf16*)(ws + WS_H); bf16* MIX = (bf16*)(ws + WS_MIX); bf16* HID = (bf16*)(ws + WS_HID);
    const int gw = vcu * NWAVES + wave, NGW = G * NWAVES;

    REP(0) if constexpr ((PH_MASK & 1) != 0) {
        LAS float* scr = (LAS float*)(lds + wave * 16384);
        constexpr int I_IN = (DM / 64) * (NIN / 32), I_O = (DM / 64) * (DM / 32), I_G = (DM / 64) * (DFF / 32), I_D = (DFF / 64) * (DM / 32);
        constexpr int NITEMS = I_IN + I_O + 2 * I_G + I_D;
        for (int it = gw; it < NITEMS; it += NGW) {
            int r = it;
            if (r < I_IN) { const int nb = r % (NIN / 32), kb = r / (NIN / 32); p0_transpose_item(w_in, DM, NIN, WIN_T, 32 * nb, 64 * kb, 32 * nb, scr, lane); continue; } r -= I_IN;
            if (r < I_O) { const int nb = r % (DM / 32), kb = r / (DM / 32); p0_transpose_item(w_o, DM, DM, WO_T, 32 * nb, 64 * kb, 32 * nb, scr, lane); continue; } r -= I_O;
            if (r < 2 * I_G) { const int up = r >= I_G ? 1 : 0; if (up) r -= I_G; const int nb = r % (DFF / 32), kb = r / (DFF / 32), n0 = 32 * nb;
                p0_transpose_item(up ? w_up : w_gate, DM, DFF, W13_T, (n0 >> 7) * 256 + up * 128 + (n0 & 127), 64 * kb, n0, scr, lane); continue; } r -= 2 * I_G;
            { const int nb = r % (DM / 32), kb = r / (DM / 32); p0_transpose_item(w_down, DFF, DM, W2_T, 32 * nb, 64 * kb, 32 * nb, scr, lane); }
        }
        { const int gt = bx * NTHR + tid;
          if (gt < M * 2 / 4) ((f32x4*)GST)[gt] = (f32x4){0.f, 0.f, 0.f, 0.f};
          if (gt < 8 * 128 * 128 / 8) { const f32x4 a = *(const f32x4*)(w_s + 8 * gt), b = *(const f32x4*)(w_s + 8 * gt + 4);
              v4u w; w.x = cvt_pk_bf16(a.x, a.y); w.y = cvt_pk_bf16(a.z, a.w); w.z = cvt_pk_bf16(b.x, b.y); w.w = cvt_pk_bf16(b.z, b.w); *(v4u*)(WSB + 8 * gt) = w; } }
        const size_t n8 = (size_t)M * DM / 8, nthr = (size_t)G * NTHR;
        for (size_t i = (size_t)bx * NTHR + tid; i < n8; i += nthr) { const size_t e = i * 8;
            const float* src = (e < (size_t)MP * DM) ? xp + e : xs + (e - (size_t)MP * DM);
            const f32x4 a = *(const f32x4*)src, b = *(const f32x4*)(src + 4);
            v4u w; w.x = cvt_pk_bf16(a.x, a.y); w.y = cvt_pk_bf16(a.z, a.w); w.z = cvt_pk_bf16(b.x, b.y); w.w = cvt_pk_bf16(b.z, b.w);
            *(v4u*)(XB + e) = w; }
    }
    grid.sync();
    REP(1) if constexpr ((PH_MASK & 2) != 0) { pg8::Gemm g{XB, WIN_T, M, NIN, DM}; pg8::StaticOrder S; S.init(M, NIN, G, bx); EpiH E{Hb, GST};
      pg8::gemm_phase<EpiH, pg8::StaticOrder, true, true>(lds, g, S, E); }
    grid.sync();
    REP(2) if constexpr ((PH_MASK & 4) != 0) {
      for (int it = vcu; it < NGC * 8; it += G) {
#ifndef NO_ATTN
        if (it < NGC * 4) attn_unit(lds, Hb, MIX, sink, it >> 2, (it >> 1) & 1, it & 1);
#endif
#ifndef NO_SGU
        if (it >= NGC * 4) { const int a = it - NGC * 4; sgu_pair(lds, Hb, MIX, ln_sgu_g, ln_sgu_b, WSB, b_s, GST, a >> 2, a & 3); }
#endif
    } }
    grid.sync();
    REP(3) if constexpr ((PH_MASK & 8) != 0) { pg8::Gemm g{MIX, WO_T, M, DM, DM}; pg8::StaticOrder S; S.init(M, DM, G, bx); EpiY1 E{xp, xs, out};
      pg8::gemm_phase<EpiY1, pg8::StaticOrder, true, true>(lds, g, S, E); }
    grid.sync();
    REP(4) if constexpr ((PH_MASK & 16) != 0) ln_rows<false>(out, nullptr, XB, ST1, ln1_g, ln1_b, gw, NGW, lane);
    grid.sync();
    REP(5) if constexpr ((PH_MASK & 32) != 0) { pg8::Gemm g{XB, W13_T, M, 2 * DFF, DM}; pg8::StaticOrder S; S.init(M, 2 * DFF, G, bx); EpiHid E{HID};
      pg8::gemm_phase<EpiHid, pg8::StaticOrder, true, true>(lds, g, S, E); }
    grid.sync();
    if constexpr ((PH_MASK & 64) != 0) { pg8::Gemm g{HID, W2_T, M, DM, DFF}; pg8::StaticOrder S; S.init(M, DM, G, bx); EpiY2 E{out, ST1, ln1_g, ln1_b};
      pg8::gemm_phase<EpiY2, pg8::StaticOrder, true, true>(lds, g, S, E); }
    grid.sync();
    if constexpr ((PH_MASK & 128) != 0) ln_rows<true>(out, out, nullptr, nullptr, ln2_g, ln2_b, gw, NGW, lane);
}

extern "C" void kernel_launch(void* const* d_in, const int* in_sizes, int n_in, void* d_out, int out_size, void* d_ws, size_t ws_size, hipStream_t stream) {
    static int grid = 0;
    if (grid == 0) {
        if (n_in != 16 || out_size != M * DM || ws_size < WS_END) { fprintf(stderr, "kernel_launch: unexpected shapes (n_in %d, out %d, ws %zu)\n", n_in, out_size, ws_size); grid = -1; return; }
        int dev = 0, cus = 0, per_cu = 0;
        hipGetDevice(&dev);
        hipDeviceGetAttribute(&cus, hipDeviceAttributeMultiprocessorCount, dev);
        if (hipFuncSetAttribute((const void*)fwd_megakernel, hipFuncAttributeMaxDynamicSharedMemorySize, LDS_BYTES) != hipSuccess) { fprintf(stderr, "kernel_launch: hipFuncSetAttribute failed\n"); grid = -1; return; }
        if (hipOccupancyMaxActiveBlocksPerMultiprocessor(&per_cu, (const void*)fwd_megakernel, NTHR, LDS_BYTES) != hipSuccess || per_cu < 1) { fprintf(stderr, "kernel_launch: occupancy query says %d\n", per_cu); per_cu = 1; }
        (void)hipGetLastError();
        grid = cus;
        fprintf(stderr, "kernel_launch: grid %d (cus %d, per_cu %d)\n", grid, cus, per_cu);
    }
    if (grid < 0) return;
    Args a{};
    for (int i = 0; i < 16; ++i) a.in[i] = (const float*)d_in[i];
    a.out = (float*)d_out; a.ws = (unsigned char*)d_ws;
    void* kargs[] = {&a};
    hipError_t e = hipLaunchCooperativeKernel((const void*)fwd_megakernel, dim3(grid), dim3(NTHR), kargs, LDS_BYTES, stream);
    if (e != hipSuccess) fprintf(stderr, "kernel_launch: cooperative launch failed: %s (grid %d)\n", hipGetErrorString(e), grid);
}
```

```cpp
#include <hip/hip_runtime.h>
#include <hip/hip_cooperative_groups.h>
#include <cstdio>
#include <cstdint>
namespace cg = cooperative_groups;

namespace pg8 {
#define PG8_LAS __attribute__((address_space(3)))
typedef unsigned short bf16_t;
typedef short bf16x8 __attribute__((ext_vector_type(8)));
typedef float f32x4 __attribute__((ext_vector_type(4)));
typedef unsigned u32x4 __attribute__((ext_vector_type(4)));
constexpr int BM = 256, BK = 64, HALF = 128, HTB = HALF * BK * 2  , STAGE_BYTES = 8 * HTB, NXCD = 8, WGM = 8;

__host__ __device__ __forceinline__ int lds_byte(int r, int c) { const int st = (r >> 4) * 2 + (c >> 5), rr = r & 15, cc = c & 31, ob = rr * 64 + cc * 2; return st * 1024 + (ob ^ (((ob >> 9) & 1) << 5)); }
__host__ __device__ __forceinline__ void stage_rc(int b, int& R, int& C) { const int st = b / 1024, sb = b % 1024, swz = sb ^ (((sb >> 9) & 1) << 5); R = (st >> 1) * 16 + swz / 64; C = (st & 1) * 32 + (swz % 64) / 2; }
__host__ __device__ __forceinline__ int perm32(int rho) { const int n = rho >> 4, i = rho & 15; return 8 * (i >> 2) + 4 * n + (i & 3); }

struct Unit { int pm, pn; };
struct Gemm { const bf16_t* A; const bf16_t* Bt; int M, N, K; };

struct StaticOrder {
    int nM, nN, nwg, G, c;
    __host__ __device__ void init(int M, int N, int G_, int c_) { nM = M / BM; nN = N / BM; nwg = nM * nN; G = G_; c = c_; }
    __host__ __device__ bool next(int i, Unit& u) const {
        const long L = (long)i * G + c; if (L >= nwg) return false;
        int wgid = (int)L; { const int q = nwg / NXCD, r = nwg % NXCD, xcd = wgid % NXCD, off = wgid / NXCD; wgid = (xcd < r ? xcd * (q + 1) : r * (q + 1) + (xcd - r) * q) + off; }
        const int nig = WGM * nN, gid = wgid / nig, fm = gid * WGM, gsz = (nM - fm) < WGM ? (nM - fm) : WGM;
        u.pm = fm + ((wgid % nig) % gsz); u.pn = (wgid % nig) / gsz; return true;
    }
    __device__ __forceinline__ void a_ready(const Unit&) const {}
    __device__ __forceinline__ void done(const Unit&) const {}
};

__device__ __forceinline__ unsigned cvt_pk_bf16(float lo, float hi) { unsigned r; asm("v_cvt_pk_bf16_f32 %0, %1, %2" : "=v"(r) : "v"(lo), "v"(hi)); return r; }

template <class Epi, class Sched, bool ALIGN_EPI = false, bool SP2 = false>
__device__ __forceinline__ void gemm_phase(PG8_LAS unsigned char* lds, const Gemm g, const Sched& S, const Epi& E) {
    int tid_ = threadIdx.x; asm volatile("" : "+v"(tid_));
    const int tid = tid_, wid = __builtin_amdgcn_readfirstlane(tid >> 6), lane = tid & 63, wr = wid >> 2, wc = wid & 3, fr = lane & 15, fq = lane >> 4;
    const int K = g.K, nt = K / BK;
    unsigned voffA[2], voffB[2];
#pragma unroll
    for (int i = 0; i < 2; ++i) { int R, C; stage_rc(tid * 16 + i * 8192, R, C); const int Rb = Epi::PERM ? ((R & ~31) + perm32(R & 31)) : R;
        voffA[i] = (unsigned)(R * K + C) * 2u; voffB[i] = (unsigned)(Rb * K + C) * 2u; }
    const size_t kstep = (size_t)(BK * 2);
    const size_t hstep = (size_t)HALF * K * 2;
    const size_t tstep = 2 * hstep;
    const unsigned ldsw = (unsigned)wid * 1024u;
    const int aoff = lds_byte(wr * 64 + fr, fq * 8), boff = lds_byte(wc * 32 + fr, fq * 8);
#define PG8_SA(b, h) (((b) * 2 + (h)) * HTB)
#define PG8_SB(b, h) ((4 + (b) * 2 + (h)) * HTB)
#define PG8_STAGE(bufoff, gbase, voff) do { _Pragma("unroll") for (int _i = 0; _i < 2; ++_i) \
        __builtin_amdgcn_global_load_lds((const unsigned*)((const char*)(gbase) + (voff)[_i]), (PG8_LAS unsigned*)(lds + (bufoff) + ldsw + _i * 8192), 16, 0, 0); } while (0)
#define PG8_LDA(dst, b, h) do { _Pragma("unroll") for (int m = 0; m < 4; ++m) _Pragma("unroll") for (int k = 0; k < 2; ++k) dst[m][k] = *(const PG8_LAS bf16x8*)(lds + PG8_SA(b, h) + aoff + m * 2048 + k * 1024); } while (0)
#define PG8_LDB(dst, b, h) do { _Pragma("unroll") for (int n = 0; n < 2; ++n) _Pragma("unroll") for (int k = 0; k < 2; ++k) dst[n][k] = *(const PG8_LAS bf16x8*)(lds + PG8_SB(b, h) + boff + n * 2048 + k * 1024); } while (0)
#define PG8_MMA(ai, bj, At, Bt) do { __builtin_amdgcn_s_setprio(1); _Pragma("unroll") for (int m = 0; m < 4; ++m) _Pragma("unroll") for (int n = 0; n < 2; ++n) _Pragma("unroll") for (int k = 0; k < 2; ++k) \
        acc[ai][bj][m][n] = __builtin_amdgcn_mfma_f32_16x16x32_bf16(Bt[n][k], At[m][k], acc[ai][bj][m][n], 0, 0, 0); __builtin_amdgcn_s_setprio(0); } while (0)
#define PG8_WAIT_V(n) asm volatile("s_waitcnt vmcnt(" #n ")" ::: "memory")
#define PG8_WAIT_L(n) asm volatile("s_waitcnt lgkmcnt(" #n ")" ::: "memory")
#define PG8_BAR __builtin_amdgcn_s_barrier()
#define PG8_SCHED __builtin_amdgcn_sched_barrier(0)
    Unit cur, nxt; int ui = 0;
    if (!S.next(0, cur)) return;
    f32x4 acc[2][2][4][2];
#pragma unroll
    for (int a = 0; a < 2; ++a)
#pragma unroll
        for (int b = 0; b < 2; ++b)
#pragma unroll
            for (int m = 0; m < 4; ++m)
#pragma unroll
                for (int n = 0; n < 2; ++n) acc[a][b][m][n] = (f32x4){0.f, 0.f, 0.f, 0.f};
    bf16x8 At[4][2], B0[2][2], B1[2][2];
    const char* cA = (const char*)g.A + (size_t)cur.pm * tstep; const char* cB = (const char*)g.Bt + (size_t)cur.pn * tstep;
    S.a_ready(cur);
    if constexpr (SP2) {
        PG8_STAGE(PG8_SB(0, 0), cB, voffB); PG8_STAGE(PG8_SB(0, 1), cB + hstep, voffB); PG8_STAGE(PG8_SA(0, 0), cA, voffA); PG8_STAGE(PG8_SA(0, 1), cA + hstep, voffA);
        if (wr == 1) PG8_BAR;
        PG8_WAIT_V(2); PG8_BAR;
        PG8_STAGE(PG8_SB(1, 0), cB + kstep, voffB); PG8_STAGE(PG8_SA(1, 0), cA + kstep, voffA); PG8_STAGE(PG8_SB(1, 1), cB + hstep + kstep, voffB);
        PG8_WAIT_V(6); PG8_BAR;
    } else {
        PG8_STAGE(PG8_SB(0, 0), cB, voffB); PG8_STAGE(PG8_SA(0, 0), cA, voffA); PG8_STAGE(PG8_SB(0, 1), cB + hstep, voffB); PG8_STAGE(PG8_SA(0, 1), cA + hstep, voffA);
        if (wr == 1) PG8_BAR;
        PG8_WAIT_V(4); PG8_BAR;
        PG8_STAGE(PG8_SB(1, 0), cB + kstep, voffB); PG8_STAGE(PG8_SA(1, 0), cA + kstep, voffA); PG8_STAGE(PG8_SB(1, 1), cB + hstep + kstep, voffB);
        PG8_WAIT_V(6); PG8_BAR;
    }
    for (;;) {
        const bool has_next = S.next(ui + 1, nxt);
        const char* nA = has_next ? (const char*)g.A + (size_t)nxt.pm * tstep : cA; const char* nB = has_next ? (const char*)g.Bt + (size_t)nxt.pn * tstep : cB;
        for (int t = 0; t < nt; t += 2) {
            const bool last = (t == nt - 2);
            const char* a1 = cA + (size_t)(t + 1) * kstep;
            const char* a2 = last ? nA : cA + (size_t)(t + 2) * kstep; const char* b2 = last ? nB : cB + (size_t)(t + 2) * kstep;
            const char* a3 = a2 + kstep; const char* b3 = b2 + kstep;
            if (last && has_next) S.a_ready(nxt);
            if constexpr (SP2) {
            PG8_LDB(B0, 0, 0); PG8_LDB(B1, 0, 1); PG8_SCHED; PG8_LDA(At, 0, 0); PG8_STAGE(PG8_SA(1, 1), a1 + hstep, voffA);
            PG8_WAIT_V(8); PG8_WAIT_L(0); PG8_BAR; PG8_MMA(0, 0, At, B0); PG8_MMA(0, 1, At, B1); PG8_BAR; PG8_SCHED;
            PG8_LDA(At, 0, 1); PG8_STAGE(PG8_SB(0, 0), b2, voffB); PG8_STAGE(PG8_SB(0, 1), b2 + hstep, voffB); PG8_STAGE(PG8_SA(0, 0), a2, voffA);
            PG8_WAIT_V(8); PG8_WAIT_L(0); PG8_BAR; PG8_MMA(1, 0, At, B0); PG8_MMA(1, 1, At, B1); PG8_BAR; PG8_SCHED;
            PG8_LDB(B0, 1, 0); PG8_LDB(B1, 1, 1); PG8_SCHED; PG8_LDA(At, 1, 0); PG8_STAGE(PG8_SA(0, 1), a2 + hstep, voffA);
            PG8_WAIT_V(8); PG8_WAIT_L(0); PG8_BAR; PG8_MMA(0, 0, At, B0); PG8_MMA(0, 1, At, B1); PG8_BAR; PG8_SCHED;
            PG8_LDA(At, 1, 1); PG8_STAGE(PG8_SB(1, 0), b3, voffB); PG8_STAGE(PG8_SB(1, 1), b3 + hstep, voffB); PG8_STAGE(PG8_SA(1, 0), a3, voffA);
            PG8_WAIT_V(8); PG8_WAIT_L(0); PG8_BAR; PG8_MMA(1, 0, At, B0); PG8_MMA(1, 1, At, B1); PG8_BAR; PG8_SCHED;
            } else {
            PG8_LDB(B0, 0, 0); PG8_SCHED; PG8_LDA(At, 0, 0); PG8_STAGE(PG8_SA(1, 1), a1 + hstep, voffA);
            PG8_WAIT_L(8); PG8_BAR; PG8_WAIT_L(0); PG8_MMA(0, 0, At, B0); PG8_BAR; PG8_SCHED;
            PG8_LDB(B1, 0, 1); PG8_STAGE(PG8_SB(0, 0), b2, voffB);
            PG8_BAR; PG8_WAIT_L(0); PG8_MMA(0, 1, At, B1); PG8_BAR;
            PG8_LDA(At, 0, 1); PG8_STAGE(PG8_SA(0, 0), a2, voffA);
            PG8_BAR; PG8_WAIT_L(0); PG8_MMA(1, 0, At, B0); PG8_BAR; PG8_SCHED;
            PG8_STAGE(PG8_SB(0, 1), b2 + hstep, voffB);
            PG8_WAIT_V(6); PG8_BAR; PG8_MMA(1, 1, At, B1); PG8_BAR;
            PG8_LDB(B0, 1, 0); PG8_SCHED; PG8_LDA(At, 1, 0); PG8_STAGE(PG8_SA(0, 1), a2 + hstep, voffA);
            PG8_WAIT_L(8); PG8_BAR; PG8_WAIT_L(0); PG8_MMA(0, 0, At, B0); PG8_BAR; PG8_SCHED;
            PG8_LDB(B1, 1, 1); PG8_STAGE(PG8_SB(1, 0), b3, voffB);
            PG8_BAR; PG8_WAIT_L(0); PG8_MMA(0, 1, At, B1); PG8_BAR;
            PG8_LDA(At, 1, 1); PG8_STAGE(PG8_SA(1, 0), a3, voffA);
            PG8_BAR; PG8_WAIT_L(0); PG8_MMA(1, 0, At, B0); PG8_BAR; PG8_SCHED;
            PG8_STAGE(PG8_SB(1, 1), b3 + hstep, voffB);
            PG8_WAIT_V(6); PG8_BAR; PG8_MMA(1, 1, At, B1); PG8_BAR;
            }
        }
        if constexpr (ALIGN_EPI) { if (wr == 0) PG8_BAR; }
        E(acc, cur, wr, wc, fr, fq); S.done(cur);
        if (!has_next) break;
#pragma unroll
        for (int a = 0; a < 2; ++a)
#pragma unroll
            for (int b = 0; b < 2; ++b)
#pragma unroll
                for (int m = 0; m < 4; ++m)
#pragma unroll
                    for (int n = 0; n < 2; ++n) acc[a][b][m][n] = (f32x4){0.f, 0.f, 0.f, 0.f};
        cur = nxt; cA = nA; cB = nB; ++ui;
        if constexpr (ALIGN_EPI) { if (wr == 1) PG8_BAR; }
    }
    PG8_WAIT_V(0);
    if constexpr (!ALIGN_EPI) { if (wr == 0) PG8_BAR; }
    PG8_BAR;
#undef PG8_SA
#undef PG8_SB
#undef PG8_STAGE
#undef PG8_LDA
#undef PG8_LDB
#undef PG8_MMA
#undef PG8_WAIT_V
#undef PG8_WAIT_L
#undef PG8_BAR
#undef PG8_SCHED
}
}

constexpr int NWAVES = 8, NTHR = 512;
constexpr int M = 24576, MP = 16384, DM = 2048, NIN = 3584, DFF = 5632;
constexpr int COL_K = 1024, COL_V = 1280, COL_U = 1536, COL_GV = 2560;
constexpr int NGC = 192;
constexpr float LN_EPS = 1e-5f;
constexpr float ALPHA = 1.189207115002721f;
constexpr float LOG2E = 1.4426950408889634f;

constexpr size_t MiB = 1u << 20;
constexpr size_t WS_WSB = 0, WS_GST = 512 * 1024, WS_BAR = 768 * 1024;
constexpr size_t WS_WIN = 1 * MiB, WS_WO = 15 * MiB, WS_W13 = 23 * MiB, WS_W2 = 67 * MiB, WS_ST1 = 89 * MiB;
constexpr size_t WS_XB = 90 * MiB;
constexpr size_t WS_H = 186 * MiB;
constexpr size_t WS_MIX = 354 * MiB;
constexpr size_t WS_HID = 186 * MiB;
constexpr size_t WS_END = 450 * MiB;
static_assert(WS_H + (size_t)M * NIN * 2 == WS_MIX && WS_MIX + (size_t)M * DM * 2 == WS_END && WS_HID + (size_t)M * DFF * 2 == WS_END, "ws map");

constexpr int LDS_BYTES = 131072 + 4096;

#define GAS __attribute__((address_space(1)))
#define LAS __attribute__((address_space(3)))
typedef unsigned short bf16;
typedef unsigned v4u __attribute__((ext_vector_type(4)));
typedef unsigned v2u __attribute__((ext_vector_type(2)));
typedef float f32x4 __attribute__((ext_vector_type(4)));
typedef float f32x2 __attribute__((ext_vector_type(2)));
typedef short bf16x8 __attribute__((ext_vector_type(8)));
using pg8::cvt_pk_bf16;
#define LDS_WAIT() asm volatile("s_waitcnt lgkmcnt(0)" ::: "memory")
__device__ __forceinline__ float bf_lo(unsigned w) { return __uint_as_float(w << 16); }
__device__ __forceinline__ float bf_hi(unsigned w) { return __uint_as_float(w & 0xffff0000u); }
__device__ __forceinline__ float wave_sum(float v) {
#pragma unroll
    for (int o = 1; o < 64; o <<= 1) v += __shfl_xor(v, o);
    return v;
}
__device__ __forceinline__ float gelu_tanh(float x) {
    const float t = x * (-2.3022082f + (-0.10294324f) * x * x);
    return x * __builtin_amdgcn_rcpf(1.0f + __builtin_amdgcn_exp2f(t));
}
__device__ __forceinline__ float silu_f(float x) { return x * __builtin_amdgcn_rcpf(1.0f + __builtin_amdgcn_exp2f(-LOG2E * x)); }

struct EpiH {
    static constexpr bool PERM = true;
    bf16* O; float* gst;
    __device__ __forceinline__ void operator()(const f32x4 (&acc)[2][2][4][2], const pg8::Unit& u, int wr, int wc, int fr, int fq) const {
        const int row0 = u.pm * 256 + wr * 64 + fr, col0 = u.pn * 256 + wc * 32 + 8 * fq;
        const bool act = u.pn >= 6, stat = u.pn >= 10;
#pragma unroll
        for (int ai = 0; ai < 2; ++ai)
#pragma unroll
            for (int m = 0; m < 4; ++m) { bf16* rowp = O + (size_t)(row0 + ai * 128 + m * 16) * NIN + col0;
                float rs = 0.f, rq = 0.f;
#pragma unroll
                for (int bj = 0; bj < 2; ++bj) { f32x4 v0 = acc[ai][bj][m][0], v1 = acc[ai][bj][m][1];
                    if (act) {
#pragma unroll
                        for (int i = 0; i < 4; ++i) { v0[i] = gelu_tanh(v0[i]); v1[i] = gelu_tanh(v1[i]); } }
                    v4u w; w.x = cvt_pk_bf16(v0[0], v0[1]); w.y = cvt_pk_bf16(v0[2], v0[3]); w.z = cvt_pk_bf16(v1[0], v1[1]); w.w = cvt_pk_bf16(v1[2], v1[3]);
                    *(v4u*)(rowp + bj * 128) = w;
                    if (stat) {
#pragma unroll
                        for (int t = 0; t < 4; ++t) { const float a = bf_lo(w[t]), b = bf_hi(w[t]); rs += a + b; rq += a * a + b * b; } } }
                if (stat) { rs += __shfl_xor(rs, 16); rs += __shfl_xor(rs, 32); rq += __shfl_xor(rq, 16); rq += __shfl_xor(rq, 32);
                    if (fq == 0) { float* gp = gst + 2 * (size_t)(row0 + ai * 128 + m * 16); __hip_atomic_fetch_add(gp, rs, __ATOMIC_RELAXED, __HIP_MEMORY_SCOPE_AGENT); __hip_atomic_fetch_add(gp + 1, rq, __ATOMIC_RELAXED, __HIP_MEMORY_SCOPE_AGENT); } } }
    }
};
struct EpiY1 {
    static constexpr bool PERM = false;
    const float* xp; const float* xs; float* Y;
    __device__ __forceinline__ void operator()(const f32x4 (&acc)[2][2][4][2], const pg8::Unit& u, int wr, int wc, int fr, int fq) const {
        const int row0 = u.pm * 256 + wr * 64 + fr, col0 = u.pn * 256 + wc * 32 + 4 * fq;
        const float* xb = (u.pm < MP / 256) ? xp : xs - (size_t)MP * DM;
#pragma unroll
        for (int ai = 0; ai < 2; ++ai)
#pragma unroll
            for (int m = 0; m < 4; ++m) { const size_t off = (size_t)(row0 + ai * 128 + m * 16) * DM + col0;
#pragma unroll
                for (int bj = 0; bj < 2; ++bj)
#pragma unroll
                    for (int n = 0; n < 2; ++n) { const f32x4 xv = *(const f32x4*)(xb + off + bj * 128 + n * 16);
                        *(f32x4*)(Y + off + bj * 128 + n * 16) = xv * ALPHA + acc[ai][bj][m][n]; } }
    }
};
struct EpiHid {
    static constexpr bool PERM = true;
    bf16* O;
    __device__ __forceinline__ void operator()(const f32x4 (&acc)[2][2][4][2], const pg8::Unit& u, int wr, int wc, int fr, int fq) const {
        const int row0 = u.pm * 256 + wr * 64 + fr, col0 = u.pn * 128 + wc * 32 + 8 * fq;
#pragma unroll
        for (int ai = 0; ai < 2; ++ai)
#pragma unroll
            for (int m = 0; m < 4; ++m) {
                const f32x4 g0 = acc[ai][0][m][0], g1 = acc[ai][0][m][1], u0 = acc[ai][1][m][0], u1 = acc[ai][1][m][1];
                float h[8];
#pragma unroll
                for (int i = 0; i < 4; ++i) { h[i] = silu_f(g0[i]) * u0[i]; h[4 + i] = silu_f(g1[i]) * u1[i]; }
                v4u w; w.x = cvt_pk_bf16(h[0], h[1]); w.y = cvt_pk_bf16(h[2], h[3]); w.z = cvt_pk_bf16(h[4], h[5]); w.w = cvt_pk_bf16(h[6], h[7]);
                *(v4u*)(O + (size_t)(row0 + ai * 128 + m * 16) * DFF + col0) = w; }
    }
};
struct EpiY2 {
    static constexpr bool PERM = false;
    float* Y; const float* st1; const float* g1; const float* b1;
    __device__ __forceinline__ void operator()(const f32x4 (&acc)[2][2][4][2], const pg8::Unit& u, int wr, int wc, int fr, int fq) const {
        const int row0 = u.pm * 256 + wr * 64 + fr, col0 = u.pn * 256 + wc * 32 + 4 * fq;
        f32x4 gv[2][2], bv[2][2];
#pragma unroll
        for (int bj = 0; bj < 2; ++bj)
#pragma unroll
            for (int n = 0; n < 2; ++n) { gv[bj][n] = *(const f32x4*)(g1 + col0 + bj * 128 + n * 16) * ALPHA; bv[bj][n] = *(const f32x4*)(b1 + col0 + bj * 128 + n * 16) * ALPHA; }
#pragma unroll
        for (int ai = 0; ai < 2; ++ai)
#pragma unroll
            for (int m = 0; m < 4; ++m) { const int r = row0 + ai * 128 + m * 16; const size_t off = (size_t)r * DM + col0;
                const f32x2 st = *(const f32x2*)(st1 + 2 * r);
#pragma unroll
                for (int bj = 0; bj < 2; ++bj)
#pragma unroll
                    for (int n = 0; n < 2; ++n) { const f32x4 yv = *(const f32x4*)(Y + off + bj * 128 + n * 16);
                        *(f32x4*)(Y + off + bj * 128 + n * 16) = ((yv - st.x) * st.y) * gv[bj][n] + bv[bj][n] + acc[ai][bj][m][n]; } }
    }
};

__device__ __forceinline__ void p0_transpose_item(const float* W, int K, int N, bf16* WT, int drow0, int k0, int n0, LAS float* scr, int lane) {
#pragma unroll 8
    for (int i = 0; i < 32; ++i) { const int kk = 2 * i + (lane >> 5); scr[kk * 33 + (lane & 31)] = W[(size_t)(k0 + kk) * N + n0 + (lane & 31)]; }
    LDS_WAIT(); asm volatile("" ::: "memory");
    const int c = lane & 7;
#pragma unroll
    for (int j = 0; j < 4; ++j) { const int n = (lane >> 3) + 8 * j; const LAS float* s = scr + (8 * c) * 33 + n;
        v4u o; o.x = cvt_pk_bf16(s[0 * 33], s[1 * 33]); o.y = cvt_pk_bf16(s[2 * 33], s[3 * 33]); o.z = cvt_pk_bf16(s[4 * 33], s[5 * 33]); o.w = cvt_pk_bf16(s[6 * 33], s[7 * 33]);
        *(v4u*)(WT + (size_t)(drow0 + n) * K + k0 + 8 * c) = o; }
    LDS_WAIT(); asm volatile("" ::: "memory");
}

struct Args { const float* in[16]; float* out; unsigned char* ws; };

template <bool FINAL>
__device__ __forceinline__ void ln_rows(const float* src, float* dstf, bf16* dstb, float* stats, const float* g, const float* b, int gw, int NGW, int lane) {
    f32x4 gg[8], bb[8];
#pragma unroll
    for (int j = 0; j < 8; ++j) { gg[j] = ((const f32x4*)g)[lane + 64 * j]; bb[j] = ((const f32x4*)b)[lane + 64 * j]; }
    for (int m = gw; m < M; m += NGW) {
        const f32x4* xr = (const f32x4*)(src + (size_t)m * DM) + lane;
        f32x4 v[8]; float s = 0.f;
#pragma unroll
        for (int j = 0; j < 8; ++j) { v[j] = xr[64 * j]; s += (v[j].x + v[j].y) + (v[j].z + v[j].w); }
        const float mean = wave_sum(s) * (1.f / DM); float s2 = 0.f;
#pragma unroll
        for (int j = 0; j < 8; ++j) { v[j] = v[j] - mean; s2 += (v[j].x * v[j].x + v[j].y * v[j].y) + (v[j].z * v[j].z + v[j].w * v[j].w); }
        const float rstd = 1.f / sqrtf(wave_sum(s2) * (1.f / DM) + LN_EPS);
        if (FINAL) {
            f32x4* o = (f32x4*)(dstf + (size_t)m * DM) + lane;
#pragma unroll
            for (int j = 0; j < 8; ++j) o[64 * j] = (v[j] * rstd) * gg[j] + bb[j];
        } else {
            v2u* o = (v2u*)(dstb + (size_t)m * DM) + lane;
#pragma unroll
            for (int j = 0; j < 8; ++j) { const f32x4 y = (v[j] * rstd) * gg[j] + bb[j]; v2u w; w.x = cvt_pk_bf16(y.x, y.y); w.y = cvt_pk_bf16(y.z, y.w); o[64 * j] = w; }
            if (lane == 0) { stats[2 * m] = mean; stats[2 * m + 1] = rstd; }
        }
    }
}

constexpr int VT_PITCH = 784;
__device__ __forceinline__ void attn_head_scores(const LAS unsigned char* kbase, const bf16x8 (&qf)[4], int swz, int p0, float rel0f, float nslope2, float sink2, float pen0, float pen2, v4u (&pf)[9], float& inv) {
    f32x4 S[18];
#pragma unroll
    for (int j = 0; j < 18; ++j) {
        S[j] = (f32x4){0.f, 0.f, 0.f, 0.f};
#pragma unroll
        for (int ks = 0; ks < 4; ++ks) { const bf16x8 kf = *(const LAS bf16x8*)(kbase + (j >> 1) * 8192 + (j & 1) * 1024 + (((4 * ks) ^ swz) << 4));
            S[j] = __builtin_amdgcn_mfma_f32_16x16x32_bf16(kf, qf[ks], S[j], 0, 0, 0); }
        if (j & 1) __builtin_amdgcn_sched_barrier(0);
    }
    const float sc2 = 0.08838834764831845f * LOG2E;
    float mx = sink2;
    asm volatile("" : "+v"(rel0f));
#pragma unroll
    for (int t = 0; t < 9; ++t) { const int p = p0 + t; const float pen = p < 4 ? pen0 : (p >= 8 ? pen2 : 0.f);
#pragma unroll
        for (int e = 0; e < 2; ++e)
#pragma unroll
            for (int i = 0; i < 4; ++i) { const float relf = rel0f + (float)(32 * t + 4 * e + i);
                float sv = __builtin_fmaf(S[2 * t + e][i], sc2, __builtin_fmaf(__builtin_fabsf(relf), nslope2, pen));
                if (t == 0 || t == 8) sv = (__builtin_fabsf(relf) > 128.f) ? -1e30f : sv;
                S[2 * t + e][i] = sv; mx = fmaxf(mx, sv); } }
    mx = fmaxf(mx, __shfl_xor(mx, 16)); mx = fmaxf(mx, __shfl_xor(mx, 32));
    float sum = 0.f;
#pragma unroll
    for (int j = 0; j < 18; ++j)
#pragma unroll
        for (int i = 0; i < 4; ++i) { const float p = __builtin_amdgcn_exp2f(S[j][i] - mx); S[j][i] = p; sum += p; }
    sum += __shfl_xor(sum, 16); sum += __shfl_xor(sum, 32);
    inv = 1.0f / (sum + __builtin_amdgcn_exp2f(sink2 - mx));
#pragma unroll
    for (int t = 0; t < 9; ++t) { pf[t].x = cvt_pk_bf16(S[2 * t][0], S[2 * t][1]); pf[t].y = cvt_pk_bf16(S[2 * t][2], S[2 * t][3]);
        pf[t].z = cvt_pk_bf16(S[2 * t + 1][0], S[2 * t + 1][1]); pf[t].w = cvt_pk_bf16(S[2 * t + 1][2], S[2 * t + 1][3]); }
}
__device__ __forceinline__ void attn_head_pv(const LAS unsigned char* vbase, const v4u (&pf)[9], float inv, bf16* Og) {
#pragma unroll
    for (int dt = 0; dt < 8; ++dt) {
        f32x4 o = (f32x4){0.f, 0.f, 0.f, 0.f};
#pragma unroll
        for (int t = 0; t < 9; ++t) { const bf16x8 vf = *(const LAS bf16x8*)(vbase + 16 * dt * VT_PITCH + 64 * t);
            o = __builtin_amdgcn_mfma_f32_16x16x32_bf16(vf, __builtin_bit_cast(bf16x8, pf[t]), o, 0, 0, 0); }
        v2u w; w.x = cvt_pk_bf16(o[0] * inv, o[1] * inv); w.y = cvt_pk_bf16(o[2] * inv, o[3] * inv);
        *(v2u*)(Og + 16 * dt) = w;
        __builtin_amdgcn_sched_barrier(0);
    }
}
__device__ __forceinline__ void vt_write(LAS unsigned char* lds, const v4u (&in)[8], int dblk, int key0) {
#pragma unroll
    for (int i = 0; i < 8; ++i) { v4u o;
#pragma unroll
        for (int t = 0; t < 4; ++t) { const unsigned a = in[2 * t][i >> 1], b = in[2 * t + 1][i >> 1];
            o[t] = (i & 1) ? ((a >> 16) | (b & 0xffff0000u)) : ((a & 0xffffu) | (b << 16)); }
        *(LAS v4u*)(lds + (8 * dblk + i) * VT_PITCH + key0 * 2) = o; }
}
__device__ __forceinline__ void attn_unit(LAS unsigned char* lds, const bf16* H, bf16* MIX, const float* sink, int gc, int kv, int hp) {
    int tid_ = threadIdx.x; asm volatile("" : "+v"(tid_));
    const int tid = tid_, lane = tid & 63, wave = __builtin_amdgcn_readfirstlane(tid >> 6);
    const int c = gc & 15, fr = lane & 15, fq = lane >> 4, hA = 4 * kv + 2 * hp, hB = hA + 1;
    const int rowq0 = gc * 128, roww0 = rowq0 - 128;
    const bool v0 = (c != 0), v2 = (c != 15);
    const int p0 = wave >> 1;
    __syncthreads();
    {
        const bf16* Kg = H + COL_K + 128 * kv;
#pragma unroll
        for (int it = 0; it < 12; ++it) { const int ch = tid + it * NTHR, row = ch >> 4, cc = ch & 15, kb = row >> 7;
            const int grow = roww0 + row + ((kb == 0 && !v0) ? 128 : 0) - ((kb == 2 && !v2) ? 128 : 0);
            const v4u v = *(const v4u*)(Kg + (size_t)grow * NIN + cc * 8);
            const int g = (((row >> 3) & 3) << 2) | (row & 3);
            *(LAS v4u*)(lds + row * 256 + ((cc ^ g) << 4)) = v; }
    }
    bf16x8 qfA[4], qfB[4];
    { const bf16* Qg = H + (size_t)(rowq0 + 16 * wave + fr) * NIN + 128 * hA + 8 * fq;
#pragma unroll
      for (int ks = 0; ks < 4; ++ks) { qfA[ks] = *(const bf16x8*)(Qg + 32 * ks); qfB[ks] = *(const bf16x8*)(Qg + 128 + 32 * ks); } }
    const int r = tid & 255, sblk = r >> 4, dblk = r & 15;
    v4u vin0[8], vin1[8];
    { const bf16* Vg = H + COL_V + 128 * kv + 8 * dblk;
      const int kb = tid >> 8, key0 = 128 * kb + 8 * sblk, grow = roww0 + key0 + ((kb == 0 && !v0) ? 128 : 0);
#pragma unroll
      for (int jj = 0; jj < 8; ++jj) vin0[jj] = *(const v4u*)(Vg + (size_t)(grow + jj) * NIN);
      if (wave < 4) { const int grow2 = roww0 + 256 + 8 * sblk - (v2 ? 0 : 128);
#pragma unroll
          for (int jj = 0; jj < 8; ++jj) vin1[jj] = *(const v4u*)(Vg + (size_t)(grow2 + jj) * NIN); } }
    __syncthreads();
    const int qi = 16 * wave + fr;
    float rel0f = (float)(32 * p0 + 8 * fq - 128 - qi);
    asm volatile("" : "+v"(rel0f));
    const float pen0 = v0 ? 0.f : -1e30f, pen2 = v2 ? 0.f : -1e30f;
    const LAS unsigned char* kbase = lds + (32 * p0 + 8 * (fr >> 2) + (fr & 3)) * 256;
    const int swz = fq ^ fr;
    v4u pfA[9], pfB[9]; float invA, invB;
    attn_head_scores(kbase, qfA, swz, p0, rel0f, -__builtin_amdgcn_exp2f(-(float)(hA + 1)) * LOG2E, sink[hA] * LOG2E, pen0, pen2, pfA, invA);
    attn_head_scores(kbase, qfB, swz, p0, rel0f, -__builtin_amdgcn_exp2f(-(float)(hB + 1)) * LOG2E, sink[hB] * LOG2E, pen0, pen2, pfB, invB);
    __syncthreads();
    vt_write(lds, vin0, dblk, 128 * (tid >> 8) + 8 * sblk);
    if (wave < 4) vt_write(lds, vin1, dblk, 256 + 8 * sblk);
    __syncthreads();
    const LAS unsigned char* vbase = lds + fr * VT_PITCH + 64 * p0 + 16 * fq;
    bf16* Og = MIX + (size_t)(rowq0 + 16 * wave + fr) * DM + 128 * hA + 4 * fq;
    attn_head_pv(vbase, pfA, invA, Og);
    attn_head_pv(vbase, pfB, invB, Og + 128);
}

constexpr int GT_PITCH = 272, GT_BYTES = 128 * GT_PITCH;
__device__ __forceinline__ void sgu_pair(LAS unsigned char* lds, const bf16* H, bf16* MIX, const float* lng, const float* lnb, const bf16* wsb, const float* b_s, const float* gst, int gc, int gp) {
    int tid_ = threadIdx.x; asm volatile("" : "+v"(tid_));
    const int tid = tid_, lane = tid & 63, wave = __builtin_amdgcn_readfirstlane(tid >> 6);
    const int r0 = gc * 128, fr = lane & 15, fq = lane >> 4;
    __syncthreads();
    { const int gsel = tid >> 8, r = tid & 255, sblk = r >> 4, dblk = r & 15, g = 2 * gp + gsel, ch0 = 128 * g + 8 * dblk;
      const f32x4 ga = *(const f32x4*)(lng + ch0), gb = *(const f32x4*)(lng + ch0 + 4), ba = *(const f32x4*)(lnb + ch0), bb = *(const f32x4*)(lnb + ch0 + 4);
      const float gam[8] = {ga.x, ga.y, ga.z, ga.w, gb.x, gb.y, gb.z, gb.w}, bet[8] = {ba.x, ba.y, ba.z, ba.w, bb.x, bb.y, bb.z, bb.w};
      v4u in[8]; f32x2 st[8];
#pragma unroll
      for (int jj = 0; jj < 8; ++jj) { in[jj] = *(const v4u*)(H + (size_t)(r0 + 8 * sblk + jj) * NIN + COL_GV + ch0); st[jj] = *(const f32x2*)(gst + 2 * (size_t)(r0 + 8 * sblk + jj)); }
#pragma unroll
      for (int jj = 0; jj < 8; ++jj) { const float mean = st[jj].x * (1.f / 1024.f), var = fmaxf(st[jj].y * (1.f / 1024.f) - mean * mean, 0.f); st[jj].x = mean; st[jj].y = 1.f / sqrtf(var + LN_EPS); }
#pragma unroll
      for (int i = 0; i < 8; ++i) { v4u o;
#pragma unroll
          for (int t = 0; t < 4; ++t) { const unsigned a = in[2 * t][i >> 1], b = in[2 * t + 1][i >> 1];
              const float xa = (i & 1) ? bf_hi(a) : bf_lo(a), xb = (i & 1) ? bf_hi(b) : bf_lo(b);
              o[t] = cvt_pk_bf16((xa - st[2 * t].x) * st[2 * t].y * gam[i] + bet[i], (xb - st[2 * t + 1].x) * st[2 * t + 1].y * gam[i] + bet[i]); }
          *(LAS v4u*)(lds + gsel * GT_BYTES + (8 * dblk + i) * GT_PITCH + 16 * sblk) = o; } }
    const int gsel = wave >> 2, tq = wave & 3, g = 2 * gp + gsel;
    bf16x8 wf[2][4];
#pragma unroll
    for (int tt = 0; tt < 2; ++tt)
#pragma unroll
        for (int ks = 0; ks < 4; ++ks) wf[tt][ks] = *(const bf16x8*)(wsb + (size_t)(g * 128 + 32 * tq + 16 * tt + fr) * 128 + 32 * ks + 8 * fq);
    __syncthreads();
    const LAS unsigned char* Gb = lds + gsel * GT_BYTES + fr * GT_PITCH + 16 * fq;
    const float bias0 = b_s[g * 128 + 32 * tq + fr], bias1 = b_s[g * 128 + 32 * tq + 16 + fr];
#pragma unroll
    for (int dt = 0; dt < 8; ++dt) {
        f32x4 a0 = (f32x4){0.f, 0.f, 0.f, 0.f}, a1 = a0;
#pragma unroll
        for (int ks = 0; ks < 4; ++ks) { const bf16x8 gf = *(const LAS bf16x8*)(Gb + 16 * dt * GT_PITCH + 64 * ks);
            a0 = __builtin_amdgcn_mfma_f32_16x16x32_bf16(gf, wf[0][ks], a0, 0, 0, 0);
            a1 = __builtin_amdgcn_mfma_f32_16x16x32_bf16(gf, wf[1][ks], a1, 0, 0, 0); }
#pragma unroll
        for (int tt = 0; tt < 2; ++tt) { const int t = 32 * tq + 16 * tt + fr; const float bias = tt ? bias1 : bias0; const f32x4 a = tt ? a1 : a0;
            const v2u uu = *(const v2u*)(H + (size_t)(r0 + t) * NIN + COL_U + 128 * g + 16 * dt + 4 * fq);
            v2u w; w.x = cvt_pk_bf16(bf_lo(uu.x) * (a[0] + bias), bf_hi(uu.x) * (a[1] + bias)); w.y = cvt_pk_bf16(bf_lo(uu.y) * (a[2] + bias), bf_hi(uu.y) * (a[3] + bias));
            *(v2u*)(MIX + (size_t)(r0 + t) * DM + 1024 + 128 * g + 16 * dt + 4 * fq) = w; }
    }
}

#define XB_TMO      128
#define XB_XCNT(j)  (256  + 64 * (j))
#define XB_XSUB(j)  (1280 + 64 * (j))
#define XB_XGEN(j)  (2304 + 64 * (j))
#define XB_TOP      3328
#define XB_TOPGEN   3392
#define XCD_BAR_WORDS 3456
#define XB_SPIN_CAP (1u << 18)
__device__ __forceinline__ unsigned xb_ld(unsigned* p)              { return __hip_atomic_load(p, __ATOMIC_RELAXED, __HIP_MEMORY_SCOPE_AGENT); }
__device__ __forceinline__ unsigned xb_add(unsigned* p, unsigned v) { return __hip_atomic_fetch_add(p, v, __ATOMIC_RELAXED, __HIP_MEMORY_SCOPE_AGENT); }
__device__ __forceinline__ unsigned xb_xcc_id() { return (unsigned)__builtin_amdgcn_s_getreg((3 << 11) | 20) & 0xFu; }
#define XB_SPIN(cond, bar) do { unsigned _sp = 0; while (cond) { __builtin_amdgcn_s_sleep(1); \
    if ((++_sp & 255u) == 0u) { if (xb_ld(&(bar)[XB_TMO])) break; if (_sp > XB_SPIN_CAP) { atomicAdd(&(bar)[XB_TMO], 1u); break; } } } } while (0)
struct XcdBarrier { unsigned* bar; unsigned x; volatile LAS unsigned* st; };
__device__ __forceinline__ XcdBarrier xcd_barrier_post(unsigned* bar, volatile LAS unsigned* st) {
    XcdBarrier b; b.bar = bar; b.x = xb_xcc_id(); b.st = st;
    if (threadIdx.x == 0) (void)xb_add(&bar[XB_XCNT(b.x)], 1u);
    return b;
}
__device__ __forceinline__ void xcd_barrier_complete(unsigned* bar, unsigned x, unsigned& nloc, unsigned& nx) {
    const unsigned G = gridDim.x * gridDim.y * gridDim.z;
    unsigned sum, cnt, mine, sp = 0u;
    for (;;) {
        sum = 0u; cnt = 0u; mine = 0u;
#pragma unroll
        for (unsigned j = 0; j < 16; ++j) { const unsigned c = xb_ld(&bar[XB_XCNT(j)]); sum += c; cnt += (c > 0u) ? 1u : 0u; mine = (j == x) ? c : mine; }
        if (sum == G) break;
        __builtin_amdgcn_s_sleep(1);
        if ((++sp & 255u) == 0u) { if (xb_ld(&bar[XB_TMO])) break; if (sp > XB_SPIN_CAP) { atomicAdd(&bar[XB_TMO], 1u); break; } }
    }
    nloc = mine > 0u ? mine : 1u; nx = cnt > 0u ? cnt : 1u;
}
__device__ __forceinline__ void xcd_barrier(const XcdBarrier& b) {
    asm volatile("s_waitcnt vmcnt(0)" ::: "memory");
    __syncthreads();
    if (threadIdx.x == 0) {
        unsigned* bar = b.bar;
        __builtin_amdgcn_s_waitcnt(0);
        unsigned nloc = b.st[0], nx = b.st[1];
        if (nloc == 0u) { xcd_barrier_complete(bar, b.x, nloc, nx); b.st[0] = nloc; b.st[1] = nx; }
        const unsigned old = xb_add(&bar[XB_XSUB(b.x)], 1u);
        const unsigned gen = old / nloc;
        if (old + 1u == (gen + 1u) * nloc) {
            __builtin_amdgcn_fence(__ATOMIC_RELEASE, "agent");
            asm volatile("s_waitcnt vmcnt(0)" ::: "memory");
            const unsigned og = xb_add(&bar[XB_TOP], 1u);
            const unsigned tg = og / nx;
            if (og + 1u == (tg + 1u) * nx) xb_add(&bar[XB_TOPGEN], 1u);
            else XB_SPIN(xb_ld(&bar[XB_TOPGEN]) == tg, bar);
            __builtin_amdgcn_fence(__ATOMIC_ACQUIRE, "agent");
            xb_add(&bar[XB_XGEN(b.x)], 1u);
            asm volatile("s_waitcnt vmcnt(0)" ::: "memory");
        } else {
            XB_SPIN(xb_ld(&bar[XB_XGEN(b.x)]) == gen, bar);
            __builtin_amdgcn_fence(__ATOMIC_ACQUIRE, "agent");
            asm volatile("s_waitcnt vmcnt(0)" ::: "memory");
        }
    }
    __syncthreads();
}

#ifndef PH_MASK
#define PH_MASK 0xff
#endif
#ifndef DUP_MASK
#define DUP_MASK 0
#endif
#define GSYNC() xcd_barrier(xbar)
#define REP(k) for (int rep_ = 0; rep_ < (((DUP_MASK >> (k)) & 1) ? 2 : 1); ++rep_, (rep_ < (((DUP_MASK >> (k)) & 1) ? 2 : 1) ? GSYNC() : (void)0))
__global__ void __launch_bounds__(NTHR, 2) fwd_megakernel(Args args) {
    extern __shared__ __attribute__((aligned(16))) unsigned char lds_raw[];
    cg::grid_group grid = cg::this_grid();
    LAS unsigned char* lds = (LAS unsigned char*)lds_raw;
    const int tid = threadIdx.x, lane = tid & 63, wave = __builtin_amdgcn_readfirstlane(tid >> 6);
    const int G = gridDim.x, bx = blockIdx.x;
    const int vcu = (G % 8 == 0) ? (bx % 8) * (G / 8) + bx / 8 : bx;
    unsigned char* ws = args.ws;
    const float* xp = args.in[0]; const float* xs = args.in[1];
    const float* w_in = args.in[2]; const float* ln_sgu_g = args.in[3]; const float* ln_sgu_b = args.in[4]; const float* w_s = args.in[5]; const float* b_s = args.in[6];
    const float* sink = args.in[7]; const float* w_o = args.in[8]; const float* ln1_g = args.in[9]; const float* ln1_b = args.in[10];
    const float* w_gate = args.in[11]; const float* w_up = args.in[12]; const float* w_down = args.in[13]; const float* ln2_g = args.in[14]; const float* ln2_b = args.in[15];
    float* out = args.out;
    bf16* WIN_T = (bf16*)(ws + WS_WIN); bf16* WO_T = (bf16*)(ws + WS_WO); bf16* W13_T = (bf16*)(ws + WS_W13); bf16* W2_T = (bf16*)(ws + WS_W2);
    float* ST1 = (float*)(ws + WS_ST1); float* GST = (float*)(ws + WS_GST); bf16* WSB = (bf16*)(ws + WS_WSB);
    bf16* XB = (bf16*)(ws + WS_XB); bf16* Hb = (bf16*)(ws + WS_H); bf16* MIX = (bf16*)(ws + WS_MIX); bf16* HID = (bf16*)(ws + WS_HID);
    const int gw = vcu * NWAVES + wave, NGW = G * NWAVES;
    if (tid < 2) ((volatile LAS unsigned*)(lds + 131072 + 2048))[tid] = 0u;
    if (bx == 0) for (int i = tid; i < XCD_BAR_WORDS; i += NTHR) ((unsigned*)(ws + WS_BAR))[i] = 0u;
    __syncthreads();

    if constexpr ((PH_MASK & 1) != 0) {
        LAS float* scr = (LAS float*)(lds + wave * 16384);
        constexpr int I_IN = (DM / 64) * (NIN / 32), I_O = (DM / 64) * (DM / 32), I_G = (DM / 64) * (DFF / 32), I_D = (DFF / 64) * (DM / 32);
        constexpr int NITEMS = I_IN + I_O + 2 * I_G + I_D;
        for (int it = gw; it < NITEMS; it += NGW) {
            int r = it;
            if (r < I_IN) { const int nb = r % (NIN / 32), kb = r / (NIN / 32); p0_transpose_item(w_in, DM, NIN, WIN_T, 32 * nb, 64 * kb, 32 * nb, scr, lane); continue; } r -= I_IN;
            if (r < I_O) { const int nb = r % (DM / 32), kb = r / (DM / 32); p0_transpose_item(w_o, DM, DM, WO_T, 32 * nb, 64 * kb, 32 * nb, scr, lane); continue; } r -= I_O;
            if (r < 2 * I_G) { const int up = r >= I_G ? 1 : 0; if (up) r -= I_G; const int nb = r % (DFF / 32), kb = r / (DFF / 32), n0 = 32 * nb;
                p0_transpose_item(up ? w_up : w_gate, DM, DFF, W13_T, (n0 >> 7) * 256 + up * 128 + (n0 & 127), 64 * kb, n0, scr, lane); continue; } r -= 2 * I_G;
            { const int nb = r % (DM / 32), kb = r / (DM / 32); p0_transpose_item(w_down, DFF, DM, W2_T, 32 * nb, 64 * kb, 32 * nb, scr, lane); }
        }
        { const int gt = bx * NTHR + tid;
          if (gt < M * 2 / 4) ((f32x4*)GST)[gt] = (f32x4){0.f, 0.f, 0.f, 0.f};
          if (gt < 8 * 128 * 128 / 8) { const f32x4 a = *(const f32x4*)(w_s + 8 * gt), b = *(const f32x4*)(w_s + 8 * gt + 4);
              v4u w; w.x = cvt_pk_bf16(a.x, a.y); w.y = cvt_pk_bf16(a.z, a.w); w.z = cvt_pk_bf16(b.x, b.y); w.w = cvt_pk_bf16(b.z, b.w); *(v4u*)(WSB + 8 * gt) = w; } }
        const size_t n8 = (size_t)M * DM / 8, nthr = (size_t)G * NTHR;
        for (size_t i = (size_t)bx * NTHR + tid; i < n8; i += nthr) { const size_t e = i * 8;
            const float* src = (e < (size_t)MP * DM) ? xp + e : xs + (e - (size_t)MP * DM);
            const f32x4 a = *(const f32x4*)src, b = *(const f32x4*)(src + 4);
            v4u w; w.x = cvt_pk_bf16(a.x, a.y); w.y = cvt_pk_bf16(a.z, a.w); w.z = cvt_pk_bf16(b.x, b.y); w.w = cvt_pk_bf16(b.z, b.w);
            *(v4u*)(XB + e) = w; }
    }
    grid.sync();
    const XcdBarrier xbar = xcd_barrier_post((unsigned*)(ws + WS_BAR), (volatile LAS unsigned*)(lds + 131072 + 2048));
    REP(1) if constexpr ((PH_MASK & 2) != 0) { pg8::Gemm g{XB, WIN_T, M, NIN, DM}; pg8::StaticOrder S; S.init(M, NIN, G, bx); EpiH E{Hb, GST};
      pg8::gemm_phase<EpiH, pg8::StaticOrder, true, true>(lds, g, S, E); }
    GSYNC();
    REP(2) if constexpr ((PH_MASK & 4) != 0) {
      for (int it = vcu; it < NGC * 8; it += G) {
#ifndef NO_ATTN
        if (it < NGC * 4) { attn_unit(lds, Hb, MIX, sink, it >> 2, (it >> 1) & 1, it & 1); if (DUP_MASK & 64) attn_unit(lds, Hb, MIX, sink, it >> 2, (it >> 1) & 1, it & 1); }
#endif
#ifndef NO_SGU
        if (it >= NGC * 4) { const int a = it - NGC * 4; sgu_pair(lds, Hb, MIX, ln_sgu_g, ln_sgu_b, WSB, b_s, GST, a >> 2, a & 3); if (DUP_MASK & 128) sgu_pair(lds, Hb, MIX, ln_sgu_g, ln_sgu_b, WSB, b_s, GST, a >> 2, a & 3); }
#endif
    } }
    GSYNC();
    REP(3) if constexpr ((PH_MASK & 8) != 0) { pg8::Gemm g{MIX, WO_T, M, DM, DM}; pg8::StaticOrder S; S.init(M, DM, G, bx); EpiY1 E{xp, xs, out};
      pg8::gemm_phase<EpiY1, pg8::StaticOrder, true, true>(lds, g, S, E); }
    GSYNC();
    REP(4) if constexpr ((PH_MASK & 16) != 0) ln_rows<false>(out, nullptr, XB, ST1, ln1_g, ln1_b, gw, NGW, lane);
    GSYNC();
    REP(5) if constexpr ((PH_MASK & 32) != 0) { pg8::Gemm g{XB, W13_T, M, 2 * DFF, DM}; pg8::StaticOrder S; S.init(M, 2 * DFF, G, bx); EpiHid E{HID};
      pg8::gemm_phase<EpiHid, pg8::StaticOrder, true, true>(lds, g, S, E); }
    GSYNC();
    if constexpr ((PH_MASK & 64) != 0) { pg8::Gemm g{HID, W2_T, M, DM, DFF}; pg8::StaticOrder S; S.init(M, DM, G, bx); EpiY2 E{out, ST1, ln1_g, ln1_b};
      pg8::gemm_phase<EpiY2, pg8::StaticOrder, true, true>(lds, g, S, E); }
    GSYNC();
#ifdef SYNC_PROBE
    for (int i = 0; i < 16; ++i) GSYNC();
#endif
    if constexpr ((PH_MASK & 128) != 0) ln_rows<true>(out, out, nullptr, nullptr, ln2_g, ln2_b, gw, NGW, lane);
}

extern "C" void kernel_launch(void* const* d_in, const int* in_sizes, int n_in, void* d_out, int out_size, void* d_ws, size_t ws_size, hipStream_t stream) {
    static int grid = 0;
    if (grid == 0) {
        if (n_in != 16 || out_size != M * DM || ws_size < WS_END) { fprintf(stderr, "kernel_launch: unexpected shapes (n_in %d, out %d, ws %zu)\n", n_in, out_size, ws_size); grid = -1; return; }
        int dev = 0, cus = 0, per_cu = 0;
        hipGetDevice(&dev);
        hipDeviceGetAttribute(&cus, hipDeviceAttributeMultiprocessorCount, dev);
        if (hipFuncSetAttribute((const void*)fwd_megakernel, hipFuncAttributeMaxDynamicSharedMemorySize, LDS_BYTES) != hipSuccess) { fprintf(stderr, "kernel_launch: hipFuncSetAttribute failed\n"); grid = -1; return; }
        if (hipOccupancyMaxActiveBlocksPerMultiprocessor(&per_cu, (const void*)fwd_megakernel, NTHR, LDS_BYTES) != hipSuccess || per_cu < 1) { fprintf(stderr, "kernel_launch: occupancy query says %d\n", per_cu); per_cu = 1; }
        (void)hipGetLastError();
        grid = cus;
        fprintf(stderr, "kernel_launch: grid %d (cus %d, per_cu %d)\n", grid, cus, per_cu);
    }
    if (grid < 0) return;
    Args a{};
    for (int i = 0; i < 16; ++i) a.in[i] = (const float*)d_in[i];
    a.out = (float*)d_out; a.ws = (unsigned char*)d_ws;
    void* kargs[] = {&a};
    hipError_t e = hipLaunchCooperativeKernel((const void*)fwd_megakernel, dim3(grid), dim3(NTHR), kargs, LDS_BYTES, stream);
    if (e != hipSuccess) fprintf(stderr, "kernel_launch: cooperative launch failed: %s (grid %d)\n", hipGetErrorString(e), grid);
}
```

```cpp
#include <hip/hip_runtime.h>
#include <hip/hip_cooperative_groups.h>
#include <cstdio>
#include <cstdint>
namespace cg = cooperative_groups;

namespace pg8 {
#define PG8_LAS __attribute__((address_space(3)))
typedef unsigned short bf16_t;
typedef short bf16x8 __attribute__((ext_vector_type(8)));
typedef float f32x4 __attribute__((ext_vector_type(4)));
typedef unsigned u32x4 __attribute__((ext_vector_type(4)));
constexpr int BM = 256, BK = 64, HALF = 128, HTB = HALF * BK * 2  , STAGE_BYTES = 8 * HTB, NXCD = 8, WGM = 8;

__host__ __device__ __forceinline__ int lds_byte(int r, int c) { const int st = (r >> 4) * 2 + (c >> 5), rr = r & 15, cc = c & 31, ob = rr * 64 + cc * 2; return st * 1024 + (ob ^ (((ob >> 9) & 1) << 5)); }
__host__ __device__ __forceinline__ void stage_rc(int b, int& R, int& C) { const int st = b / 1024, sb = b % 1024, swz = sb ^ (((sb >> 9) & 1) << 5); R = (st >> 1) * 16 + swz / 64; C = (st & 1) * 32 + (swz % 64) / 2; }
__host__ __device__ __forceinline__ int perm32(int rho) { const int n = rho >> 4, i = rho & 15; return 8 * (i >> 2) + 4 * n + (i & 3); }

struct Unit { int pm, pn; };
struct Gemm { const bf16_t* A; const bf16_t* Bt; int M, N, K; };

struct StaticOrder {
    int nM, nN, nwg, G, c;
    __host__ __device__ void init(int M, int N, int G_, int c_) { nM = M / BM; nN = N / BM; nwg = nM * nN; G = G_; c = c_; }
    __host__ __device__ bool next(int i, Unit& u) const {
        const long L = (long)i * G + c; if (L >= nwg) return false;
        int wgid = (int)L; { const int q = nwg / NXCD, r = nwg % NXCD, xcd = wgid % NXCD, off = wgid / NXCD; wgid = (xcd < r ? xcd * (q + 1) : r * (q + 1) + (xcd - r) * q) + off; }
        const int nig = WGM * nN, gid = wgid / nig, fm = gid * WGM, gsz = (nM - fm) < WGM ? (nM - fm) : WGM;
        u.pm = fm + ((wgid % nig) % gsz); u.pn = (wgid % nig) / gsz; return true;
    }
    __device__ __forceinline__ void a_ready(const Unit&) const {}
    __device__ __forceinline__ void done(const Unit&) const {}
};

__device__ __forceinline__ unsigned cvt_pk_bf16(float lo, float hi) { unsigned r; asm("v_cvt_pk_bf16_f32 %0, %1, %2" : "=v"(r) : "v"(lo), "v"(hi)); return r; }

template <class Epi, class Sched, bool ALIGN_EPI = false, bool SP2 = false>
__device__ __forceinline__ void gemm_phase(PG8_LAS unsigned char* lds, const Gemm g, const Sched& S, const Epi& E) {
    int tid_ = threadIdx.x; asm volatile("" : "+v"(tid_));
    const int tid = tid_, wid = __builtin_amdgcn_readfirstlane(tid >> 6), lane = tid & 63, wr = wid >> 2, wc = wid & 3, fr = lane & 15, fq = lane >> 4;
    const int K = g.K, nt = K / BK;
    unsigned voffA[2], voffB[2];
#pragma unroll
    for (int i = 0; i < 2; ++i) { int R, C; stage_rc(tid * 16 + i * 8192, R, C); const int Rb = Epi::PERM ? ((R & ~31) + perm32(R & 31)) : R;
        voffA[i] = (unsigned)(R * K + C) * 2u; voffB[i] = (unsigned)(Rb * K + C) * 2u; }
    const size_t kstep = (size_t)(BK * 2);
    const size_t hstep = (size_t)HALF * K * 2;
    const size_t tstep = 2 * hstep;
    const unsigned ldsw = (unsigned)wid * 1024u;
    const int aoff = lds_byte(wr * 64 + fr, fq * 8), boff = lds_byte(wc * 32 + fr, fq * 8);
#define PG8_SA(b, h) (((b) * 2 + (h)) * HTB)
#define PG8_SB(b, h) ((4 + (b) * 2 + (h)) * HTB)
#define PG8_STAGE(bufoff, gbase, voff) do { _Pragma("unroll") for (int _i = 0; _i < 2; ++_i) \
        __builtin_amdgcn_global_load_lds((const unsigned*)((const char*)(gbase) + (voff)[_i]), (PG8_LAS unsigned*)(lds + (bufoff) + ldsw + _i * 8192), 16, 0, 0); } while (0)
#define PG8_LDA(dst, b, h) do { _Pragma("unroll") for (int m = 0; m < 4; ++m) _Pragma("unroll") for (int k = 0; k < 2; ++k) dst[m][k] = *(const PG8_LAS bf16x8*)(lds + PG8_SA(b, h) + aoff + m * 2048 + k * 1024); } while (0)
#define PG8_LDB(dst, b, h) do { _Pragma("unroll") for (int n = 0; n < 2; ++n) _Pragma("unroll") for (int k = 0; k < 2; ++k) dst[n][k] = *(const PG8_LAS bf16x8*)(lds + PG8_SB(b, h) + boff + n * 2048 + k * 1024); } while (0)
#define PG8_MMA(ai, bj, At, Bt) do { __builtin_amdgcn_s_setprio(1); _Pragma("unroll") for (int m = 0; m < 4; ++m) _Pragma("unroll") for (int n = 0; n < 2; ++n) _Pragma("unroll") for (int k = 0; k < 2; ++k) \
        acc[ai][bj][m][n] = __builtin_amdgcn_mfma_f32_16x16x32_bf16(Bt[n][k], At[m][k], acc[ai][bj][m][n], 0, 0, 0); __builtin_amdgcn_s_setprio(0); } while (0)
#define PG8_WAIT_V(n) asm volatile("s_waitcnt vmcnt(" #n ")" ::: "memory")
#define PG8_WAIT_L(n) asm volatile("s_waitcnt lgkmcnt(" #n ")" ::: "memory")
#define PG8_BAR __builtin_amdgcn_s_barrier()
#define PG8_SCHED __builtin_amdgcn_sched_barrier(0)
    Unit cur, nxt; int ui = 0;
    if (!S.next(0, cur)) return;
    f32x4 acc[2][2][4][2];
#pragma unroll
    for (int a = 0; a < 2; ++a)
#pragma unroll
        for (int b = 0; b < 2; ++b)
#pragma unroll
            for (int m = 0; m < 4; ++m)
#pragma unroll
                for (int n = 0; n < 2; ++n) acc[a][b][m][n] = (f32x4){0.f, 0.f, 0.f, 0.f};
    bf16x8 At[4][2], B0[2][2], B1[2][2];
    const char* cA = (const char*)g.A + (size_t)cur.pm * tstep; const char* cB = (const char*)g.Bt + (size_t)cur.pn * tstep;
    S.a_ready(cur);
    if constexpr (SP2) {
        PG8_STAGE(PG8_SB(0, 0), cB, voffB); PG8_STAGE(PG8_SB(0, 1), cB + hstep, voffB); PG8_STAGE(PG8_SA(0, 0), cA, voffA); PG8_STAGE(PG8_SA(0, 1), cA + hstep, voffA);
        if (wr == 1) PG8_BAR;
        PG8_WAIT_V(2); PG8_BAR;
        PG8_STAGE(PG8_SB(1, 0), cB + kstep, voffB); PG8_STAGE(PG8_SA(1, 0), cA + kstep, voffA); PG8_STAGE(PG8_SB(1, 1), cB + hstep + kstep, voffB);
        PG8_WAIT_V(6); PG8_BAR;
    } else {
        PG8_STAGE(PG8_SB(0, 0), cB, voffB); PG8_STAGE(PG8_SA(0, 0), cA, voffA); PG8_STAGE(PG8_SB(0, 1), cB + hstep, voffB); PG8_STAGE(PG8_SA(0, 1), cA + hstep, voffA);
        if (wr == 1) PG8_BAR;
        PG8_WAIT_V(4); PG8_BAR;
        PG8_STAGE(PG8_SB(1, 0), cB + kstep, voffB); PG8_STAGE(PG8_SA(1, 0), cA + kstep, voffA); PG8_STAGE(PG8_SB(1, 1), cB + hstep + kstep, voffB);
        PG8_WAIT_V(6); PG8_BAR;
    }
    for (;;) {
        const bool has_next = S.next(ui + 1, nxt);
        const char* nA = has_next ? (const char*)g.A + (size_t)nxt.pm * tstep : cA; const char* nB = has_next ? (const char*)g.Bt + (size_t)nxt.pn * tstep : cB;
        for (int t = 0; t < nt; t += 2) {
            const bool last = (t == nt - 2);
            const char* a1 = cA + (size_t)(t + 1) * kstep;
            const char* a2 = last ? nA : cA + (size_t)(t + 2) * kstep; const char* b2 = last ? nB : cB + (size_t)(t + 2) * kstep;
            const char* a3 = a2 + kstep; const char* b3 = b2 + kstep;
            if (last && has_next) S.a_ready(nxt);
            if constexpr (SP2) {
            PG8_LDB(B0, 0, 0); PG8_LDB(B1, 0, 1); PG8_SCHED; PG8_LDA(At, 0, 0); PG8_STAGE(PG8_SA(1, 1), a1 + hstep, voffA);
            PG8_WAIT_V(8); PG8_WAIT_L(0); PG8_BAR; PG8_MMA(0, 0, At, B0); PG8_MMA(0, 1, At, B1); PG8_BAR; PG8_SCHED;
            PG8_LDA(At, 0, 1); PG8_STAGE(PG8_SB(0, 0), b2, voffB); PG8_STAGE(PG8_SB(0, 1), b2 + hstep, voffB); PG8_STAGE(PG8_SA(0, 0), a2, voffA);
            PG8_WAIT_V(8); PG8_WAIT_L(0); PG8_BAR; PG8_MMA(1, 0, At, B0); PG8_MMA(1, 1, At, B1); PG8_BAR; PG8_SCHED;
            PG8_LDB(B0, 1, 0); PG8_LDB(B1, 1, 1); PG8_SCHED; PG8_LDA(At, 1, 0); PG8_STAGE(PG8_SA(0, 1), a2 + hstep, voffA);
            PG8_WAIT_V(8); PG8_WAIT_L(0); PG8_BAR; PG8_MMA(0, 0, At, B0); PG8_MMA(0, 1, At, B1); PG8_BAR; PG8_SCHED;
            PG8_LDA(At, 1, 1); PG8_STAGE(PG8_SB(1, 0), b3, voffB); PG8_STAGE(PG8_SB(1, 1), b3 + hstep, voffB); PG8_STAGE(PG8_SA(1, 0), a3, voffA);
            PG8_WAIT_V(8); PG8_WAIT_L(0); PG8_BAR; PG8_MMA(1, 0, At, B0); PG8_MMA(1, 1, At, B1); PG8_BAR; PG8_SCHED;
            } else {
            PG8_LDB(B0, 0, 0); PG8_SCHED; PG8_LDA(At, 0, 0); PG8_STAGE(PG8_SA(1, 1), a1 + hstep, voffA);
            PG8_WAIT_L(8); PG8_BAR; PG8_WAIT_L(0); PG8_MMA(0, 0, At, B0); PG8_BAR; PG8_SCHED;
            PG8_LDB(B1, 0, 1); PG8_STAGE(PG8_SB(0, 0), b2, voffB);
            PG8_BAR; PG8_WAIT_L(0); PG8_MMA(0, 1, At, B1); PG8_BAR;
            PG8_LDA(At, 0, 1); PG8_STAGE(PG8_SA(0, 0), a2, voffA);
            PG8_BAR; PG8_WAIT_L(0); PG8_MMA(1, 0, At, B0); PG8_BAR; PG8_SCHED;
            PG8_STAGE(PG8_SB(0, 1), b2 + hstep, voffB);
            PG8_WAIT_V(6); PG8_BAR; PG8_MMA(1, 1, At, B1); PG8_BAR;
            PG8_LDB(B0, 1, 0); PG8_SCHED; PG8_LDA(At, 1, 0); PG8_STAGE(PG8_SA(0, 1), a2 + hstep, voffA);
            PG8_WAIT_L(8); PG8_BAR; PG8_WAIT_L(0); PG8_MMA(0, 0, At, B0); PG8_BAR; PG8_SCHED;
            PG8_LDB(B1, 1, 1); PG8_STAGE(PG8_SB(1, 0), b3, voffB);
            PG8_BAR; PG8_WAIT_L(0); PG8_MMA(0, 1, At, B1); PG8_BAR;
            PG8_LDA(At, 1, 1); PG8_STAGE(PG8_SA(1, 0), a3, voffA);
            PG8_BAR; PG8_WAIT_L(0); PG8_MMA(1, 0, At, B0); PG8_BAR; PG8_SCHED;
            PG8_STAGE(PG8_SB(1, 1), b3 + hstep, voffB);
            PG8_WAIT_V(6); PG8_BAR; PG8_MMA(1, 1, At, B1); PG8_BAR;
            }
        }
        if constexpr (ALIGN_EPI) { if (wr == 0) PG8_BAR; }
        E(acc, cur, wr, wc, fr, fq); S.done(cur);
        if (!has_next) break;
#pragma unroll
        for (int a = 0; a < 2; ++a)
#pragma unroll
            for (int b = 0; b < 2; ++b)
#pragma unroll
                for (int m = 0; m < 4; ++m)
#pragma unroll
                    for (int n = 0; n < 2; ++n) acc[a][b][m][n] = (f32x4){0.f, 0.f, 0.f, 0.f};
        cur = nxt; cA = nA; cB = nB; ++ui;
        if constexpr (ALIGN_EPI) { if (wr == 1) PG8_BAR; }
    }
    PG8_WAIT_V(0);
    if constexpr (!ALIGN_EPI) { if (wr == 0) PG8_BAR; }
    PG8_BAR;
#undef PG8_SA
#undef PG8_SB
#undef PG8_STAGE
#undef PG8_LDA
#undef PG8_LDB
#undef PG8_MMA
#undef PG8_WAIT_V
#undef PG8_WAIT_L
#undef PG8_BAR
#undef PG8_SCHED
}
}

constexpr int NWAVES = 8, NTHR = 512;
constexpr int M = 24576, MP = 16384, DM = 2048, NIN = 3584, DFF = 5632;
constexpr int COL_K = 1024, COL_V = 1280, COL_U = 1536, COL_GV = 2560;
constexpr int NGC = 192;
constexpr float LN_EPS = 1e-5f;
constexpr float ALPHA = 1.189207115002721f;
constexpr float LOG2E = 1.4426950408889634f;

constexpr size_t MiB = 1u << 20;
constexpr size_t WS_WSB = 0, WS_GST = 512 * 1024, WS_BAR = 768 * 1024;
constexpr size_t WS_WIN = 1 * MiB, WS_WO = 15 * MiB, WS_W13 = 23 * MiB, WS_W2 = 67 * MiB, WS_ST1 = 89 * MiB;
constexpr size_t WS_XB = 90 * MiB;
constexpr size_t WS_H = 186 * MiB;
constexpr size_t WS_MIX = 354 * MiB;
constexpr size_t WS_HID = 186 * MiB;
constexpr size_t WS_END = 450 * MiB;
static_assert(WS_H + (size_t)M * NIN * 2 == WS_MIX && WS_MIX + (size_t)M * DM * 2 == WS_END && WS_HID + (size_t)M * DFF * 2 == WS_END, "ws map");

constexpr int LDS_BYTES = 131072 + 4096;

#define GAS __attribute__((address_space(1)))
#define LAS __attribute__((address_space(3)))
typedef unsigned short bf16;
typedef unsigned v4u __attribute__((ext_vector_type(4)));
typedef unsigned v2u __attribute__((ext_vector_type(2)));
typedef float f32x4 __attribute__((ext_vector_type(4)));
typedef float f32x2 __attribute__((ext_vector_type(2)));
typedef short bf16x8 __attribute__((ext_vector_type(8)));
using pg8::cvt_pk_bf16;
#define LDS_WAIT() asm volatile("s_waitcnt lgkmcnt(0)" ::: "memory")
__device__ __forceinline__ float bf_lo(unsigned w) { return __uint_as_float(w << 16); }
__device__ __forceinline__ float bf_hi(unsigned w) { return __uint_as_float(w & 0xffff0000u); }
__device__ __forceinline__ float wave_sum(float v) {
#pragma unroll
    for (int o = 1; o < 64; o <<= 1) v += __shfl_xor(v, o);
    return v;
}
__device__ __forceinline__ float gelu_tanh(float x) {
    const float t = x * (-2.3022082f + (-0.10294324f) * x * x);
    return x * __builtin_amdgcn_rcpf(1.0f + __builtin_amdgcn_exp2f(t));
}
__device__ __forceinline__ float silu_f(float x) { return x * __builtin_amdgcn_rcpf(1.0f + __builtin_amdgcn_exp2f(-LOG2E * x)); }

struct EpiH {
    static constexpr bool PERM = true;
    bf16* O; float* gst;
    __device__ __forceinline__ void operator()(const f32x4 (&acc)[2][2][4][2], const pg8::Unit& u, int wr, int wc, int fr, int fq) const {
        const int row0 = u.pm * 256 + wr * 64 + fr, col0 = u.pn * 256 + wc * 32 + 8 * fq;
        const bool act = u.pn >= 6, stat = u.pn >= 10;
#pragma unroll
        for (int ai = 0; ai < 2; ++ai)
#pragma unroll
            for (int m = 0; m < 4; ++m) { bf16* rowp = O + (size_t)(row0 + ai * 128 + m * 16) * NIN + col0;
                float rs = 0.f, rq = 0.f;
#pragma unroll
                for (int bj = 0; bj < 2; ++bj) { f32x4 v0 = acc[ai][bj][m][0], v1 = acc[ai][bj][m][1];
                    if (act) {
#pragma unroll
                        for (int i = 0; i < 4; ++i) { v0[i] = gelu_tanh(v0[i]); v1[i] = gelu_tanh(v1[i]); } }
                    v4u w; w.x = cvt_pk_bf16(v0[0], v0[1]); w.y = cvt_pk_bf16(v0[2], v0[3]); w.z = cvt_pk_bf16(v1[0], v1[1]); w.w = cvt_pk_bf16(v1[2], v1[3]);
                    *(v4u*)(rowp + bj * 128) = w;
                    if (stat) {
#pragma unroll
                        for (int t = 0; t < 4; ++t) { const float a = bf_lo(w[t]), b = bf_hi(w[t]); rs += a + b; rq += a * a + b * b; } } }
                if (stat) { rs += __shfl_xor(rs, 16); rs += __shfl_xor(rs, 32); rq += __shfl_xor(rq, 16); rq += __shfl_xor(rq, 32);
                    if (fq == 0) { float* gp = gst + 2 * (size_t)(row0 + ai * 128 + m * 16); __hip_atomic_fetch_add(gp, rs, __ATOMIC_RELAXED, __HIP_MEMORY_SCOPE_AGENT); __hip_atomic_fetch_add(gp + 1, rq, __ATOMIC_RELAXED, __HIP_MEMORY_SCOPE_AGENT); } } }
    }
};
struct EpiY1 {
    static constexpr bool PERM = false;
    const float* xp; const float* xs; float* Y;
    __device__ __forceinline__ void operator()(const f32x4 (&acc)[2][2][4][2], const pg8::Unit& u, int wr, int wc, int fr, int fq) const {
        const int row0 = u.pm * 256 + wr * 64 + fr, col0 = u.pn * 256 + wc * 32 + 4 * fq;
        const float* xb = (u.pm < MP / 256) ? xp : xs - (size_t)MP * DM;
#pragma unroll
        for (int ai = 0; ai < 2; ++ai)
#pragma unroll
            for (int m = 0; m < 4; ++m) { const size_t off = (size_t)(row0 + ai * 128 + m * 16) * DM + col0;
#pragma unroll
                for (int bj = 0; bj < 2; ++bj)
#pragma unroll
                    for (int n = 0; n < 2; ++n) { const f32x4 xv = *(const f32x4*)(xb + off + bj * 128 + n * 16);
                        *(f32x4*)(Y + off + bj * 128 + n * 16) = xv * ALPHA + acc[ai][bj][m][n]; } }
    }
};
struct EpiHid {
    static constexpr bool PERM = true;
    bf16* O;
    __device__ __forceinline__ void operator()(const f32x4 (&acc)[2][2][4][2], const pg8::Unit& u, int wr, int wc, int fr, int fq) const {
        const int row0 = u.pm * 256 + wr * 64 + fr, col0 = u.pn * 128 + wc * 32 + 8 * fq;
#pragma unroll
        for (int ai = 0; ai < 2; ++ai)
#pragma unroll
            for (int m = 0; m < 4; ++m) {
                const f32x4 g0 = acc[ai][0][m][0], g1 = acc[ai][0][m][1], u0 = acc[ai][1][m][0], u1 = acc[ai][1][m][1];
                float h[8];
#pragma unroll
                for (int i = 0; i < 4; ++i) { h[i] = silu_f(g0[i]) * u0[i]; h[4 + i] = silu_f(g1[i]) * u1[i]; }
                v4u w; w.x = cvt_pk_bf16(h[0], h[1]); w.y = cvt_pk_bf16(h[2], h[3]); w.z = cvt_pk_bf16(h[4], h[5]); w.w = cvt_pk_bf16(h[6], h[7]);
                *(v4u*)(O + (size_t)(row0 + ai * 128 + m * 16) * DFF + col0) = w; }
    }
};
struct EpiY2 {
    static constexpr bool PERM = false;
    float* Y; const float* st1; const float* g1; const float* b1;
    __device__ __forceinline__ void operator()(const f32x4 (&acc)[2][2][4][2], const pg8::Unit& u, int wr, int wc, int fr, int fq) const {
        const int row0 = u.pm * 256 + wr * 64 + fr, col0 = u.pn * 256 + wc * 32 + 4 * fq;
        f32x4 gv[2][2], bv[2][2];
#pragma unroll
        for (int bj = 0; bj < 2; ++bj)
#pragma unroll
            for (int n = 0; n < 2; ++n) { gv[bj][n] = *(const f32x4*)(g1 + col0 + bj * 128 + n * 16) * ALPHA; bv[bj][n] = *(const f32x4*)(b1 + col0 + bj * 128 + n * 16) * ALPHA; }
#pragma unroll
        for (int ai = 0; ai < 2; ++ai)
#pragma unroll
            for (int m = 0; m < 4; ++m) { const int r = row0 + ai * 128 + m * 16; const size_t off = (size_t)r * DM + col0;
                const f32x2 st = *(const f32x2*)(st1 + 2 * r);
#pragma unroll
                for (int bj = 0; bj < 2; ++bj)
#pragma unroll
                    for (int n = 0; n < 2; ++n) { const f32x4 yv = *(const f32x4*)(Y + off + bj * 128 + n * 16);
                        *(f32x4*)(Y + off + bj * 128 + n * 16) = ((yv - st.x) * st.y) * gv[bj][n] + bv[bj][n] + acc[ai][bj][m][n]; } }
    }
};

__device__ __forceinline__ void p0_transpose_item(const float* W, int K, int N, bf16* WT, int drow0, int k0, int n0, LAS float* scr, int lane) {
    float v[32];
    const float* wp = W + (size_t)(k0 + (lane >> 5)) * N + n0 + (lane & 31);
#pragma unroll
    for (int i = 0; i < 32; ++i) v[i] = wp[(size_t)(2 * i) * N];
#pragma unroll
    for (int i = 0; i < 32; ++i) scr[(2 * i + (lane >> 5)) * 33 + (lane & 31)] = v[i];
    LDS_WAIT(); asm volatile("" ::: "memory");
    const int c = lane & 7;
#pragma unroll
    for (int j = 0; j < 4; ++j) { const int n = (lane >> 3) + 8 * j; const LAS float* s = scr + (8 * c) * 33 + n;
        v4u o; o.x = cvt_pk_bf16(s[0 * 33], s[1 * 33]); o.y = cvt_pk_bf16(s[2 * 33], s[3 * 33]); o.z = cvt_pk_bf16(s[4 * 33], s[5 * 33]); o.w = cvt_pk_bf16(s[6 * 33], s[7 * 33]);
        *(v4u*)(WT + (size_t)(drow0 + n) * K + k0 + 8 * c) = o; }
    LDS_WAIT(); asm volatile("" ::: "memory");
}

struct Args { const float* in[16]; float* out; unsigned char* ws; };

template <bool FINAL>
__device__ __forceinline__ void ln_rows(const float* src, float* dstf, bf16* dstb, float* stats, const float* g, const float* b, int gw, int NGW, int lane) {
    f32x4 gg[8], bb[8];
#pragma unroll
    for (int j = 0; j < 8; ++j) { gg[j] = ((const f32x4*)g)[lane + 64 * j]; bb[j] = ((const f32x4*)b)[lane + 64 * j]; }
    for (int m = gw; m < M; m += NGW) {
        const f32x4* xr = (const f32x4*)(src + (size_t)m * DM) + lane;
        f32x4 v[8]; float s = 0.f;
#pragma unroll
        for (int j = 0; j < 8; ++j) { v[j] = xr[64 * j]; s += (v[j].x + v[j].y) + (v[j].z + v[j].w); }
        const float mean = wave_sum(s) * (1.f / DM); float s2 = 0.f;
#pragma unroll
        for (int j = 0; j < 8; ++j) { v[j] = v[j] - mean; s2 += (v[j].x * v[j].x + v[j].y * v[j].y) + (v[j].z * v[j].z + v[j].w * v[j].w); }
        const float rstd = 1.f / sqrtf(wave_sum(s2) * (1.f / DM) + LN_EPS);
        if (FINAL) {
            f32x4* o = (f32x4*)(dstf + (size_t)m * DM) + lane;
#pragma unroll
            for (int j = 0; j < 8; ++j) o[64 * j] = (v[j] * rstd) * gg[j] + bb[j];
        } else {
            v2u* o = (v2u*)(dstb + (size_t)m * DM) + lane;
#pragma unroll
            for (int j = 0; j < 8; ++j) { const f32x4 y = (v[j] * rstd) * gg[j] + bb[j]; v2u w; w.x = cvt_pk_bf16(y.x, y.y); w.y = cvt_pk_bf16(y.z, y.w); o[64 * j] = w; }
            if (lane == 0) { stats[2 * m] = mean; stats[2 * m + 1] = rstd; }
        }
    }
}

constexpr int VT_PITCH = 784;
__device__ __forceinline__ void attn_head_scores(const LAS unsigned char* kbase, const bf16x8 (&qf)[4], int swz, int p0, float rel0f, float nslope2, float sink2, float pen0, float pen2, v4u (&pf)[9], float& inv) {
    f32x4 S[18];
#pragma unroll
    for (int j = 0; j < 18; ++j) {
        S[j] = (f32x4){0.f, 0.f, 0.f, 0.f};
#pragma unroll
        for (int ks = 0; ks < 4; ++ks) { const bf16x8 kf = *(const LAS bf16x8*)(kbase + (j >> 1) * 8192 + (j & 1) * 1024 + (((4 * ks) ^ swz) << 4));
            S[j] = __builtin_amdgcn_mfma_f32_16x16x32_bf16(kf, qf[ks], S[j], 0, 0, 0); }
        if (j & 1) __builtin_amdgcn_sched_barrier(0);
    }
    const float sc2 = 0.08838834764831845f * LOG2E;
    float mx = sink2;
    asm volatile("" : "+v"(rel0f));
#pragma unroll
    for (int t = 0; t < 9; ++t) { const int p = p0 + t; const float pen = p < 4 ? pen0 : (p >= 8 ? pen2 : 0.f);
#pragma unroll
        for (int e = 0; e < 2; ++e)
#pragma unroll
            for (int i = 0; i < 4; ++i) { const float relf = rel0f + (float)(32 * t + 4 * e + i);
                float sv = __builtin_fmaf(S[2 * t + e][i], sc2, __builtin_fmaf(__builtin_fabsf(relf), nslope2, pen));
                if (t == 0 || t == 8) sv = (__builtin_fabsf(relf) > 128.f) ? -1e30f : sv;
                S[2 * t + e][i] = sv; mx = fmaxf(mx, sv); } }
    mx = fmaxf(mx, __shfl_xor(mx, 16)); mx = fmaxf(mx, __shfl_xor(mx, 32));
    float sum = 0.f;
#pragma unroll
    for (int j = 0; j < 18; ++j)
#pragma unroll
        for (int i = 0; i < 4; ++i) { const float p = __builtin_amdgcn_exp2f(S[j][i] - mx); S[j][i] = p; sum += p; }
    sum += __shfl_xor(sum, 16); sum += __shfl_xor(sum, 32);
    inv = 1.0f / (sum + __builtin_amdgcn_exp2f(sink2 - mx));
#pragma unroll
    for (int t = 0; t < 9; ++t) { pf[t].x = cvt_pk_bf16(S[2 * t][0], S[2 * t][1]); pf[t].y = cvt_pk_bf16(S[2 * t][2], S[2 * t][3]);
        pf[t].z = cvt_pk_bf16(S[2 * t + 1][0], S[2 * t + 1][1]); pf[t].w = cvt_pk_bf16(S[2 * t + 1][2], S[2 * t + 1][3]); }
}
__device__ __forceinline__ void attn_head_pv(const LAS unsigned char* vbase, const v4u (&pf)[9], float inv, bf16* Og) {
#pragma unroll
    for (int dt = 0; dt < 8; ++dt) {
        f32x4 o = (f32x4){0.f, 0.f, 0.f, 0.f};
#pragma unroll
        for (int t = 0; t < 9; ++t) { const bf16x8 vf = *(const LAS bf16x8*)(vbase + 16 * dt * VT_PITCH + 64 * t);
            o = __builtin_amdgcn_mfma_f32_16x16x32_bf16(vf, __builtin_bit_cast(bf16x8, pf[t]), o, 0, 0, 0); }
        v2u w; w.x = cvt_pk_bf16(o[0] * inv, o[1] * inv); w.y = cvt_pk_bf16(o[2] * inv, o[3] * inv);
        *(v2u*)(Og + 16 * dt) = w;
        __builtin_amdgcn_sched_barrier(0);
    }
}
__device__ __forceinline__ void vt_write(LAS unsigned char* lds, const v4u (&in)[8], int dblk, int key0) {
#pragma unroll
    for (int i = 0; i < 8; ++i) { v4u o;
#pragma unroll
        for (int t = 0; t < 4; ++t) { const unsigned a = in[2 * t][i >> 1], b = in[2 * t + 1][i >> 1];
            o[t] = (i & 1) ? ((a >> 16) | (b & 0xffff0000u)) : ((a & 0xffffu) | (b << 16)); }
        *(LAS v4u*)(lds + (8 * dblk + i) * VT_PITCH + key0 * 2) = o; }
}
__device__ __forceinline__ void attn_unit(LAS unsigned char* lds, const bf16* H, bf16* MIX, const float* sink, int gc, int kv, int hp) {
    int tid_ = threadIdx.x; asm volatile("" : "+v"(tid_));
    const int tid = tid_, lane = tid & 63, wave = __builtin_amdgcn_readfirstlane(tid >> 6);
    const int c = gc & 15, fr = lane & 15, fq = lane >> 4, hA = 4 * kv + 2 * hp, hB = hA + 1;
    const int rowq0 = gc * 128, roww0 = rowq0 - 128;
    const bool v0 = (c != 0), v2 = (c != 15);
    const int p0 = wave >> 1;
    __syncthreads();
    {
        const bf16* Kg = H + COL_K + 128 * kv;
#pragma unroll
        for (int it = 0; it < 12; ++it) { const int ch = tid + it * NTHR, row = ch >> 4, cc = ch & 15, kb = row >> 7;
            const int grow = roww0 + row + ((kb == 0 && !v0) ? 128 : 0) - ((kb == 2 && !v2) ? 128 : 0);
            const v4u v = *(const v4u*)(Kg + (size_t)grow * NIN + cc * 8);
            const int g = (((row >> 3) & 3) << 2) | (row & 3);
            *(LAS v4u*)(lds + row * 256 + ((cc ^ g) << 4)) = v; }
    }
    bf16x8 qfA[4], qfB[4];
    { const bf16* Qg = H + (size_t)(rowq0 + 16 * wave + fr) * NIN + 128 * hA + 8 * fq;
#pragma unroll
      for (int ks = 0; ks < 4; ++ks) { qfA[ks] = *(const bf16x8*)(Qg + 32 * ks); qfB[ks] = *(const bf16x8*)(Qg + 128 + 32 * ks); } }
    const int r = tid & 255, sblk = r >> 4, dblk = r & 15;
    v4u vin0[8], vin1[8];
    { const bf16* Vg = H + COL_V + 128 * kv + 8 * dblk;
      const int kb = tid >> 8, key0 = 128 * kb + 8 * sblk, grow = roww0 + key0 + ((kb == 0 && !v0) ? 128 : 0);
#pragma unroll
      for (int jj = 0; jj < 8; ++jj) vin0[jj] = *(const v4u*)(Vg + (size_t)(grow + jj) * NIN);
      if (wave < 4) { const int grow2 = roww0 + 256 + 8 * sblk - (v2 ? 0 : 128);
#pragma unroll
          for (int jj = 0; jj < 8; ++jj) vin1[jj] = *(const v4u*)(Vg + (size_t)(grow2 + jj) * NIN); } }
    __syncthreads();
    const int qi = 16 * wave + fr;
    float rel0f = (float)(32 * p0 + 8 * fq - 128 - qi);
    asm volatile("" : "+v"(rel0f));
    const float pen0 = v0 ? 0.f : -1e30f, pen2 = v2 ? 0.f : -1e30f;
    const LAS unsigned char* kbase = lds + (32 * p0 + 8 * (fr >> 2) + (fr & 3)) * 256;
    const int swz = fq ^ fr;
    v4u pfA[9], pfB[9]; float invA, invB;
    attn_head_scores(kbase, qfA, swz, p0, rel0f, -__builtin_amdgcn_exp2f(-(float)(hA + 1)) * LOG2E, sink[hA] * LOG2E, pen0, pen2, pfA, invA);
    attn_head_scores(kbase, qfB, swz, p0, rel0f, -__builtin_amdgcn_exp2f(-(float)(hB + 1)) * LOG2E, sink[hB] * LOG2E, pen0, pen2, pfB, invB);
    __syncthreads();
    vt_write(lds, vin0, dblk, 128 * (tid >> 8) + 8 * sblk);
    if (wave < 4) vt_write(lds, vin1, dblk, 256 + 8 * sblk);
    __syncthreads();
    const LAS unsigned char* vbase = lds + fr * VT_PITCH + 64 * p0 + 16 * fq;
    bf16* Og = MIX + (size_t)(rowq0 + 16 * wave + fr) * DM + 128 * hA + 4 * fq;
    attn_head_pv(vbase, pfA, invA, Og);
    attn_head_pv(vbase, pfB, invB, Og + 128);
}

constexpr int GT_PITCH = 272, GT_BYTES = 128 * GT_PITCH;
__device__ __forceinline__ void sgu_pair(LAS unsigned char* lds, const bf16* H, bf16* MIX, const float* lng, const float* lnb, const bf16* wsb, const float* b_s, const float* gst, int gc, int gp) {
    int tid_ = threadIdx.x; asm volatile("" : "+v"(tid_));
    const int tid = tid_, lane = tid & 63, wave = __builtin_amdgcn_readfirstlane(tid >> 6);
    const int r0 = gc * 128, fr = lane & 15, fq = lane >> 4;
    __syncthreads();
    { const int gsel = tid >> 8, r = tid & 255, sblk = r >> 4, dblk = r & 15, g = 2 * gp + gsel, ch0 = 128 * g + 8 * dblk;
      const f32x4 ga = *(const f32x4*)(lng + ch0), gb = *(const f32x4*)(lng + ch0 + 4), ba = *(const f32x4*)(lnb + ch0), bb = *(const f32x4*)(lnb + ch0 + 4);
      const float gam[8] = {ga.x, ga.y, ga.z, ga.w, gb.x, gb.y, gb.z, gb.w}, bet[8] = {ba.x, ba.y, ba.z, ba.w, bb.x, bb.y, bb.z, bb.w};
      v4u in[8]; f32x2 st[8];
#pragma unroll
      for (int jj = 0; jj < 8; ++jj) { in[jj] = *(const v4u*)(H + (size_t)(r0 + 8 * sblk + jj) * NIN + COL_GV + ch0); st[jj] = *(const f32x2*)(gst + 2 * (size_t)(r0 + 8 * sblk + jj)); }
#pragma unroll
      for (int jj = 0; jj < 8; ++jj) { const float mean = st[jj].x * (1.f / 1024.f), var = fmaxf(st[jj].y * (1.f / 1024.f) - mean * mean, 0.f); st[jj].x = mean; st[jj].y = 1.f / sqrtf(var + LN_EPS); }
#pragma unroll
      for (int i = 0; i < 8; ++i) { v4u o;
#pragma unroll
          for (int t = 0; t < 4; ++t) { const unsigned a = in[2 * t][i >> 1], b = in[2 * t + 1][i >> 1];
              const float xa = (i & 1) ? bf_hi(a) : bf_lo(a), xb = (i & 1) ? bf_hi(b) : bf_lo(b);
              o[t] = cvt_pk_bf16((xa - st[2 * t].x) * st[2 * t].y * gam[i] + bet[i], (xb - st[2 * t + 1].x) * st[2 * t + 1].y * gam[i] + bet[i]); }
          *(LAS v4u*)(lds + gsel * GT_BYTES + (8 * dblk + i) * GT_PITCH + 16 * sblk) = o; } }
    const int gsel = wave >> 2, tq = wave & 3, g = 2 * gp + gsel;
    bf16x8 wf[2][4];
#pragma unroll
    for (int tt = 0; tt < 2; ++tt)
#pragma unroll
        for (int ks = 0; ks < 4; ++ks) wf[tt][ks] = *(const bf16x8*)(wsb + (size_t)(g * 128 + 32 * tq + 16 * tt + fr) * 128 + 32 * ks + 8 * fq);
    __syncthreads();
    const LAS unsigned char* Gb = lds + gsel * GT_BYTES + fr * GT_PITCH + 16 * fq;
    const float bias0 = b_s[g * 128 + 32 * tq + fr], bias1 = b_s[g * 128 + 32 * tq + 16 + fr];
#pragma unroll
    for (int dt = 0; dt < 8; ++dt) {
        f32x4 a0 = (f32x4){0.f, 0.f, 0.f, 0.f}, a1 = a0;
#pragma unroll
        for (int ks = 0; ks < 4; ++ks) { const bf16x8 gf = *(const LAS bf16x8*)(Gb + 16 * dt * GT_PITCH + 64 * ks);
            a0 = __builtin_amdgcn_mfma_f32_16x16x32_bf16(gf, wf[0][ks], a0, 0, 0, 0);
            a1 = __builtin_amdgcn_mfma_f32_16x16x32_bf16(gf, wf[1][ks], a1, 0, 0, 0); }
#pragma unroll
        for (int tt = 0; tt < 2; ++tt) { const int t = 32 * tq + 16 * tt + fr; const float bias = tt ? bias1 : bias0; const f32x4 a = tt ? a1 : a0;
            const v2u uu = *(const v2u*)(H + (size_t)(r0 + t) * NIN + COL_U + 128 * g + 16 * dt + 4 * fq);
            v2u w; w.x = cvt_pk_bf16(bf_lo(uu.x) * (a[0] + bias), bf_hi(uu.x) * (a[1] + bias)); w.y = cvt_pk_bf16(bf_lo(uu.y) * (a[2] + bias), bf_hi(uu.y) * (a[3] + bias));
            *(v2u*)(MIX + (size_t)(r0 + t) * DM + 1024 + 128 * g + 16 * dt + 4 * fq) = w; }
    }
}

#define XB_TMO      128
#define XB_XCNT(j)  (256  + 64 * (j))
#define XB_XSUB(j)  (1280 + 64 * (j))
#define XB_XGEN(j)  (2304 + 64 * (j))
#define XB_TOP      3328
#define XB_TOPGEN   3392
#define XCD_BAR_WORDS 3456
#define XB_SPIN_CAP (1u << 18)
__device__ __forceinline__ unsigned xb_ld(unsigned* p)              { return __hip_atomic_load(p, __ATOMIC_RELAXED, __HIP_MEMORY_SCOPE_AGENT); }
__device__ __forceinline__ unsigned xb_add(unsigned* p, unsigned v) { return __hip_atomic_fetch_add(p, v, __ATOMIC_RELAXED, __HIP_MEMORY_SCOPE_AGENT); }
__device__ __forceinline__ unsigned xb_xcc_id() { return (unsigned)__builtin_amdgcn_s_getreg((3 << 11) | 20) & 0xFu; }
#define XB_SPIN(cond, bar) do { unsigned _sp = 0; while (cond) { __builtin_amdgcn_s_sleep(1); \
    if ((++_sp & 255u) == 0u) { if (xb_ld(&(bar)[XB_TMO])) break; if (_sp > XB_SPIN_CAP) { atomicAdd(&(bar)[XB_TMO], 1u); break; } } } } while (0)
struct XcdBarrier { unsigned* bar; unsigned x; volatile LAS unsigned* st; };
__device__ __forceinline__ XcdBarrier xcd_barrier_post(unsigned* bar, volatile LAS unsigned* st) {
    XcdBarrier b; b.bar = bar; b.x = xb_xcc_id(); b.st = st;
    if (threadIdx.x == 0) (void)xb_add(&bar[XB_XCNT(b.x)], 1u);
    return b;
}
__device__ __forceinline__ void xcd_barrier_complete(unsigned* bar, unsigned x, unsigned& nloc, unsigned& nx) {
    const unsigned G = gridDim.x * gridDim.y * gridDim.z;
    unsigned sum, cnt, mine, sp = 0u;
    for (;;) {
        sum = 0u; cnt = 0u; mine = 0u;
#pragma unroll
        for (unsigned j = 0; j < 16; ++j) { const unsigned c = xb_ld(&bar[XB_XCNT(j)]); sum += c; cnt += (c > 0u) ? 1u : 0u; mine = (j == x) ? c : mine; }
        if (sum == G) break;
        __builtin_amdgcn_s_sleep(1);
        if ((++sp & 255u) == 0u) { if (xb_ld(&bar[XB_TMO])) break; if (sp > XB_SPIN_CAP) { atomicAdd(&bar[XB_TMO], 1u); break; } }
    }
    nloc = mine > 0u ? mine : 1u; nx = cnt > 0u ? cnt : 1u;
}
__device__ __forceinline__ void xcd_barrier(const XcdBarrier& b) {
    asm volatile("s_waitcnt vmcnt(0)" ::: "memory");
    __syncthreads();
    if (threadIdx.x == 0) {
        unsigned* bar = b.bar;
        __builtin_amdgcn_s_waitcnt(0);
        unsigned nloc = b.st[0], nx = b.st[1];
        if (nloc == 0u) { xcd_barrier_complete(bar, b.x, nloc, nx); b.st[0] = nloc; b.st[1] = nx; }
        const unsigned old = xb_add(&bar[XB_XSUB(b.x)], 1u);
        const unsigned gen = old / nloc;
        if (old + 1u == (gen + 1u) * nloc) {
            __builtin_amdgcn_fence(__ATOMIC_RELEASE, "agent");
            asm volatile("s_waitcnt vmcnt(0)" ::: "memory");
            const unsigned og = xb_add(&bar[XB_TOP], 1u);
            const unsigned tg = og / nx;
            if (og + 1u == (tg + 1u) * nx) xb_add(&bar[XB_TOPGEN], 1u);
            else XB_SPIN(xb_ld(&bar[XB_TOPGEN]) == tg, bar);
            __builtin_amdgcn_fence(__ATOMIC_ACQUIRE, "agent");
            xb_add(&bar[XB_XGEN(b.x)], 1u);
            asm volatile("s_waitcnt vmcnt(0)" ::: "memory");
        } else {
            XB_SPIN(xb_ld(&bar[XB_XGEN(b.x)]) == gen, bar);
            __builtin_amdgcn_fence(__ATOMIC_ACQUIRE, "agent");
            asm volatile("s_waitcnt vmcnt(0)" ::: "memory");
        }
    }
    __syncthreads();
}

#ifndef PH_MASK
#define PH_MASK 0xff
#endif
#ifndef DUP_MASK
#define DUP_MASK 0
#endif
#define GSYNC() xcd_barrier(xbar)
#define REP(k) for (int rep_ = 0; rep_ < (((DUP_MASK >> (k)) & 1) ? 2 : 1); ++rep_, (rep_ < (((DUP_MASK >> (k)) & 1) ? 2 : 1) ? GSYNC() : (void)0))
__global__ void __launch_bounds__(NTHR, 2) fwd_megakernel(Args args) {
    extern __shared__ __attribute__((aligned(16))) unsigned char lds_raw[];
    cg::grid_group grid = cg::this_grid();
    LAS unsigned char* lds = (LAS unsigned char*)lds_raw;
    const int tid = threadIdx.x, lane = tid & 63, wave = __builtin_amdgcn_readfirstlane(tid >> 6);
    const int G = gridDim.x, bx = blockIdx.x;
    const int vcu = (G % 8 == 0) ? (bx % 8) * (G / 8) + bx / 8 : bx;
    unsigned char* ws = args.ws;
    const float* xp = args.in[0]; const float* xs = args.in[1];
    const float* w_in = args.in[2]; const float* ln_sgu_g = args.in[3]; const float* ln_sgu_b = args.in[4]; const float* w_s = args.in[5]; const float* b_s = args.in[6];
    const float* sink = args.in[7]; const float* w_o = args.in[8]; const float* ln1_g = args.in[9]; const float* ln1_b = args.in[10];
    const float* w_gate = args.in[11]; const float* w_up = args.in[12]; const float* w_down = args.in[13]; const float* ln2_g = args.in[14]; const float* ln2_b = args.in[15];
    float* out = args.out;
    bf16* WIN_T = (bf16*)(ws + WS_WIN); bf16* WO_T = (bf16*)(ws + WS_WO); bf16* W13_T = (bf16*)(ws + WS_W13); bf16* W2_T = (bf16*)(ws + WS_W2);
    float* ST1 = (float*)(ws + WS_ST1); float* GST = (float*)(ws + WS_GST); bf16* WSB = (bf16*)(ws + WS_WSB);
    bf16* XB = (bf16*)(ws + WS_XB); bf16* Hb = (bf16*)(ws + WS_H); bf16* MIX = (bf16*)(ws + WS_MIX); bf16* HID = (bf16*)(ws + WS_HID);
    const int gw = vcu * NWAVES + wave, NGW = G * NWAVES;
    if (tid < 2) ((volatile LAS unsigned*)(lds + 131072 + 2048))[tid] = 0u;
    if (bx == 0) for (int i = tid; i < XCD_BAR_WORDS; i += NTHR) ((unsigned*)(ws + WS_BAR))[i] = 0u;
    __syncthreads();

    if constexpr ((PH_MASK & 1) != 0) {
        LAS float* scr = (LAS float*)(lds + wave * 16384);
        constexpr int I_IN = (DM / 64) * (NIN / 32);
        for (int it = gw; it < I_IN; it += NGW) { const int nb = it % (NIN / 32), kb = it / (NIN / 32); p0_transpose_item(w_in, DM, NIN, WIN_T, 32 * nb, 64 * kb, 32 * nb, scr, lane); }
        { const int gt = bx * NTHR + tid;
          if (gt < M * 2 / 4) ((f32x4*)GST)[gt] = (f32x4){0.f, 0.f, 0.f, 0.f};
          if (gt < 8 * 128 * 128 / 8) { const f32x4 a = *(const f32x4*)(w_s + 8 * gt), b = *(const f32x4*)(w_s + 8 * gt + 4);
              v4u w; w.x = cvt_pk_bf16(a.x, a.y); w.y = cvt_pk_bf16(a.z, a.w); w.z = cvt_pk_bf16(b.x, b.y); w.w = cvt_pk_bf16(b.z, b.w); *(v4u*)(WSB + 8 * gt) = w; } }
        const size_t n8 = (size_t)M * DM / 8, nthr = (size_t)G * NTHR;
        for (size_t i = (size_t)bx * NTHR + tid; i < n8; i += nthr) { const size_t e = i * 8;
            const float* src = (e < (size_t)MP * DM) ? xp + e : xs + (e - (size_t)MP * DM);
            const f32x4 a = *(const f32x4*)src, b = *(const f32x4*)(src + 4);
            v4u w; w.x = cvt_pk_bf16(a.x, a.y); w.y = cvt_pk_bf16(a.z, a.w); w.z = cvt_pk_bf16(b.x, b.y); w.w = cvt_pk_bf16(b.z, b.w);
            *(v4u*)(XB + e) = w; }
    }
    grid.sync();
    const XcdBarrier xbar = xcd_barrier_post((unsigned*)(ws + WS_BAR), (volatile LAS unsigned*)(lds + 131072 + 2048));
    REP(1) if constexpr ((PH_MASK & 2) != 0) { pg8::Gemm g{XB, WIN_T, M, NIN, DM}; pg8::StaticOrder S; S.init(M, NIN, G, bx); EpiH E{Hb, GST};
      pg8::gemm_phase<EpiH, pg8::StaticOrder, true, true>(lds, g, S, E);
      const int nfull = (M / 256) * (NIN / 256) / G, nrem = (M / 256) * (NIN / 256) - nfull * G;
      if (bx >= nrem) {
          LAS float* scr = (LAS float*)(lds + wave * 16384);
          constexpr int I_O = (DM / 64) * (DM / 32), I_G = (DM / 64) * (DFF / 32), I_D = (DFF / 64) * (DM / 32);
          const int cw = (bx - nrem) * NWAVES + wave, NCW = (G - nrem) * NWAVES;
          for (int it = cw; it < I_O + 2 * I_G + I_D; it += NCW) {
              int r = it;
              if (r < I_O) { const int nb = r % (DM / 32), kb = r / (DM / 32); p0_transpose_item(w_o, DM, DM, WO_T, 32 * nb, 64 * kb, 32 * nb, scr, lane); continue; } r -= I_O;
              if (r < 2 * I_G) { const int up = r >= I_G ? 1 : 0; if (up) r -= I_G; const int nb = r % (DFF / 32), kb = r / (DFF / 32), n0 = 32 * nb;
                  p0_transpose_item(up ? w_up : w_gate, DM, DFF, W13_T, (n0 >> 7) * 256 + up * 128 + (n0 & 127), 64 * kb, n0, scr, lane); continue; } r -= 2 * I_G;
              { const int nb = r % (DM / 32), kb = r / (DM / 32); p0_transpose_item(w_down, DFF, DM, W2_T, 32 * nb, 64 * kb, 32 * nb, scr, lane); }
          }
      } }
    GSYNC();
    REP(2) if constexpr ((PH_MASK & 4) != 0) {
      for (int it = vcu; it < NGC * 8; it += G) {
#ifndef NO_ATTN
        if (it < NGC * 4) { attn_unit(lds, Hb, MIX, sink, it >> 2, (it >> 1) & 1, it & 1); if (DUP_MASK & 64) attn_unit(lds, Hb, MIX, sink, it >> 2, (it >> 1) & 1, it & 1); }
#endif
#ifndef NO_SGU
        if (it >= NGC * 4) { const int a = it - NGC * 4; sgu_pair(lds, Hb, MIX, ln_sgu_g, ln_sgu_b, WSB, b_s, GST, a >> 2, a & 3); if (DUP_MASK & 128) sgu_pair(lds, Hb, MIX, ln_sgu_g, ln_sgu_b, WSB, b_s, GST, a >> 2, a & 3); }
#endif
    } }
    GSYNC();
    REP(3) if constexpr ((PH_MASK & 8) != 0) { pg8::Gemm g{MIX, WO_T, M, DM, DM}; pg8::StaticOrder S; S.init(M, DM, G, bx); EpiY1 E{xp, xs, out};
      pg8::gemm_phase<EpiY1, pg8::StaticOrder, true, true>(lds, g, S, E); }
    GSYNC();
    REP(4) if constexpr ((PH_MASK & 16) != 0) ln_rows<false>(out, nullptr, XB, ST1, ln1_g, ln1_b, gw, NGW, lane);
    GSYNC();
    REP(5) if constexpr ((PH_MASK & 32) != 0) { pg8::Gemm g{XB, W13_T, M, 2 * DFF, DM}; pg8::StaticOrder S; S.init(M, 2 * DFF, G, bx); EpiHid E{HID};
      pg8::gemm_phase<EpiHid, pg8::StaticOrder, true, true>(lds, g, S, E); }
    GSYNC();
    if constexpr ((PH_MASK & 64) != 0) { pg8::Gemm g{HID, W2_T, M, DM, DFF}; pg8::StaticOrder S; S.init(M, DM, G, bx); EpiY2 E{out, ST1, ln1_g, ln1_b};
      pg8::gemm_phase<EpiY2, pg8::StaticOrder, true, true>(lds, g, S, E); }
    GSYNC();
#ifdef SYNC_PROBE
    for (int i = 0; i < 16; ++i) GSYNC();
#endif
    if constexpr ((PH_MASK & 128) != 0) ln_rows<true>(out, out, nullptr, nullptr, ln2_g, ln2_b, gw, NGW, lane);
}

extern "C" void kernel_launch(void* const* d_in, const int* in_sizes, int n_in, void* d_out, int out_size, void* d_ws, size_t ws_size, hipStream_t stream) {
    static int grid = 0;
    if (grid == 0) {
        if (n_in != 16 || out_size != M * DM || ws_size < WS_END) { fprintf(stderr, "kernel_launch: unexpected shapes (n_in %d, out %d, ws %zu)\n", n_in, out_size, ws_size); grid = -1; return; }
        int dev = 0, cus = 0, per_cu = 0;
        hipGetDevice(&dev);
        hipDeviceGetAttribute(&cus, hipDeviceAttributeMultiprocessorCount, dev);
        if (hipFuncSetAttribute((const void*)fwd_megakernel, hipFuncAttributeMaxDynamicSharedMemorySize, LDS_BYTES) != hipSuccess) { fprintf(stderr, "kernel_launch: hipFuncSetAttribute failed\n"); grid = -1; return; }
        if (hipOccupancyMaxActiveBlocksPerMultiprocessor(&per_cu, (const void*)fwd_megakernel, NTHR, LDS_BYTES) != hipSuccess || per_cu < 1) { fprintf(stderr, "kernel_launch: occupancy query says %d\n", per_cu); per_cu = 1; }
        (void)hipGetLastError();
        grid = cus;
        fprintf(stderr, "kernel_launch: grid %d (cus %d, per_cu %d)\n", grid, cus, per_cu);
    }
    if (grid < 0) return;
    Args a{};
    for (int i = 0; i < 16; ++i) a.in[i] = (const float*)d_in[i];
    a.out = (float*)d_out; a.ws = (unsigned char*)d_ws;
    void* kargs[] = {&a};
    hipError_t e = hipLaunchCooperativeKernel((const void*)fwd_megakernel, dim3(grid), dim3(NTHR), kargs, LDS_BYTES, stream);
    if (e != hipSuccess) fprintf(stderr, "kernel_launch: cooperative launch failed: %s (grid %d)\n", hipGetErrorString(e), grid);
}
```

```cpp
#include <hip/hip_runtime.h>
#include <hip/hip_cooperative_groups.h>
#include <cstdio>
#include <cstdint>
namespace cg = cooperative_groups;

namespace pg8 {
#define PG8_LAS __attribute__((address_space(3)))
typedef unsigned short bf16_t;
typedef short bf16x8 __attribute__((ext_vector_type(8)));
typedef float f32x4 __attribute__((ext_vector_type(4)));
typedef unsigned u32x4 __attribute__((ext_vector_type(4)));
constexpr int BM = 256, BK = 64, HALF = 128, HTB = HALF * BK * 2  , STAGE_BYTES = 8 * HTB, NXCD = 8, WGM = 8;

__host__ __device__ __forceinline__ int lds_byte(int r, int c) { const int st = (r >> 4) * 2 + (c >> 5), rr = r & 15, cc = c & 31, ob = rr * 64 + cc * 2; return st * 1024 + (ob ^ (((ob >> 9) & 1) << 5)); }
__host__ __device__ __forceinline__ void stage_rc(int b, int& R, int& C) { const int st = b / 1024, sb = b % 1024, swz = sb ^ (((sb >> 9) & 1) << 5); R = (st >> 1) * 16 + swz / 64; C = (st & 1) * 32 + (swz % 64) / 2; }
__host__ __device__ __forceinline__ int perm32(int rho) { const int n = rho >> 4, i = rho & 15; return 8 * (i >> 2) + 4 * n + (i & 3); }

struct Unit { int pm, pn; };
struct Gemm { const bf16_t* A; const bf16_t* Bt; int M, N, K; };

struct StaticOrder {
    int nM, nN, nwg, G, c;
    __host__ __device__ void init(int M, int N, int G_, int c_) { nM = M / BM; nN = N / BM; nwg = nM * nN; G = G_; c = c_; }
    __host__ __device__ bool next(int i, Unit& u) const {
        const long L = (long)i * G + c; if (L >= nwg) return false;
        int wgid = (int)L; { const int q = nwg / NXCD, r = nwg % NXCD, xcd = wgid % NXCD, off = wgid / NXCD; wgid = (xcd < r ? xcd * (q + 1) : r * (q + 1) + (xcd - r) * q) + off; }
        const int nig = WGM * nN, gid = wgid / nig, fm = gid * WGM, gsz = (nM - fm) < WGM ? (nM - fm) : WGM;
        u.pm = fm + ((wgid % nig) % gsz); u.pn = (wgid % nig) / gsz; return true;
    }
    __device__ __forceinline__ void a_ready(const Unit&) const {}
    __device__ __forceinline__ void done(const Unit&) const {}
};

__device__ __forceinline__ unsigned cvt_pk_bf16(float lo, float hi) { unsigned r; asm("v_cvt_pk_bf16_f32 %0, %1, %2" : "=v"(r) : "v"(lo), "v"(hi)); return r; }

template <class Epi, class Sched, bool ALIGN_EPI = false, bool SP2 = false>
__device__ __forceinline__ void gemm_phase(PG8_LAS unsigned char* lds, const Gemm g, const Sched& S, const Epi& E) {
    int tid_ = threadIdx.x; asm volatile("" : "+v"(tid_));
    const int tid = tid_, wid = __builtin_amdgcn_readfirstlane(tid >> 6), lane = tid & 63, wr = wid >> 2, wc = wid & 3, fr = lane & 15, fq = lane >> 4;
    const int K = g.K, nt = K / BK;
    unsigned voffA[2], voffB[2];
#pragma unroll
    for (int i = 0; i < 2; ++i) { int R, C; stage_rc(tid * 16 + i * 8192, R, C); const int Rb = Epi::PERM ? ((R & ~31) + perm32(R & 31)) : R;
        voffA[i] = (unsigned)(R * K + C) * 2u; voffB[i] = (unsigned)(Rb * K + C) * 2u; }
    const size_t kstep = (size_t)(BK * 2);
    const size_t hstep = (size_t)HALF * K * 2;
    const size_t tstep = 2 * hstep;
    const unsigned ldsw = (unsigned)wid * 1024u;
    const int aoff = lds_byte(wr * 64 + fr, fq * 8), boff = lds_byte(wc * 32 + fr, fq * 8);
#define PG8_SA(b, h) (((b) * 2 + (h)) * HTB)
#define PG8_SB(b, h) ((4 + (b) * 2 + (h)) * HTB)
#define PG8_STAGE(bufoff, gbase, voff) do { _Pragma("unroll") for (int _i = 0; _i < 2; ++_i) \
        __builtin_amdgcn_global_load_lds((const unsigned*)((const char*)(gbase) + (voff)[_i]), (PG8_LAS unsigned*)(lds + (bufoff) + ldsw + _i * 8192), 16, 0, 0); } while (0)
#define PG8_LDA(dst, b, h) do { _Pragma("unroll") for (int m = 0; m < 4; ++m) _Pragma("unroll") for (int k = 0; k < 2; ++k) dst[m][k] = *(const PG8_LAS bf16x8*)(lds + PG8_SA(b, h) + aoff + m * 2048 + k * 1024); } while (0)
#define PG8_LDB(dst, b, h) do { _Pragma("unroll") for (int n = 0; n < 2; ++n) _Pragma("unroll") for (int k = 0; k < 2; ++k) dst[n][k] = *(const PG8_LAS bf16x8*)(lds + PG8_SB(b, h) + boff + n * 2048 + k * 1024); } while (0)
#define PG8_MMA(ai, bj, At, Bt) do { __builtin_amdgcn_s_setprio(1); _Pragma("unroll") for (int m = 0; m < 4; ++m) _Pragma("unroll") for (int n = 0; n < 2; ++n) _Pragma("unroll") for (int k = 0; k < 2; ++k) \
        acc[ai][bj][m][n] = __builtin_amdgcn_mfma_f32_16x16x32_bf16(Bt[n][k], At[m][k], acc[ai][bj][m][n], 0, 0, 0); __builtin_amdgcn_s_setprio(0); } while (0)
#define PG8_WAIT_V(n) asm volatile("s_waitcnt vmcnt(" #n ")" ::: "memory")
#define PG8_WAIT_L(n) asm volatile("s_waitcnt lgkmcnt(" #n ")" ::: "memory")
#define PG8_BAR __builtin_amdgcn_s_barrier()
#define PG8_SCHED __builtin_amdgcn_sched_barrier(0)
    Unit cur, nxt; int ui = 0;
    if (!S.next(0, cur)) return;
    f32x4 acc[2][2][4][2];
#pragma unroll
    for (int a = 0; a < 2; ++a)
#pragma unroll
        for (int b = 0; b < 2; ++b)
#pragma unroll
            for (int m = 0; m < 4; ++m)
#pragma unroll
                for (int n = 0; n < 2; ++n) acc[a][b][m][n] = (f32x4){0.f, 0.f, 0.f, 0.f};
    bf16x8 At[4][2], B0[2][2], B1[2][2];
    const char* cA = (const char*)g.A + (size_t)cur.pm * tstep; const char* cB = (const char*)g.Bt + (size_t)cur.pn * tstep;
    S.a_ready(cur);
    if constexpr (SP2) {
        PG8_STAGE(PG8_SB(0, 0), cB, voffB); PG8_STAGE(PG8_SB(0, 1), cB + hstep, voffB); PG8_STAGE(PG8_SA(0, 0), cA, voffA); PG8_STAGE(PG8_SA(0, 1), cA + hstep, voffA);
        if (wr == 1) PG8_BAR;
        PG8_WAIT_V(2); PG8_BAR;
        PG8_STAGE(PG8_SB(1, 0), cB + kstep, voffB); PG8_STAGE(PG8_SA(1, 0), cA + kstep, voffA); PG8_STAGE(PG8_SB(1, 1), cB + hstep + kstep, voffB);
        PG8_WAIT_V(6); PG8_BAR;
    } else {
        PG8_STAGE(PG8_SB(0, 0), cB, voffB); PG8_STAGE(PG8_SA(0, 0), cA, voffA); PG8_STAGE(PG8_SB(0, 1), cB + hstep, voffB); PG8_STAGE(PG8_SA(0, 1), cA + hstep, voffA);
        if (wr == 1) PG8_BAR;
        PG8_WAIT_V(4); PG8_BAR;
        PG8_STAGE(PG8_SB(1, 0), cB + kstep, voffB); PG8_STAGE(PG8_SA(1, 0), cA + kstep, voffA); PG8_STAGE(PG8_SB(1, 1), cB + hstep + kstep, voffB);
        PG8_WAIT_V(6); PG8_BAR;
    }
    for (;;) {
        const bool has_next = S.next(ui + 1, nxt);
        const char* nA = has_next ? (const char*)g.A + (size_t)nxt.pm * tstep : cA; const char* nB = has_next ? (const char*)g.Bt + (size_t)nxt.pn * tstep : cB;
        for (int t = 0; t < nt; t += 2) {
            const bool last = (t == nt - 2);
            const char* a1 = cA + (size_t)(t + 1) * kstep;
            const char* a2 = last ? nA : cA + (size_t)(t + 2) * kstep; const char* b2 = last ? nB : cB + (size_t)(t + 2) * kstep;
            const char* a3 = a2 + kstep; const char* b3 = b2 + kstep;
            if (last && has_next) S.a_ready(nxt);
            if constexpr (SP2) {
            PG8_LDB(B0, 0, 0); PG8_LDB(B1, 0, 1); PG8_SCHED; PG8_LDA(At, 0, 0); PG8_STAGE(PG8_SA(1, 1), a1 + hstep, voffA);
            PG8_WAIT_V(8); PG8_WAIT_L(0); PG8_BAR; PG8_MMA(0, 0, At, B0); PG8_MMA(0, 1, At, B1); PG8_BAR; PG8_SCHED;
            PG8_LDA(At, 0, 1); PG8_STAGE(PG8_SB(0, 0), b2, voffB); PG8_STAGE(PG8_SB(0, 1), b2 + hstep, voffB); PG8_STAGE(PG8_SA(0, 0), a2, voffA);
            PG8_WAIT_V(8); PG8_WAIT_L(0); PG8_BAR; PG8_MMA(1, 0, At, B0); PG8_MMA(1, 1, At, B1); PG8_BAR; PG8_SCHED;
            PG8_LDB(B0, 1, 0); PG8_LDB(B1, 1, 1); PG8_SCHED; PG8_LDA(At, 1, 0); PG8_STAGE(PG8_SA(0, 1), a2 + hstep, voffA);
            PG8_WAIT_V(8); PG8_WAIT_L(0); PG8_BAR; PG8_MMA(0, 0, At, B0); PG8_MMA(0, 1, At, B1); PG8_BAR; PG8_SCHED;
            PG8_LDA(At, 1, 1); PG8_STAGE(PG8_SB(1, 0), b3, voffB); PG8_STAGE(PG8_SB(1, 1), b3 + hstep, voffB); PG8_STAGE(PG8_SA(1, 0), a3, voffA);
            PG8_WAIT_V(8); PG8_WAIT_L(0); PG8_BAR; PG8_MMA(1, 0, At, B0); PG8_MMA(1, 1, At, B1); PG8_BAR; PG8_SCHED;
            } else {
            PG8_LDB(B0, 0, 0); PG8_SCHED; PG8_LDA(At, 0, 0); PG8_STAGE(PG8_SA(1, 1), a1 + hstep, voffA);
            PG8_WAIT_L(8); PG8_BAR; PG8_WAIT_L(0); PG8_MMA(0, 0, At, B0); PG8_BAR; PG8_SCHED;
            PG8_LDB(B1, 0, 1); PG8_STAGE(PG8_SB(0, 0), b2, voffB);
            PG8_BAR; PG8_WAIT_L(0); PG8_MMA(0, 1, At, B1); PG8_BAR;
            PG8_LDA(At, 0, 1); PG8_STAGE(PG8_SA(0, 0), a2, voffA);
            PG8_BAR; PG8_WAIT_L(0); PG8_MMA(1, 0, At, B0); PG8_BAR; PG8_SCHED;
            PG8_STAGE(PG8_SB(0, 1), b2 + hstep, voffB);
            PG8_WAIT_V(6); PG8_BAR; PG8_MMA(1, 1, At, B1); PG8_BAR;
            PG8_LDB(B0, 1, 0); PG8_SCHED; PG8_LDA(At, 1, 0); PG8_STAGE(PG8_SA(0, 1), a2 + hstep, voffA);
            PG8_WAIT_L(8); PG8_BAR; PG8_WAIT_L(0); PG8_MMA(0, 0, At, B0); PG8_BAR; PG8_SCHED;
            PG8_LDB(B1, 1, 1); PG8_STAGE(PG8_SB(1, 0), b3, voffB);
            PG8_BAR; PG8_WAIT_L(0); PG8_MMA(0, 1, At, B1); PG8_BAR;
            PG8_LDA(At, 1, 1); PG8_STAGE(PG8_SA(1, 0), a3, voffA);
            PG8_BAR; PG8_WAIT_L(0); PG8_MMA(1, 0, At, B0); PG8_BAR; PG8_SCHED;
            PG8_STAGE(PG8_SB(1, 1), b3 + hstep, voffB);
            PG8_WAIT_V(6); PG8_BAR; PG8_MMA(1, 1, At, B1); PG8_BAR;
            }
        }
        if constexpr (ALIGN_EPI) { if (wr == 0) PG8_BAR; }
        E(acc, cur, wr, wc, fr, fq); S.done(cur);
        if (!has_next) break;
#pragma unroll
        for (int a = 0; a < 2; ++a)
#pragma unroll
            for (int b = 0; b < 2; ++b)
#pragma unroll
                for (int m = 0; m < 4; ++m)
#pragma unroll
                    for (int n = 0; n < 2; ++n) acc[a][b][m][n] = (f32x4){0.f, 0.f, 0.f, 0.f};
        cur = nxt; cA = nA; cB = nB; ++ui;
        if constexpr (ALIGN_EPI) { if (wr == 1) PG8_BAR; }
    }
    PG8_WAIT_V(0);
    if constexpr (!ALIGN_EPI) { if (wr == 0) PG8_BAR; }
    PG8_BAR;
#undef PG8_SA
#undef PG8_SB
#undef PG8_STAGE
#undef PG8_LDA
#undef PG8_LDB
#undef PG8_MMA
#undef PG8_WAIT_V
#undef PG8_WAIT_L
#undef PG8_BAR
#undef PG8_SCHED
}
}

constexpr int NWAVES = 8, NTHR = 512;
constexpr int M = 24576, MP = 16384, DM = 2048, NIN = 3584, DFF = 5632;
constexpr int COL_K = 1024, COL_V = 1280, COL_U = 1536, COL_GV = 2560;
constexpr int NGC = 192;
constexpr float LN_EPS = 1e-5f;
constexpr float ALPHA = 1.189207115002721f;
constexpr float LOG2E = 1.4426950408889634f;

constexpr size_t MiB = 1u << 20;
constexpr size_t WS_WSB = 0, WS_GST = 512 * 1024, WS_BAR = 768 * 1024;
constexpr size_t WS_WIN = 1 * MiB, WS_WO = 15 * MiB, WS_W13 = 23 * MiB, WS_W2 = 67 * MiB, WS_ST1 = 89 * MiB;
constexpr size_t WS_XB = 90 * MiB;
constexpr size_t WS_H = 186 * MiB;
constexpr size_t WS_MIX = 354 * MiB;
constexpr size_t WS_HID = 186 * MiB;
constexpr size_t WS_END = 450 * MiB;
static_assert(WS_H + (size_t)M * NIN * 2 == WS_MIX && WS_MIX + (size_t)M * DM * 2 == WS_END && WS_HID + (size_t)M * DFF * 2 == WS_END, "ws map");

constexpr int LDS_BYTES = 131072 + 4096;

#define GAS __attribute__((address_space(1)))
#define LAS __attribute__((address_space(3)))
typedef unsigned short bf16;
typedef unsigned v4u __attribute__((ext_vector_type(4)));
typedef unsigned v2u __attribute__((ext_vector_type(2)));
typedef float f32x4 __attribute__((ext_vector_type(4)));
typedef float f32x2 __attribute__((ext_vector_type(2)));
typedef short bf16x8 __attribute__((ext_vector_type(8)));
using pg8::cvt_pk_bf16;
#define LDS_WAIT() asm volatile("s_waitcnt lgkmcnt(0)" ::: "memory")
__device__ __forceinline__ float bf_lo(unsigned w) { return __uint_as_float(w << 16); }
__device__ __forceinline__ float bf_hi(unsigned w) { return __uint_as_float(w & 0xffff0000u); }
__device__ __forceinline__ float wave_sum(float v) {
#pragma unroll
    for (int o = 1; o < 64; o <<= 1) v += __shfl_xor(v, o);
    return v;
}
__device__ __forceinline__ float gelu_tanh(float x) {
    const float t = x * (-2.3022082f + (-0.10294324f) * x * x);
    return x * __builtin_amdgcn_rcpf(1.0f + __builtin_amdgcn_exp2f(t));
}
__device__ __forceinline__ float silu_f(float x) { return x * __builtin_amdgcn_rcpf(1.0f + __builtin_amdgcn_exp2f(-LOG2E * x)); }

struct EpiH {
    static constexpr bool PERM = true;
    bf16* O; float* gst;
    __device__ __forceinline__ void operator()(const f32x4 (&acc)[2][2][4][2], const pg8::Unit& u, int wr, int wc, int fr, int fq) const {
        const int row0 = u.pm * 256 + wr * 64 + fr, col0 = u.pn * 256 + wc * 32 + 8 * fq;
        const bool act = u.pn >= 6, stat = u.pn >= 10;
#pragma unroll
        for (int ai = 0; ai < 2; ++ai)
#pragma unroll
            for (int m = 0; m < 4; ++m) { bf16* rowp = O + (size_t)(row0 + ai * 128 + m * 16) * NIN + col0;
                float rs = 0.f, rq = 0.f;
#pragma unroll
                for (int bj = 0; bj < 2; ++bj) { f32x4 v0 = acc[ai][bj][m][0], v1 = acc[ai][bj][m][1];
                    if (act) {
#pragma unroll
                        for (int i = 0; i < 4; ++i) { v0[i] = gelu_tanh(v0[i]); v1[i] = gelu_tanh(v1[i]); } }
                    v4u w; w.x = cvt_pk_bf16(v0[0], v0[1]); w.y = cvt_pk_bf16(v0[2], v0[3]); w.z = cvt_pk_bf16(v1[0], v1[1]); w.w = cvt_pk_bf16(v1[2], v1[3]);
                    *(v4u*)(rowp + bj * 128) = w;
                    if (stat) {
#pragma unroll
                        for (int t = 0; t < 4; ++t) { const float a = bf_lo(w[t]), b = bf_hi(w[t]); rs += a + b; rq += a * a + b * b; } } }
                if (stat) { rs += __shfl_xor(rs, 16); rs += __shfl_xor(rs, 32); rq += __shfl_xor(rq, 16); rq += __shfl_xor(rq, 32);
                    if (fq == 0) { float* gp = gst + 2 * (size_t)(row0 + ai * 128 + m * 16); __hip_atomic_fetch_add(gp, rs, __ATOMIC_RELAXED, __HIP_MEMORY_SCOPE_AGENT); __hip_atomic_fetch_add(gp + 1, rq, __ATOMIC_RELAXED, __HIP_MEMORY_SCOPE_AGENT); } } }
    }
};
struct EpiY1 {
    static constexpr bool PERM = false;
    const float* xp; const float* xs; float* Y;
    __device__ __forceinline__ void operator()(const f32x4 (&acc)[2][2][4][2], const pg8::Unit& u, int wr, int wc, int fr, int fq) const {
        const int row0 = u.pm * 256 + wr * 64 + fr, col0 = u.pn * 256 + wc * 32 + 4 * fq;
        const float* xb = (u.pm < MP / 256) ? xp : xs - (size_t)MP * DM;
#pragma unroll
        for (int ai = 0; ai < 2; ++ai)
#pragma unroll
            for (int m = 0; m < 4; ++m) { const size_t off = (size_t)(row0 + ai * 128 + m * 16) * DM + col0;
#pragma unroll
                for (int bj = 0; bj < 2; ++bj)
#pragma unroll
                    for (int n = 0; n < 2; ++n) { const f32x4 xv = *(const f32x4*)(xb + off + bj * 128 + n * 16);
                        *(f32x4*)(Y + off + bj * 128 + n * 16) = xv * ALPHA + acc[ai][bj][m][n]; } }
    }
};
struct EpiHid {
    static constexpr bool PERM = true;
    bf16* O;
    __device__ __forceinline__ void operator()(const f32x4 (&acc)[2][2][4][2], const pg8::Unit& u, int wr, int wc, int fr, int fq) const {
        const int row0 = u.pm * 256 + wr * 64 + fr, col0 = u.pn * 128 + wc * 32 + 8 * fq;
#pragma unroll
        for (int ai = 0; ai < 2; ++ai)
#pragma unroll
            for (int m = 0; m < 4; ++m) {
                const f32x4 g0 = acc[ai][0][m][0], g1 = acc[ai][0][m][1], u0 = acc[ai][1][m][0], u1 = acc[ai][1][m][1];
                float h[8];
#pragma unroll
                for (int i = 0; i < 4; ++i) { h[i] = silu_f(g0[i]) * u0[i]; h[4 + i] = silu_f(g1[i]) * u1[i]; }
                v4u w; w.x = cvt_pk_bf16(h[0], h[1]); w.y = cvt_pk_bf16(h[2], h[3]); w.z = cvt_pk_bf16(h[4], h[5]); w.w = cvt_pk_bf16(h[6], h[7]);
                *(v4u*)(O + (size_t)(row0 + ai * 128 + m * 16) * DFF + col0) = w; }
    }
};
struct EpiY2 {
    static constexpr bool PERM = false;
    float* Y; const float* st1; const float* g1; const float* b1;
    __device__ __forceinline__ void operator()(const f32x4 (&acc)[2][2][4][2], const pg8::Unit& u, int wr, int wc, int fr, int fq) const {
        const int row0 = u.pm * 256 + wr * 64 + fr, col0 = u.pn * 256 + wc * 32 + 4 * fq;
        f32x4 gv[2][2], bv[2][2];
#pragma unroll
        for (int bj = 0; bj < 2; ++bj)
#pragma unroll
            for (int n = 0; n < 2; ++n) { gv[bj][n] = *(const f32x4*)(g1 + col0 + bj * 128 + n * 16) * ALPHA; bv[bj][n] = *(const f32x4*)(b1 + col0 + bj * 128 + n * 16) * ALPHA; }
#pragma unroll
        for (int ai = 0; ai < 2; ++ai)
#pragma unroll
            for (int m = 0; m < 4; ++m) { const int r = row0 + ai * 128 + m * 16; const size_t off = (size_t)r * DM + col0;
                const f32x2 st = *(const f32x2*)(st1 + 2 * r);
#pragma unroll
                for (int bj = 0; bj < 2; ++bj)
#pragma unroll
                    for (int n = 0; n < 2; ++n) { const f32x4 yv = *(const f32x4*)(Y + off + bj * 128 + n * 16);
                        *(f32x4*)(Y + off + bj * 128 + n * 16) = ((yv - st.x) * st.y) * gv[bj][n] + bv[bj][n] + acc[ai][bj][m][n]; } }
    }
};

__device__ __forceinline__ void p0_transpose_item(const float* W, int K, int N, bf16* WT, int drow0, int k0, int n0, LAS float* scr, int lane) {
    float v[32];
    const float* wp = W + (size_t)(k0 + (lane >> 5)) * N + n0 + (lane & 31);
#pragma unroll
    for (int i = 0; i < 32; ++i) v[i] = wp[(size_t)(2 * i) * N];
#pragma unroll
    for (int i = 0; i < 32; ++i) scr[(2 * i + (lane >> 5)) * 33 + (lane & 31)] = v[i];
    LDS_WAIT(); asm volatile("" ::: "memory");
    const int c = lane & 7;
#pragma unroll
    for (int j = 0; j < 4; ++j) { const int n = (lane >> 3) + 8 * j; const LAS float* s = scr + (8 * c) * 33 + n;
        v4u o; o.x = cvt_pk_bf16(s[0 * 33], s[1 * 33]); o.y = cvt_pk_bf16(s[2 * 33], s[3 * 33]); o.z = cvt_pk_bf16(s[4 * 33], s[5 * 33]); o.w = cvt_pk_bf16(s[6 * 33], s[7 * 33]);
        *(v4u*)(WT + (size_t)(drow0 + n) * K + k0 + 8 * c) = o; }
    LDS_WAIT(); asm volatile("" ::: "memory");
}

struct Args { const float* in[16]; float* out; unsigned char* ws; };

template <bool FINAL>
__device__ __forceinline__ void ln_rows(const float* src, float* dstf, bf16* dstb, float* stats, const float* g, const float* b, int gw, int NGW, int lane) {
    f32x4 gg[8], bb[8];
#pragma unroll
    for (int j = 0; j < 8; ++j) { gg[j] = ((const f32x4*)g)[lane + 64 * j]; bb[j] = ((const f32x4*)b)[lane + 64 * j]; }
    for (int m = gw; m < M; m += NGW) {
        const f32x4* xr = (const f32x4*)(src + (size_t)m * DM) + lane;
        f32x4 v[8]; float s = 0.f;
#pragma unroll
        for (int j = 0; j < 8; ++j) { v[j] = xr[64 * j]; s += (v[j].x + v[j].y) + (v[j].z + v[j].w); }
        const float mean = wave_sum(s) * (1.f / DM); float s2 = 0.f;
#pragma unroll
        for (int j = 0; j < 8; ++j) { v[j] = v[j] - mean; s2 += (v[j].x * v[j].x + v[j].y * v[j].y) + (v[j].z * v[j].z + v[j].w * v[j].w); }
        const float rstd = 1.f / sqrtf(wave_sum(s2) * (1.f / DM) + LN_EPS);
        if (FINAL) {
            f32x4* o = (f32x4*)(dstf + (size_t)m * DM) + lane;
#pragma unroll
            for (int j = 0; j < 8; ++j) o[64 * j] = (v[j] * rstd) * gg[j] + bb[j];
        } else {
            v2u* o = (v2u*)(dstb + (size_t)m * DM) + lane;
#pragma unroll
            for (int j = 0; j < 8; ++j) { const f32x4 y = (v[j] * rstd) * gg[j] + bb[j]; v2u w; w.x = cvt_pk_bf16(y.x, y.y); w.y = cvt_pk_bf16(y.z, y.w); o[64 * j] = w; }
            if (lane == 0) { stats[2 * m] = mean; stats[2 * m + 1] = rstd; }
        }
    }
}

constexpr int VT_PITCH = 784;
__device__ __forceinline__ void attn_head_scores(const LAS unsigned char* kbase, const bf16x8 (&qf)[4], int swz, int p0, float rel0f, float nslope2, float sink2, float pen0, float pen2, v4u (&pf)[9], float& inv) {
    f32x4 S[18];
#pragma unroll
    for (int j = 0; j < 18; ++j) {
        S[j] = (f32x4){0.f, 0.f, 0.f, 0.f};
#pragma unroll
        for (int ks = 0; ks < 4; ++ks) { const bf16x8 kf = *(const LAS bf16x8*)(kbase + (j >> 1) * 8192 + (j & 1) * 1024 + (((4 * ks) ^ swz) << 4));
            S[j] = __builtin_amdgcn_mfma_f32_16x16x32_bf16(kf, qf[ks], S[j], 0, 0, 0); }
        if (j & 1) __builtin_amdgcn_sched_barrier(0);
    }
    const float sc2 = 0.08838834764831845f * LOG2E;
    float mx = sink2;
    asm volatile("" : "+v"(rel0f));
#pragma unroll
    for (int t = 0; t < 9; ++t) { const int p = p0 + t; const float pen = p < 4 ? pen0 : (p >= 8 ? pen2 : 0.f);
#pragma unroll
        for (int e = 0; e < 2; ++e)
#pragma unroll
            for (int i = 0; i < 4; ++i) { const float relf = rel0f + (float)(32 * t + 4 * e + i);
                float sv = __builtin_fmaf(S[2 * t + e][i], sc2, __builtin_fmaf(__builtin_fabsf(relf), nslope2, pen));
                if (t == 0 || t == 8) sv = (__builtin_fabsf(relf) > 128.f) ? -1e30f : sv;
                S[2 * t + e][i] = sv; mx = fmaxf(mx, sv); } }
    mx = fmaxf(mx, __shfl_xor(mx, 16)); mx = fmaxf(mx, __shfl_xor(mx, 32));
    float sum = 0.f;
#pragma unroll
    for (int j = 0; j < 18; ++j)
#pragma unroll
        for (int i = 0; i < 4; ++i) { const float p = __builtin_amdgcn_exp2f(S[j][i] - mx); S[j][i] = p; sum += p; }
    sum += __shfl_xor(sum, 16); sum += __shfl_xor(sum, 32);
    inv = 1.0f / (sum + __builtin_amdgcn_exp2f(sink2 - mx));
#pragma unroll
    for (int t = 0; t < 9; ++t) { pf[t].x = cvt_pk_bf16(S[2 * t][0], S[2 * t][1]); pf[t].y = cvt_pk_bf16(S[2 * t][2], S[2 * t][3]);
        pf[t].z = cvt_pk_bf16(S[2 * t + 1][0], S[2 * t + 1][1]); pf[t].w = cvt_pk_bf16(S[2 * t + 1][2], S[2 * t + 1][3]); }
}
__device__ __forceinline__ void attn_head_pv(const LAS unsigned char* vbase, const v4u (&pf)[9], float inv, bf16* Og) {
#pragma unroll
    for (int dt = 0; dt < 8; ++dt) {
        f32x4 o = (f32x4){0.f, 0.f, 0.f, 0.f};
#pragma unroll
        for (int t = 0; t < 9; ++t) { const bf16x8 vf = *(const LAS bf16x8*)(vbase + 16 * dt * VT_PITCH + 64 * t);
            o = __builtin_amdgcn_mfma_f32_16x16x32_bf16(vf, __builtin_bit_cast(bf16x8, pf[t]), o, 0, 0, 0); }
        v2u w; w.x = cvt_pk_bf16(o[0] * inv, o[1] * inv); w.y = cvt_pk_bf16(o[2] * inv, o[3] * inv);
        *(v2u*)(Og + 16 * dt) = w;
        __builtin_amdgcn_sched_barrier(0);
    }
}
__device__ __forceinline__ void vt_write(LAS unsigned char* lds, const v4u (&in)[8], int dblk, int key0) {
#pragma unroll
    for (int i = 0; i < 8; ++i) { v4u o;
#pragma unroll
        for (int t = 0; t < 4; ++t) { const unsigned a = in[2 * t][i >> 1], b = in[2 * t + 1][i >> 1];
            o[t] = (i & 1) ? ((a >> 16) | (b & 0xffff0000u)) : ((a & 0xffffu) | (b << 16)); }
        *(LAS v4u*)(lds + (8 * dblk + i) * VT_PITCH + key0 * 2) = o; }
}
__device__ __forceinline__ void attn_unit(LAS unsigned char* lds, const bf16* H, bf16* MIX, const float* sink, int gc, int kv, int hp) {
    int tid_ = threadIdx.x; asm volatile("" : "+v"(tid_));
    const int tid = tid_, lane = tid & 63, wave = __builtin_amdgcn_readfirstlane(tid >> 6);
    const int c = gc & 15, fr = lane & 15, fq = lane >> 4, hA = 4 * kv + 2 * hp, hB = hA + 1;
    const int rowq0 = gc * 128, roww0 = rowq0 - 128;
    const bool v0 = (c != 0), v2 = (c != 15);
    const int p0 = wave >> 1;
    __syncthreads();
    {
        const bf16* Kg = H + COL_K + 128 * kv;
#pragma unroll
        for (int it = 0; it < 12; ++it) { const int ch = tid + it * NTHR, row = ch >> 4, cc = ch & 15, kb = row >> 7;
            const int grow = roww0 + row + ((kb == 0 && !v0) ? 128 : 0) - ((kb == 2 && !v2) ? 128 : 0);
            const v4u v = *(const v4u*)(Kg + (size_t)grow * NIN + cc * 8);
            const int g = (((row >> 3) & 3) << 2) | (row & 3);
            *(LAS v4u*)(lds + row * 256 + ((cc ^ g) << 4)) = v; }
    }
    bf16x8 qfA[4], qfB[4];
    { const bf16* Qg = H + (size_t)(rowq0 + 16 * wave + fr) * NIN + 128 * hA + 8 * fq;
#pragma unroll
      for (int ks = 0; ks < 4; ++ks) { qfA[ks] = *(const bf16x8*)(Qg + 32 * ks); qfB[ks] = *(const bf16x8*)(Qg + 128 + 32 * ks); } }
    const int r = tid & 255, sblk = r >> 4, dblk = r & 15;
    v4u vin0[8], vin1[8];
    { const bf16* Vg = H + COL_V + 128 * kv + 8 * dblk;
      const int kb = tid >> 8, key0 = 128 * kb + 8 * sblk, grow = roww0 + key0 + ((kb == 0 && !v0) ? 128 : 0);
#pragma unroll
      for (int jj = 0; jj < 8; ++jj) vin0[jj] = *(const v4u*)(Vg + (size_t)(grow + jj) * NIN);
      if (wave < 4) { const int grow2 = roww0 + 256 + 8 * sblk - (v2 ? 0 : 128);
#pragma unroll
          for (int jj = 0; jj < 8; ++jj) vin1[jj] = *(const v4u*)(Vg + (size_t)(grow2 + jj) * NIN); } }
    __syncthreads();
    const int qi = 16 * wave + fr;
    float rel0f = (float)(32 * p0 + 8 * fq - 128 - qi);
    asm volatile("" : "+v"(rel0f));
    const float pen0 = v0 ? 0.f : -1e30f, pen2 = v2 ? 0.f : -1e30f;
    const LAS unsigned char* kbase = lds + (32 * p0 + 8 * (fr >> 2) + (fr & 3)) * 256;
    const int swz = fq ^ fr;
    v4u pfA[9], pfB[9]; float invA, invB;
    attn_head_scores(kbase, qfA, swz, p0, rel0f, -__builtin_amdgcn_exp2f(-(float)(hA + 1)) * LOG2E, sink[hA] * LOG2E, pen0, pen2, pfA, invA);
    attn_head_scores(kbase, qfB, swz, p0, rel0f, -__builtin_amdgcn_exp2f(-(float)(hB + 1)) * LOG2E, sink[hB] * LOG2E, pen0, pen2, pfB, invB);
    __syncthreads();
    vt_write(lds, vin0, dblk, 128 * (tid >> 8) + 8 * sblk);
    if (wave < 4) vt_write(lds, vin1, dblk, 256 + 8 * sblk);
    __syncthreads();
    const LAS unsigned char* vbase = lds + fr * VT_PITCH + 64 * p0 + 16 * fq;
    bf16* Og = MIX + (size_t)(rowq0 + 16 * wave + fr) * DM + 128 * hA + 4 * fq;
    attn_head_pv(vbase, pfA, invA, Og);
    attn_head_pv(vbase, pfB, invB, Og + 128);
}

constexpr int GT_PITCH = 272, GT_BYTES = 128 * GT_PITCH;
__device__ __forceinline__ void sgu_pair(LAS unsigned char* lds, const bf16* H, bf16* MIX, const float* lng, const float* lnb, const bf16* wsb, const float* b_s, const float* gst, int gc, int gp) {
    int tid_ = threadIdx.x; asm volatile("" : "+v"(tid_));
    const int tid = tid_, lane = tid & 63, wave = __builtin_amdgcn_readfirstlane(tid >> 6);
    const int r0 = gc * 128, fr = lane & 15, fq = lane >> 4;
    __syncthreads();
    { const int gsel = tid >> 8, r = tid & 255, sblk = r >> 4, dblk = r & 15, g = 2 * gp + gsel, ch0 = 128 * g + 8 * dblk;
      const f32x4 ga = *(const f32x4*)(lng + ch0), gb = *(const f32x4*)(lng + ch0 + 4), ba = *(const f32x4*)(lnb + ch0), bb = *(const f32x4*)(lnb + ch0 + 4);
      const float gam[8] = {ga.x, ga.y, ga.z, ga.w, gb.x, gb.y, gb.z, gb.w}, bet[8] = {ba.x, ba.y, ba.z, ba.w, bb.x, bb.y, bb.z, bb.w};
      v4u in[8]; f32x2 st[8];
#pragma unroll
      for (int jj = 0; jj < 8; ++jj) { in[jj] = *(const v4u*)(H + (size_t)(r0 + 8 * sblk + jj) * NIN + COL_GV + ch0); st[jj] = *(const f32x2*)(gst + 2 * (size_t)(r0 + 8 * sblk + jj)); }
#pragma unroll
      for (int jj = 0; jj < 8; ++jj) { const float mean = st[jj].x * (1.f / 1024.f), var = fmaxf(st[jj].y * (1.f / 1024.f) - mean * mean, 0.f); st[jj].x = mean; st[jj].y = 1.f / sqrtf(var + LN_EPS); }
#pragma unroll
      for (int i = 0; i < 8; ++i) { v4u o;
#pragma unroll
          for (int t = 0; t < 4; ++t) { const unsigned a = in[2 * t][i >> 1], b = in[2 * t + 1][i >> 1];
              const float xa = (i & 1) ? bf_hi(a) : bf_lo(a), xb = (i & 1) ? bf_hi(b) : bf_lo(b);
              o[t] = cvt_pk_bf16((xa - st[2 * t].x) * st[2 * t].y * gam[i] + bet[i], (xb - st[2 * t + 1].x) * st[2 * t + 1].y * gam[i] + bet[i]); }
          *(LAS v4u*)(lds + gsel * GT_BYTES + (8 * dblk + i) * GT_PITCH + 16 * sblk) = o; } }
    const int gsel = wave >> 2, tq = wave & 3, g = 2 * gp + gsel;
    bf16x8 wf[2][4];
#pragma unroll
    for (int tt = 0; tt < 2; ++tt)
#pragma unroll
        for (int ks = 0; ks < 4; ++ks) wf[tt][ks] = *(const bf16x8*)(wsb + (size_t)(g * 128 + 32 * tq + 16 * tt + fr) * 128 + 32 * ks + 8 * fq);
    __syncthreads();
    const LAS unsigned char* Gb = lds + gsel * GT_BYTES + fr * GT_PITCH + 16 * fq;
    const float bias0 = b_s[g * 128 + 32 * tq + fr], bias1 = b_s[g * 128 + 32 * tq + 16 + fr];
#pragma unroll
    for (int dt = 0; dt < 8; ++dt) {
        f32x4 a0 = (f32x4){0.f, 0.f, 0.f, 0.f}, a1 = a0;
#pragma unroll
        for (int ks = 0; ks < 4; ++ks) { const bf16x8 gf = *(const LAS bf16x8*)(Gb + 16 * dt * GT_PITCH + 64 * ks);
            a0 = __builtin_amdgcn_mfma_f32_16x16x32_bf16(gf, wf[0][ks], a0, 0, 0, 0);
            a1 = __builtin_amdgcn_mfma_f32_16x16x32_bf16(gf, wf[1][ks], a1, 0, 0, 0); }
#pragma unroll
        for (int tt = 0; tt < 2; ++tt) { const int t = 32 * tq + 16 * tt + fr; const float bias = tt ? bias1 : bias0; const f32x4 a = tt ? a1 : a0;
            const v2u uu = *(const v2u*)(H + (size_t)(r0 + t) * NIN + COL_U + 128 * g + 16 * dt + 4 * fq);
            v2u w; w.x = cvt_pk_bf16(bf_lo(uu.x) * (a[0] + bias), bf_hi(uu.x) * (a[1] + bias)); w.y = cvt_pk_bf16(bf_lo(uu.y) * (a[2] + bias), bf_hi(uu.y) * (a[3] + bias));
            *(v2u*)(MIX + (size_t)(r0 + t) * DM + 1024 + 128 * g + 16 * dt + 4 * fq) = w; }
    }
}

#define XB_TMO      128
#define XB_XCNT(j)  (256  + 64 * (j))
#define XB_XSUB(j)  (1280 + 64 * (j))
#define XB_XGEN(j)  (2304 + 64 * (j))
#define XB_TOP      3328
#define XB_TOPGEN   3392
#define XCD_BAR_WORDS 3456
#define XB_SPIN_CAP (1u << 18)
__device__ __forceinline__ unsigned xb_ld(unsigned* p)              { return __hip_atomic_load(p, __ATOMIC_RELAXED, __HIP_MEMORY_SCOPE_AGENT); }
__device__ __forceinline__ unsigned xb_add(unsigned* p, unsigned v) { return __hip_atomic_fetch_add(p, v, __ATOMIC_RELAXED, __HIP_MEMORY_SCOPE_AGENT); }
__device__ __forceinline__ unsigned xb_xcc_id() { return (unsigned)__builtin_amdgcn_s_getreg((3 << 11) | 20) & 0xFu; }
#define XB_SPIN(cond, bar) do { unsigned _sp = 0; while (cond) { __builtin_amdgcn_s_sleep(1); \
    if ((++_sp & 255u) == 0u) { if (xb_ld(&(bar)[XB_TMO])) break; if (_sp > XB_SPIN_CAP) { atomicAdd(&(bar)[XB_TMO], 1u); break; } } } } while (0)
struct XcdBarrier { unsigned* bar; unsigned x; volatile LAS unsigned* st; };
__device__ __forceinline__ XcdBarrier xcd_barrier_post(unsigned* bar, volatile LAS unsigned* st) {
    XcdBarrier b; b.bar = bar; b.x = xb_xcc_id(); b.st = st;
    if (threadIdx.x == 0) (void)xb_add(&bar[XB_XCNT(b.x)], 1u);
    return b;
}
__device__ __forceinline__ void xcd_barrier_complete(unsigned* bar, unsigned x, unsigned& nloc, unsigned& nx) {
    const unsigned G = gridDim.x * gridDim.y * gridDim.z;
    unsigned sum, cnt, mine, sp = 0u;
    for (;;) {
        sum = 0u; cnt = 0u; mine = 0u;
#pragma unroll
        for (unsigned j = 0; j < 16; ++j) { const unsigned c = xb_ld(&bar[XB_XCNT(j)]); sum += c; cnt += (c > 0u) ? 1u : 0u; mine = (j == x) ? c : mine; }
        if (sum == G) break;
        __builtin_amdgcn_s_sleep(1);
        if ((++sp & 255u) == 0u) { if (xb_ld(&bar[XB_TMO])) break; if (sp > XB_SPIN_CAP) { atomicAdd(&bar[XB_TMO], 1u); break; } }
    }
    nloc = mine > 0u ? mine : 1u; nx = cnt > 0u ? cnt : 1u;
}
__device__ __forceinline__ void xcd_barrier(const XcdBarrier& b) {
    asm volatile("s_waitcnt vmcnt(0)" ::: "memory");
    __syncthreads();
    if (threadIdx.x == 0) {
        unsigned* bar = b.bar;
        __builtin_amdgcn_s_waitcnt(0);
        unsigned nloc = b.st[0], nx = b.st[1];
        if (nloc == 0u) { xcd_barrier_complete(bar, b.x, nloc, nx); b.st[0] = nloc; b.st[1] = nx; }
        const unsigned old = xb_add(&bar[XB_XSUB(b.x)], 1u);
        const unsigned gen = old / nloc;
        if (old + 1u == (gen + 1u) * nloc) {
            __builtin_amdgcn_fence(__ATOMIC_RELEASE, "agent");
            asm volatile("s_waitcnt vmcnt(0)" ::: "memory");
            const unsigned og = xb_add(&bar[XB_TOP], 1u);
            const unsigned tg = og / nx;
            if (og + 1u == (tg + 1u) * nx) xb_add(&bar[XB_TOPGEN], 1u);
            else XB_SPIN(xb_ld(&bar[XB_TOPGEN]) == tg, bar);
            __builtin_amdgcn_fence(__ATOMIC_ACQUIRE, "agent");
            xb_add(&bar[XB_XGEN(b.x)], 1u);
            asm volatile("s_waitcnt vmcnt(0)" ::: "memory");
        } else {
            XB_SPIN(xb_ld(&bar[XB_XGEN(b.x)]) == gen, bar);
            __builtin_amdgcn_fence(__ATOMIC_ACQUIRE, "agent");
            asm volatile("s_waitcnt vmcnt(0)" ::: "memory");
        }
    }
    __syncthreads();
}

#ifndef PH_MASK
#define PH_MASK 0xff
#endif
#ifndef DUP_MASK
#define DUP_MASK 0
#endif
#define GSYNC() xcd_barrier(xbar)
#define REP(k) for (int rep_ = 0; rep_ < (((DUP_MASK >> (k)) & 1) ? 2 : 1); ++rep_, (rep_ < (((DUP_MASK >> (k)) & 1) ? 2 : 1) ? GSYNC() : (void)0))
__global__ void __launch_bounds__(NTHR, 2) fwd_megakernel(Args args) {
    extern __shared__ __attribute__((aligned(16))) unsigned char lds_raw[];
    LAS unsigned char* lds = (LAS unsigned char*)lds_raw;
    const int tid = threadIdx.x, lane = tid & 63, wave = __builtin_amdgcn_readfirstlane(tid >> 6);
    const int G = gridDim.x, bx = blockIdx.x;
    const int vcu = (G % 8 == 0) ? (bx % 8) * (G / 8) + bx / 8 : bx;
    unsigned char* ws = args.ws;
    const float* xp = args.in[0]; const float* xs = args.in[1];
    const float* w_in = args.in[2]; const float* ln_sgu_g = args.in[3]; const float* ln_sgu_b = args.in[4]; const float* w_s = args.in[5]; const float* b_s = args.in[6];
    const float* sink = args.in[7]; const float* w_o = args.in[8]; const float* ln1_g = args.in[9]; const float* ln1_b = args.in[10];
    const float* w_gate = args.in[11]; const float* w_up = args.in[12]; const float* w_down = args.in[13]; const float* ln2_g = args.in[14]; const float* ln2_b = args.in[15];
    float* out = args.out;
    bf16* WIN_T = (bf16*)(ws + WS_WIN); bf16* WO_T = (bf16*)(ws + WS_WO); bf16* W13_T = (bf16*)(ws + WS_W13); bf16* W2_T = (bf16*)(ws + WS_W2);
    float* ST1 = (float*)(ws + WS_ST1); float* GST = (float*)(ws + WS_GST); bf16* WSB = (bf16*)(ws + WS_WSB);
    bf16* XB = (bf16*)(ws + WS_XB); bf16* Hb = (bf16*)(ws + WS_H); bf16* MIX = (bf16*)(ws + WS_MIX); bf16* HID = (bf16*)(ws + WS_HID);
    const int gw = vcu * NWAVES + wave, NGW = G * NWAVES;
    if (tid < 2) ((volatile LAS unsigned*)(lds + 131072 + 2048))[tid] = 0u;
    __syncthreads();
    const XcdBarrier xbar = xcd_barrier_post((unsigned*)(ws + WS_BAR), (volatile LAS unsigned*)(lds + 131072 + 2048));

    if constexpr ((PH_MASK & 1) != 0) {
        LAS float* scr = (LAS float*)(lds + wave * 16384);
        constexpr int I_IN = (DM / 64) * (NIN / 32);
        for (int it = gw; it < I_IN; it += NGW) { const int nb = it % (NIN / 32), kb = it / (NIN / 32); p0_transpose_item(w_in, DM, NIN, WIN_T, 32 * nb, 64 * kb, 32 * nb, scr, lane); }
        { const int gt = bx * NTHR + tid;
          if (gt < M * 2 / 4) ((f32x4*)GST)[gt] = (f32x4){0.f, 0.f, 0.f, 0.f};
          if (gt < 8 * 128 * 128 / 8) { const f32x4 a = *(const f32x4*)(w_s + 8 * gt), b = *(const f32x4*)(w_s + 8 * gt + 4);
              v4u w; w.x = cvt_pk_bf16(a.x, a.y); w.y = cvt_pk_bf16(a.z, a.w); w.z = cvt_pk_bf16(b.x, b.y); w.w = cvt_pk_bf16(b.z, b.w); *(v4u*)(WSB + 8 * gt) = w; } }
        const size_t n8 = (size_t)M * DM / 8, nthr = (size_t)G * NTHR;
        for (size_t i = (size_t)bx * NTHR + tid; i < n8; i += nthr) { const size_t e = i * 8;
            const float* src = (e < (size_t)MP * DM) ? xp + e : xs + (e - (size_t)MP * DM);
            const f32x4 a = *(const f32x4*)src, b = *(const f32x4*)(src + 4);
            v4u w; w.x = cvt_pk_bf16(a.x, a.y); w.y = cvt_pk_bf16(a.z, a.w); w.z = cvt_pk_bf16(b.x, b.y); w.w = cvt_pk_bf16(b.z, b.w);
            *(v4u*)(XB + e) = w; }
    }
    GSYNC();
    REP(1) if constexpr ((PH_MASK & 2) != 0) { pg8::Gemm g{XB, WIN_T, M, NIN, DM}; pg8::StaticOrder S; S.init(M, NIN, G, bx); EpiH E{Hb, GST};
      pg8::gemm_phase<EpiH, pg8::StaticOrder, true, true>(lds, g, S, E);
      const int nfull = (M / 256) * (NIN / 256) / G, nrem = (M / 256) * (NIN / 256) - nfull * G;
      if (bx >= nrem) {
          LAS float* scr = (LAS float*)(lds + wave * 16384);
          constexpr int I_O = (DM / 64) * (DM / 32), I_G = (DM / 64) * (DFF / 32), I_D = (DFF / 64) * (DM / 32);
          const int cw = (bx - nrem) * NWAVES + wave, NCW = (G - nrem) * NWAVES;
          for (int it = cw; it < I_O + 2 * I_G + I_D; it += NCW) {
              int r = it;
              if (r < I_O) { const int nb = r % (DM / 32), kb = r / (DM / 32); p0_transpose_item(w_o, DM, DM, WO_T, 32 * nb, 64 * kb, 32 * nb, scr, lane); continue; } r -= I_O;
              if (r < 2 * I_G) { const int up = r >= I_G ? 1 : 0; if (up) r -= I_G; const int nb = r % (DFF / 32), kb = r / (DFF / 32), n0 = 32 * nb;
                  p0_transpose_item(up ? w_up : w_gate, DM, DFF, W13_T, (n0 >> 7) * 256 + up * 128 + (n0 & 127), 64 * kb, n0, scr, lane); continue; } r -= 2 * I_G;
              { const int nb = r % (DM / 32), kb = r / (DM / 32); p0_transpose_item(w_down, DFF, DM, W2_T, 32 * nb, 64 * kb, 32 * nb, scr, lane); }
          }
      } }
    GSYNC();
    REP(2) if constexpr ((PH_MASK & 4) != 0) {
      for (int it = vcu; it < NGC * 8; it += G) {
#ifndef NO_ATTN
        if (it < NGC * 4) { attn_unit(lds, Hb, MIX, sink, it >> 2, (it >> 1) & 1, it & 1); if (DUP_MASK & 64) attn_unit(lds, Hb, MIX, sink, it >> 2, (it >> 1) & 1, it & 1); }
#endif
#ifndef NO_SGU
        if (it >= NGC * 4) { const int a = it - NGC * 4; sgu_pair(lds, Hb, MIX, ln_sgu_g, ln_sgu_b, WSB, b_s, GST, a >> 2, a & 3); if (DUP_MASK & 128) sgu_pair(lds, Hb, MIX, ln_sgu_g, ln_sgu_b, WSB, b_s, GST, a >> 2, a & 3); }
#endif
    } }
    GSYNC();
    REP(3) if constexpr ((PH_MASK & 8) != 0) { pg8::Gemm g{MIX, WO_T, M, DM, DM}; pg8::StaticOrder S; S.init(M, DM, G, bx); EpiY1 E{xp, xs, out};
      pg8::gemm_phase<EpiY1, pg8::StaticOrder, true, true>(lds, g, S, E); }
    GSYNC();
    REP(4) if constexpr ((PH_MASK & 16) != 0) ln_rows<false>(out, nullptr, XB, ST1, ln1_g, ln1_b, gw, NGW, lane);
    GSYNC();
    REP(5) if constexpr ((PH_MASK & 32) != 0) { pg8::Gemm g{XB, W13_T, M, 2 * DFF, DM}; pg8::StaticOrder S; S.init(M, 2 * DFF, G, bx); EpiHid E{HID};
      pg8::gemm_phase<EpiHid, pg8::StaticOrder, true, true>(lds, g, S, E); }
    GSYNC();
    if constexpr ((PH_MASK & 64) != 0) { pg8::Gemm g{HID, W2_T, M, DM, DFF}; pg8::StaticOrder S; S.init(M, DM, G, bx); EpiY2 E{out, ST1, ln1_g, ln1_b};
      pg8::gemm_phase<EpiY2, pg8::StaticOrder, true, true>(lds, g, S, E); }
    GSYNC();
#ifdef SYNC_PROBE
    for (int i = 0; i < 16; ++i) GSYNC();
#endif
    if constexpr ((PH_MASK & 128) != 0) ln_rows<true>(out, out, nullptr, nullptr, ln2_g, ln2_b, gw, NGW, lane);
}

extern "C" void kernel_launch(void* const* d_in, const int* in_sizes, int n_in, void* d_out, int out_size, void* d_ws, size_t ws_size, hipStream_t stream) {
    static int grid = 0;
    if (grid == 0) {
        if (n_in != 16 || out_size != M * DM || ws_size < WS_END) { fprintf(stderr, "kernel_launch: unexpected shapes (n_in %d, out %d, ws %zu)\n", n_in, out_size, ws_size); grid = -1; return; }
        int dev = 0, cus = 0, per_cu = 0;
        hipGetDevice(&dev);
        hipDeviceGetAttribute(&cus, hipDeviceAttributeMultiprocessorCount, dev);
        if (hipFuncSetAttribute((const void*)fwd_megakernel, hipFuncAttributeMaxDynamicSharedMemorySize, LDS_BYTES) != hipSuccess) { fprintf(stderr, "kernel_launch: hipFuncSetAttribute failed\n"); grid = -1; return; }
        if (hipOccupancyMaxActiveBlocksPerMultiprocessor(&per_cu, (const void*)fwd_megakernel, NTHR, LDS_BYTES) != hipSuccess || per_cu < 1) { fprintf(stderr, "kernel_launch: occupancy query says %d workgroups per CU; nothing launched\n", per_cu); grid = -1; return; }
        grid = cus;
        fprintf(stderr, "kernel_launch: grid %d (cus %d, per_cu %d)\n", grid, cus, per_cu);
    }
    if (grid < 0) return;
    if (hipMemsetAsync((unsigned char*)d_ws + WS_BAR, 0, XCD_BAR_WORDS * 4, stream) != hipSuccess) { fprintf(stderr, "kernel_launch: hipMemsetAsync failed\n"); return; }
    Args a{};
    for (int i = 0; i < 16; ++i) a.in[i] = (const float*)d_in[i];
    a.out = (float*)d_out; a.ws = (unsigned char*)d_ws;
    void* kargs[] = {&a};
    hipError_t e = hipLaunchCooperativeKernel((const void*)fwd_megakernel, dim3(grid), dim3(NTHR), kargs, LDS_BYTES, stream);
    if (e != hipSuccess) fprintf(stderr, "kernel_launch: cooperative launch failed: %s (grid %d)\n", hipGetErrorString(e), grid);
}
```

```cpp
#include <hip/hip_runtime.h>
#include <hip/hip_cooperative_groups.h>
#include <cstdio>
#include <cstdint>
namespace cg = cooperative_groups;

namespace pg8 {
#define PG8_LAS __attribute__((address_space(3)))
typedef unsigned short bf16_t;
typedef short bf16x8 __attribute__((ext_vector_type(8)));
typedef float f32x4 __attribute__((ext_vector_type(4)));
typedef unsigned u32x4 __attribute__((ext_vector_type(4)));
constexpr int BM = 256, BK = 64, HALF = 128, HTB = HALF * BK * 2  , STAGE_BYTES = 8 * HTB, NXCD = 8, WGM = 8;

__host__ __device__ __forceinline__ int lds_byte(int r, int c) { const int st = (r >> 4) * 2 + (c >> 5), rr = r & 15, cc = c & 31, ob = rr * 64 + cc * 2; return st * 1024 + (ob ^ (((ob >> 9) & 1) << 5)); }
__host__ __device__ __forceinline__ void stage_rc(int b, int& R, int& C) { const int st = b / 1024, sb = b % 1024, swz = sb ^ (((sb >> 9) & 1) << 5); R = (st >> 1) * 16 + swz / 64; C = (st & 1) * 32 + (swz % 64) / 2; }
__host__ __device__ __forceinline__ int perm32(int rho) { const int n = rho >> 4, i = rho & 15; return 8 * (i >> 2) + 4 * n + (i & 3); }

struct Unit { int pm, pn; };
struct Gemm { const bf16_t* A; const bf16_t* Bt; int M, N, K; };

struct StaticOrder {
    int nM, nN, nwg, G, c;
    __host__ __device__ void init(int M, int N, int G_, int c_) { nM = M / BM; nN = N / BM; nwg = nM * nN; G = G_; c = c_; }
    __host__ __device__ bool next(int i, Unit& u) const {
        const long L = (long)i * G + c; if (L >= nwg) return false;
        int wgid = (int)L; { const int q = nwg / NXCD, r = nwg % NXCD, xcd = wgid % NXCD, off = wgid / NXCD; wgid = (xcd < r ? xcd * (q + 1) : r * (q + 1) + (xcd - r) * q) + off; }
        const int nig = WGM * nN, gid = wgid / nig, fm = gid * WGM, gsz = (nM - fm) < WGM ? (nM - fm) : WGM;
        u.pm = fm + ((wgid % nig) % gsz); u.pn = (wgid % nig) / gsz; return true;
    }
    __device__ __forceinline__ void a_ready(const Unit&) const {}
    __device__ __forceinline__ void done(const Unit&) const {}
};

__device__ __forceinline__ unsigned cvt_pk_bf16(float lo, float hi) { unsigned r; asm("v_cvt_pk_bf16_f32 %0, %1, %2" : "=v"(r) : "v"(lo), "v"(hi)); return r; }

template <class Epi, class Sched, bool ALIGN_EPI = false, bool SP2 = false>
__device__ __forceinline__ void gemm_phase(PG8_LAS unsigned char* lds, const Gemm g, const Sched& S, const Epi& E) {
    int tid_ = threadIdx.x; asm volatile("" : "+v"(tid_));
    const int tid = tid_, wid = __builtin_amdgcn_readfirstlane(tid >> 6), lane = tid & 63, wr = wid >> 2, wc = wid & 3, fr = lane & 15, fq = lane >> 4;
    const int K = g.K, nt = K / BK;
    unsigned voffA[2], voffB[2];
#pragma unroll
    for (int i = 0; i < 2; ++i) { int R, C; stage_rc(tid * 16 + i * 8192, R, C); const int Rb = Epi::PERM ? ((R & ~31) + perm32(R & 31)) : R;
        voffA[i] = (unsigned)(R * K + C) * 2u; voffB[i] = (unsigned)(Rb * K + C) * 2u; }
    const size_t kstep = (size_t)(BK * 2);
    const size_t hstep = (size_t)HALF * K * 2;
    const size_t tstep = 2 * hstep;
    const unsigned ldsw = (unsigned)wid * 1024u;
    const int aoff = lds_byte(wr * 64 + fr, fq * 8), boff = lds_byte(wc * 32 + fr, fq * 8);
#define PG8_SA(b, h) (((b) * 2 + (h)) * HTB)
#define PG8_SB(b, h) ((4 + (b) * 2 + (h)) * HTB)
#define PG8_STAGE(bufoff, gbase, voff) do { _Pragma("unroll") for (int _i = 0; _i < 2; ++_i) \
        __builtin_amdgcn_global_load_lds((const unsigned*)((const char*)(gbase) + (voff)[_i]), (PG8_LAS unsigned*)(lds + (bufoff) + ldsw + _i * 8192), 16, 0, 0); } while (0)
#define PG8_LDA(dst, b, h) do { _Pragma("unroll") for (int m = 0; m < 4; ++m) _Pragma("unroll") for (int k = 0; k < 2; ++k) dst[m][k] = *(const PG8_LAS bf16x8*)(lds + PG8_SA(b, h) + aoff + m * 2048 + k * 1024); } while (0)
#define PG8_LDB(dst, b, h) do { _Pragma("unroll") for (int n = 0; n < 2; ++n) _Pragma("unroll") for (int k = 0; k < 2; ++k) dst[n][k] = *(const PG8_LAS bf16x8*)(lds + PG8_SB(b, h) + boff + n * 2048 + k * 1024); } while (0)
#define PG8_MMA(ai, bj, At, Bt) do { __builtin_amdgcn_s_setprio(1); _Pragma("unroll") for (int m = 0; m < 4; ++m) _Pragma("unroll") for (int n = 0; n < 2; ++n) _Pragma("unroll") for (int k = 0; k < 2; ++k) \
        acc[ai][bj][m][n] = __builtin_amdgcn_mfma_f32_16x16x32_bf16(Bt[n][k], At[m][k], acc[ai][bj][m][n], 0, 0, 0); __builtin_amdgcn_s_setprio(0); } while (0)
#define PG8_WAIT_V(n) asm volatile("s_waitcnt vmcnt(" #n ")" ::: "memory")
#define PG8_WAIT_L(n) asm volatile("s_waitcnt lgkmcnt(" #n ")" ::: "memory")
#define PG8_BAR __builtin_amdgcn_s_barrier()
#define PG8_SCHED __builtin_amdgcn_sched_barrier(0)
    Unit cur, nxt; int ui = 0;
    if (!S.next(0, cur)) return;
    f32x4 acc[2][2][4][2];
#pragma unroll
    for (int a = 0; a < 2; ++a)
#pragma unroll
        for (int b = 0; b < 2; ++b)
#pragma unroll
            for (int m = 0; m < 4; ++m)
#pragma unroll
                for (int n = 0; n < 2; ++n) acc[a][b][m][n] = (f32x4){0.f, 0.f, 0.f, 0.f};
    bf16x8 At[4][2], B0[2][2], B1[2][2];
    const char* cA = (const char*)g.A + (size_t)cur.pm * tstep; const char* cB = (const char*)g.Bt + (size_t)cur.pn * tstep;
    S.a_ready(cur);
    if constexpr (SP2) {
        PG8_STAGE(PG8_SB(0, 0), cB, voffB); PG8_STAGE(PG8_SB(0, 1), cB + hstep, voffB); PG8_STAGE(PG8_SA(0, 0), cA, voffA); PG8_STAGE(PG8_SA(0, 1), cA + hstep, voffA);
        if (wr == 1) PG8_BAR;
        PG8_WAIT_V(2); PG8_BAR;
        PG8_STAGE(PG8_SB(1, 0), cB + kstep, voffB); PG8_STAGE(PG8_SA(1, 0), cA + kstep, voffA); PG8_STAGE(PG8_SB(1, 1), cB + hstep + kstep, voffB);
        PG8_WAIT_V(6); PG8_BAR;
    } else {
        PG8_STAGE(PG8_SB(0, 0), cB, voffB); PG8_STAGE(PG8_SA(0, 0), cA, voffA); PG8_STAGE(PG8_SB(0, 1), cB + hstep, voffB); PG8_STAGE(PG8_SA(0, 1), cA + hstep, voffA);
        if (wr == 1) PG8_BAR;
        PG8_WAIT_V(4); PG8_BAR;
        PG8_STAGE(PG8_SB(1, 0), cB + kstep, voffB); PG8_STAGE(PG8_SA(1, 0), cA + kstep, voffA); PG8_STAGE(PG8_SB(1, 1), cB + hstep + kstep, voffB);
        PG8_WAIT_V(6); PG8_BAR;
    }
    for (;;) {
        const bool has_next = S.next(ui + 1, nxt);
        const char* nA = has_next ? (const char*)g.A + (size_t)nxt.pm * tstep : cA; const char* nB = has_next ? (const char*)g.Bt + (size_t)nxt.pn * tstep : cB;
        for (int t = 0; t < nt; t += 2) {
            const bool last = (t == nt - 2);
            const char* a1 = cA + (size_t)(t + 1) * kstep;
            const char* a2 = last ? nA : cA + (size_t)(t + 2) * kstep; const char* b2 = last ? nB : cB + (size_t)(t + 2) * kstep;
            const char* a3 = a2 + kstep; const char* b3 = b2 + kstep;
            if (last && has_next) S.a_ready(nxt);
            if constexpr (SP2) {
            PG8_LDB(B0, 0, 0); PG8_LDB(B1, 0, 1); PG8_SCHED; PG8_LDA(At, 0, 0); PG8_STAGE(PG8_SA(1, 1), a1 + hstep, voffA);
            PG8_WAIT_V(8); PG8_WAIT_L(0); PG8_BAR; PG8_MMA(0, 0, At, B0); PG8_MMA(0, 1, At, B1); PG8_BAR; PG8_SCHED;
            PG8_LDA(At, 0, 1); PG8_STAGE(PG8_SB(0, 0), b2, voffB); PG8_STAGE(PG8_SB(0, 1), b2 + hstep, voffB); PG8_STAGE(PG8_SA(0, 0), a2, voffA);
            PG8_WAIT_V(8); PG8_WAIT_L(0); PG8_BAR; PG8_MMA(1, 0, At, B0); PG8_MMA(1, 1, At, B1); PG8_BAR; PG8_SCHED;
            PG8_LDB(B0, 1, 0); PG8_LDB(B1, 1, 1); PG8_SCHED; PG8_LDA(At, 1, 0); PG8_STAGE(PG8_SA(0, 1), a2 + hstep, voffA);
            PG8_WAIT_V(8); PG8_WAIT_L(0); PG8_BAR; PG8_MMA(0, 0, At, B0); PG8_MMA(0, 1, At, B1); PG8_BAR; PG8_SCHED;
            PG8_LDA(At, 1, 1); PG8_STAGE(PG8_SB(1, 0), b3, voffB); PG8_STAGE(PG8_SB(1, 1), b3 + hstep, voffB); PG8_STAGE(PG8_SA(1, 0), a3, voffA);
            PG8_WAIT_V(8); PG8_WAIT_L(0); PG8_BAR; PG8_MMA(1, 0, At, B0); PG8_MMA(1, 1, At, B1); PG8_BAR; PG8_SCHED;
            } else {
            PG8_LDB(B0, 0, 0); PG8_SCHED; PG8_LDA(At, 0, 0); PG8_STAGE(PG8_SA(1, 1), a1 + hstep, voffA);
            PG8_WAIT_L(8); PG8_BAR; PG8_WAIT_L(0); PG8_MMA(0, 0, At, B0); PG8_BAR; PG8_SCHED;
            PG8_LDB(B1, 0, 1); PG8_STAGE(PG8_SB(0, 0), b2, voffB);
            PG8_BAR; PG8_WAIT_L(0); PG8_MMA(0, 1, At, B1); PG8_BAR;
            PG8_LDA(At, 0, 1); PG8_STAGE(PG8_SA(0, 0), a2, voffA);
            PG8_BAR; PG8_WAIT_L(0); PG8_MMA(1, 0, At, B0); PG8_BAR; PG8_SCHED;
            PG8_STAGE(PG8_SB(0, 1), b2 + hstep, voffB);
            PG8_WAIT_V(6); PG8_BAR; PG8_MMA(1, 1, At, B1); PG8_BAR;
            PG8_LDB(B0, 1, 0); PG8_SCHED; PG8_LDA(At, 1, 0); PG8_STAGE(PG8_SA(0, 1), a2 + hstep, voffA);
            PG8_WAIT_L(8); PG8_BAR; PG8_WAIT_L(0); PG8_MMA(0, 0, At, B0); PG8_BAR; PG8_SCHED;
            PG8_LDB(B1, 1, 1); PG8_STAGE(PG8_SB(1, 0), b3, voffB);
            PG8_BAR; PG8_WAIT_L(0); PG8_MMA(0, 1, At, B1); PG8_BAR;
            PG8_LDA(At, 1, 1); PG8_STAGE(PG8_SA(1, 0), a3, voffA);
            PG8_BAR; PG8_WAIT_L(0); PG8_MMA(1, 0, At, B0); PG8_BAR; PG8_SCHED;
            PG8_STAGE(PG8_SB(1, 1), b3 + hstep, voffB);
            PG8_WAIT_V(6); PG8_BAR; PG8_MMA(1, 1, At, B1); PG8_BAR;
            }
        }
        if constexpr (ALIGN_EPI) { if (wr == 0) PG8_BAR; }
        E(acc, cur, wr, wc, fr, fq); S.done(cur);
        if (!has_next) break;
#pragma unroll
        for (int a = 0; a < 2; ++a)
#pragma unroll
            for (int b = 0; b < 2; ++b)
#pragma unroll
                for (int m = 0; m < 4; ++m)
#pragma unroll
                    for (int n = 0; n < 2; ++n) acc[a][b][m][n] = (f32x4){0.f, 0.f, 0.f, 0.f};
        cur = nxt; cA = nA; cB = nB; ++ui;
        if constexpr (ALIGN_EPI) { if (wr == 1) PG8_BAR; }
    }
    PG8_WAIT_V(0);
    if constexpr (!ALIGN_EPI) { if (wr == 0) PG8_BAR; }
    PG8_BAR;
#undef PG8_SA
#undef PG8_SB
#undef PG8_STAGE
#undef PG8_LDA
#undef PG8_LDB
#undef PG8_MMA
#undef PG8_WAIT_V
#undef PG8_WAIT_L
#undef PG8_BAR
#undef PG8_SCHED
}
}

constexpr int NWAVES = 8, NTHR = 512;
constexpr int M = 24576, MP = 16384, DM = 2048, NIN = 3584, DFF = 5632;
constexpr int COL_K = 1024, COL_V = 1280, COL_U = 1536, COL_GV = 2560;
constexpr int NGC = 192;
constexpr float LN_EPS = 1e-5f;
constexpr float ALPHA = 1.189207115002721f;
constexpr float LOG2E = 1.4426950408889634f;

constexpr size_t MiB = 1u << 20;
constexpr size_t WS_WSB = 0, WS_GST = 512 * 1024, WS_BAR = 768 * 1024;
constexpr size_t WS_WIN = 1 * MiB, WS_WO = 15 * MiB, WS_W13 = 23 * MiB, WS_W2 = 67 * MiB, WS_ST1 = 89 * MiB;
constexpr size_t WS_XB = 90 * MiB;
constexpr size_t WS_H = 186 * MiB;
constexpr size_t WS_MIX = 354 * MiB;
constexpr size_t WS_HID = 186 * MiB;
constexpr size_t WS_END = 450 * MiB;
static_assert(WS_H + (size_t)M * NIN * 2 == WS_MIX && WS_MIX + (size_t)M * DM * 2 == WS_END && WS_HID + (size_t)M * DFF * 2 == WS_END, "ws map");

constexpr int LDS_BYTES = 131072 + 4096;

#define GAS __attribute__((address_space(1)))
#define LAS __attribute__((address_space(3)))
typedef unsigned short bf16;
typedef unsigned v4u __attribute__((ext_vector_type(4)));
typedef unsigned v2u __attribute__((ext_vector_type(2)));
typedef float f32x4 __attribute__((ext_vector_type(4)));
typedef float f32x2 __attribute__((ext_vector_type(2)));
typedef short bf16x8 __attribute__((ext_vector_type(8)));
using pg8::cvt_pk_bf16;
#define LDS_WAIT() asm volatile("s_waitcnt lgkmcnt(0)" ::: "memory")
__device__ __forceinline__ float bf_lo(unsigned w) { return __uint_as_float(w << 16); }
__device__ __forceinline__ float bf_hi(unsigned w) { return __uint_as_float(w & 0xffff0000u); }
__device__ __forceinline__ float wave_sum(float v) {
#pragma unroll
    for (int o = 1; o < 64; o <<= 1) v += __shfl_xor(v, o);
    return v;
}
__device__ __forceinline__ float gelu_tanh(float x) {
    const float t = x * (-2.3022082f + (-0.10294324f) * x * x);
    return x * __builtin_amdgcn_rcpf(1.0f + __builtin_amdgcn_exp2f(t));
}
__device__ __forceinline__ float silu_f(float x) { return x * __builtin_amdgcn_rcpf(1.0f + __builtin_amdgcn_exp2f(-LOG2E * x)); }

struct EpiH {
    static constexpr bool PERM = true;
    bf16* O; float* gst;
    __device__ __forceinline__ void operator()(const f32x4 (&acc)[2][2][4][2], const pg8::Unit& u, int wr, int wc, int fr, int fq) const {
        const int row0 = u.pm * 256 + wr * 64 + fr, col0 = u.pn * 256 + wc * 32 + 8 * fq;
        const bool act = u.pn >= 6, stat = u.pn >= 10;
#pragma unroll
        for (int ai = 0; ai < 2; ++ai)
#pragma unroll
            for (int m = 0; m < 4; ++m) { bf16* rowp = O + (size_t)(row0 + ai * 128 + m * 16) * NIN + col0;
                float rs = 0.f, rq = 0.f;
#pragma unroll
                for (int bj = 0; bj < 2; ++bj) { f32x4 v0 = acc[ai][bj][m][0], v1 = acc[ai][bj][m][1];
                    if (act) {
#pragma unroll
                        for (int i = 0; i < 4; ++i) { v0[i] = gelu_tanh(v0[i]); v1[i] = gelu_tanh(v1[i]); } }
                    v4u w; w.x = cvt_pk_bf16(v0[0], v0[1]); w.y = cvt_pk_bf16(v0[2], v0[3]); w.z = cvt_pk_bf16(v1[0], v1[1]); w.w = cvt_pk_bf16(v1[2], v1[3]);
                    *(v4u*)(rowp + bj * 128) = w;
                    if (stat) {
#pragma unroll
                        for (int t = 0; t < 4; ++t) { const float a = bf_lo(w[t]), b = bf_hi(w[t]); rs += a + b; rq += a * a + b * b; } } }
                if (stat) { rs += __shfl_xor(rs, 16); rs += __shfl_xor(rs, 32); rq += __shfl_xor(rq, 16); rq += __shfl_xor(rq, 32);
                    if (fq == 0) { float* gp = gst + 2 * (size_t)(row0 + ai * 128 + m * 16); __hip_atomic_fetch_add(gp, rs, __ATOMIC_RELAXED, __HIP_MEMORY_SCOPE_AGENT); __hip_atomic_fetch_add(gp + 1, rq, __ATOMIC_RELAXED, __HIP_MEMORY_SCOPE_AGENT); } } }
    }
};
struct EpiY1 {
    static constexpr bool PERM = true;
    const float* xp; const float* xs; bf16* Y;
    __device__ __forceinline__ void operator()(const f32x4 (&acc)[2][2][4][2], const pg8::Unit& u, int wr, int wc, int fr, int fq) const {
        const int row0 = u.pm * 256 + wr * 64 + fr, col0 = u.pn * 256 + wc * 32 + 8 * fq;
        const float* xb = (u.pm < MP / 256) ? xp : xs - (size_t)MP * DM;
#pragma unroll
        for (int ai = 0; ai < 2; ++ai)
#pragma unroll
            for (int m = 0; m < 4; ++m) { const size_t off = (size_t)(row0 + ai * 128 + m * 16) * DM + col0;
#pragma unroll
                for (int bj = 0; bj < 2; ++bj) { const f32x4 x0 = *(const f32x4*)(xb + off + bj * 128), x1 = *(const f32x4*)(xb + off + bj * 128 + 4);
                    const f32x4 y0 = x0 * ALPHA + acc[ai][bj][m][0], y1 = x1 * ALPHA + acc[ai][bj][m][1];
                    v4u w; w.x = cvt_pk_bf16(y0[0], y0[1]); w.y = cvt_pk_bf16(y0[2], y0[3]); w.z = cvt_pk_bf16(y1[0], y1[1]); w.w = cvt_pk_bf16(y1[2], y1[3]);
                    *(v4u*)(Y + off + bj * 128) = w; } }
    }
};
struct EpiHid {
    static constexpr bool PERM = true;
    bf16* O;
    __device__ __forceinline__ void operator()(const f32x4 (&acc)[2][2][4][2], const pg8::Unit& u, int wr, int wc, int fr, int fq) const {
        const int row0 = u.pm * 256 + wr * 64 + fr, col0 = u.pn * 128 + wc * 32 + 8 * fq;
#pragma unroll
        for (int ai = 0; ai < 2; ++ai)
#pragma unroll
            for (int m = 0; m < 4; ++m) {
                const f32x4 g0 = acc[ai][0][m][0], g1 = acc[ai][0][m][1], u0 = acc[ai][1][m][0], u1 = acc[ai][1][m][1];
                float h[8];
#pragma unroll
                for (int i = 0; i < 4; ++i) { h[i] = silu_f(g0[i]) * u0[i]; h[4 + i] = silu_f(g1[i]) * u1[i]; }
                v4u w; w.x = cvt_pk_bf16(h[0], h[1]); w.y = cvt_pk_bf16(h[2], h[3]); w.z = cvt_pk_bf16(h[4], h[5]); w.w = cvt_pk_bf16(h[6], h[7]);
                *(v4u*)(O + (size_t)(row0 + ai * 128 + m * 16) * DFF + col0) = w; }
    }
};
struct EpiY2 {
    static constexpr bool PERM = true;
    const bf16* Y1; bf16* Y2; const float* st1; const float* g1; const float* b1;
    __device__ __forceinline__ void operator()(const f32x4 (&acc)[2][2][4][2], const pg8::Unit& u, int wr, int wc, int fr, int fq) const {
        const int row0 = u.pm * 256 + wr * 64 + fr, col0 = u.pn * 256 + wc * 32 + 8 * fq;
        f32x4 gv[2][2], bv[2][2];
#pragma unroll
        for (int bj = 0; bj < 2; ++bj)
#pragma unroll
            for (int n = 0; n < 2; ++n) { gv[bj][n] = *(const f32x4*)(g1 + col0 + bj * 128 + n * 4) * ALPHA; bv[bj][n] = *(const f32x4*)(b1 + col0 + bj * 128 + n * 4) * ALPHA; }
#pragma unroll
        for (int ai = 0; ai < 2; ++ai)
#pragma unroll
            for (int m = 0; m < 4; ++m) { const int r = row0 + ai * 128 + m * 16; const size_t off = (size_t)r * DM + col0;
                const f32x2 st = *(const f32x2*)(st1 + 2 * r);
#pragma unroll
                for (int bj = 0; bj < 2; ++bj) { const v4u yw = *(const v4u*)(Y1 + off + bj * 128);
                    const f32x4 ya = (f32x4){bf_lo(yw.x), bf_hi(yw.x), bf_lo(yw.y), bf_hi(yw.y)}, yb = (f32x4){bf_lo(yw.z), bf_hi(yw.z), bf_lo(yw.w), bf_hi(yw.w)};
                    const f32x4 o0 = ((ya - st.x) * st.y) * gv[bj][0] + bv[bj][0] + acc[ai][bj][m][0], o1 = ((yb - st.x) * st.y) * gv[bj][1] + bv[bj][1] + acc[ai][bj][m][1];
                    v4u w; w.x = cvt_pk_bf16(o0[0], o0[1]); w.y = cvt_pk_bf16(o0[2], o0[3]); w.z = cvt_pk_bf16(o1[0], o1[1]); w.w = cvt_pk_bf16(o1[2], o1[3]);
                    *(v4u*)(Y2 + off + bj * 128) = w; } }
    }
};

__device__ __forceinline__ void p0_transpose_item(const float* W, int K, int N, bf16* WT, int drow0, int k0, int n0, LAS float* scr, int lane) {
    float v[32];
    const float* wp = W + (size_t)(k0 + (lane >> 5)) * N + n0 + (lane & 31);
#pragma unroll
    for (int i = 0; i < 32; ++i) v[i] = wp[(size_t)(2 * i) * N];
#pragma unroll
    for (int i = 0; i < 32; ++i) scr[(2 * i + (lane >> 5)) * 33 + (lane & 31)] = v[i];
    LDS_WAIT(); asm volatile("" ::: "memory");
    const int c = lane & 7;
#pragma unroll
    for (int j = 0; j < 4; ++j) { const int n = (lane >> 3) + 8 * j; const LAS float* s = scr + (8 * c) * 33 + n;
        v4u o; o.x = cvt_pk_bf16(s[0 * 33], s[1 * 33]); o.y = cvt_pk_bf16(s[2 * 33], s[3 * 33]); o.z = cvt_pk_bf16(s[4 * 33], s[5 * 33]); o.w = cvt_pk_bf16(s[6 * 33], s[7 * 33]);
        *(v4u*)(WT + (size_t)(drow0 + n) * K + k0 + 8 * c) = o; }
    LDS_WAIT(); asm volatile("" ::: "memory");
}

struct Args { const float* in[16]; float* out; unsigned char* ws; };

template <bool FINAL>
__device__ __forceinline__ void ln_rows(const bf16* src, float* dstf, bf16* dstb, float* stats, const float* g, const float* b, int gw, int NGW, int lane) {
    f32x4 gg[8], bb[8];
#pragma unroll
    for (int j = 0; j < 4; ++j) { gg[2 * j] = ((const f32x4*)g)[2 * (lane + 64 * j)]; gg[2 * j + 1] = ((const f32x4*)g)[2 * (lane + 64 * j) + 1];
        bb[2 * j] = ((const f32x4*)b)[2 * (lane + 64 * j)]; bb[2 * j + 1] = ((const f32x4*)b)[2 * (lane + 64 * j) + 1]; }
    for (int m = gw; m < M; m += NGW) {
        const v4u* xr = (const v4u*)(src + (size_t)m * DM) + lane;
        v4u raw[4];
#pragma unroll
        for (int j = 0; j < 4; ++j) raw[j] = xr[64 * j];
        f32x4 v[8]; float s = 0.f;
#pragma unroll
        for (int j = 0; j < 4; ++j) { v[2 * j] = (f32x4){bf_lo(raw[j].x), bf_hi(raw[j].x), bf_lo(raw[j].y), bf_hi(raw[j].y)}; v[2 * j + 1] = (f32x4){bf_lo(raw[j].z), bf_hi(raw[j].z), bf_lo(raw[j].w), bf_hi(raw[j].w)}; }
#pragma unroll
        for (int j = 0; j < 8; ++j) s += (v[j].x + v[j].y) + (v[j].z + v[j].w);
        const float mean = wave_sum(s) * (1.f / DM); float s2 = 0.f;
#pragma unroll
        for (int j = 0; j < 8; ++j) { v[j] = v[j] - mean; s2 += (v[j].x * v[j].x + v[j].y * v[j].y) + (v[j].z * v[j].z + v[j].w * v[j].w); }
        const float rstd = 1.f / sqrtf(wave_sum(s2) * (1.f / DM) + LN_EPS);
        if (FINAL) {
            f32x4* o = (f32x4*)(dstf + (size_t)m * DM) + 2 * lane;
#pragma unroll
            for (int j = 0; j < 4; ++j) { o[128 * j] = (v[2 * j] * rstd) * gg[2 * j] + bb[2 * j]; o[128 * j + 1] = (v[2 * j + 1] * rstd) * gg[2 * j + 1] + bb[2 * j + 1]; }
        } else {
            v4u* o = (v4u*)(dstb + (size_t)m * DM) + lane;
#pragma unroll
            for (int j = 0; j < 4; ++j) { const f32x4 y0 = (v[2 * j] * rstd) * gg[2 * j] + bb[2 * j], y1 = (v[2 * j + 1] * rstd) * gg[2 * j + 1] + bb[2 * j + 1];
                v4u w; w.x = cvt_pk_bf16(y0.x, y0.y); w.y = cvt_pk_bf16(y0.z, y0.w); w.z = cvt_pk_bf16(y1.x, y1.y); w.w = cvt_pk_bf16(y1.z, y1.w); o[64 * j] = w; }
            if (lane == 0) { stats[2 * m] = mean; stats[2 * m + 1] = rstd; }
        }
    }
}

constexpr int VT_PITCH = 784;
__device__ __forceinline__ void attn_head_scores(const LAS unsigned char* kbase, const bf16x8 (&qf)[4], int swz, int p0, float rel0f, float nslope2, float sink2, float pen0, float pen2, v4u (&pf)[9], float& inv) {
    f32x4 S[18];
#pragma unroll
    for (int j = 0; j < 18; ++j) {
        S[j] = (f32x4){0.f, 0.f, 0.f, 0.f};
#pragma unroll
        for (int ks = 0; ks < 4; ++ks) { const bf16x8 kf = *(const LAS bf16x8*)(kbase + (j >> 1) * 8192 + (j & 1) * 1024 + (((4 * ks) ^ swz) << 4));
            S[j] = __builtin_amdgcn_mfma_f32_16x16x32_bf16(kf, qf[ks], S[j], 0, 0, 0); }
        if (j & 1) __builtin_amdgcn_sched_barrier(0);
    }
    const float sc2 = 0.08838834764831845f * LOG2E;
    float mx = sink2;
    asm volatile("" : "+v"(rel0f));
#pragma unroll
    for (int t = 0; t < 9; ++t) { const int p = p0 + t; const float pen = p < 4 ? pen0 : (p >= 8 ? pen2 : 0.f);
#pragma unroll
        for (int e = 0; e < 2; ++e)
#pragma unroll
            for (int i = 0; i < 4; ++i) { const float relf = rel0f + (float)(32 * t + 4 * e + i);
                float sv = __builtin_fmaf(S[2 * t + e][i], sc2, __builtin_fmaf(__builtin_fabsf(relf), nslope2, pen));
                if (t == 0 || t == 8) sv = (__builtin_fabsf(relf) > 128.f) ? -1e30f : sv;
                S[2 * t + e][i] = sv; mx = fmaxf(mx, sv); } }
    mx = fmaxf(mx, __shfl_xor(mx, 16)); mx = fmaxf(mx, __shfl_xor(mx, 32));
    float sum = 0.f;
#pragma unroll
    for (int j = 0; j < 18; ++j)
#pragma unroll
        for (int i = 0; i < 4; ++i) { const float p = __builtin_amdgcn_exp2f(S[j][i] - mx); S[j][i] = p; sum += p; }
    sum += __shfl_xor(sum, 16); sum += __shfl_xor(sum, 32);
    inv = 1.0f / (sum + __builtin_amdgcn_exp2f(sink2 - mx));
#pragma unroll
    for (int t = 0; t < 9; ++t) { pf[t].x = cvt_pk_bf16(S[2 * t][0], S[2 * t][1]); pf[t].y = cvt_pk_bf16(S[2 * t][2], S[2 * t][3]);
        pf[t].z = cvt_pk_bf16(S[2 * t + 1][0], S[2 * t + 1][1]); pf[t].w = cvt_pk_bf16(S[2 * t + 1][2], S[2 * t + 1][3]); }
}
__device__ __forceinline__ void attn_head_pv(const LAS unsigned char* vbase, const v4u (&pf)[9], float inv, bf16* Og) {
#pragma unroll
    for (int dt = 0; dt < 8; ++dt) {
        f32x4 o = (f32x4){0.f, 0.f, 0.f, 0.f};
#pragma unroll
        for (int t = 0; t < 9; ++t) { const bf16x8 vf = *(const LAS bf16x8*)(vbase + 16 * dt * VT_PITCH + 64 * t);
            o = __builtin_amdgcn_mfma_f32_16x16x32_bf16(vf, __builtin_bit_cast(bf16x8, pf[t]), o, 0, 0, 0); }
        v2u w; w.x = cvt_pk_bf16(o[0] * inv, o[1] * inv); w.y = cvt_pk_bf16(o[2] * inv, o[3] * inv);
        *(v2u*)(Og + 16 * dt) = w;
        __builtin_amdgcn_sched_barrier(0);
    }
}
__device__ __forceinline__ void vt_write(LAS unsigned char* lds, const v4u (&in)[8], int dblk, int key0) {
#pragma unroll
    for (int i = 0; i < 8; ++i) { v4u o;
#pragma unroll
        for (int t = 0; t < 4; ++t) { const unsigned a = in[2 * t][i >> 1], b = in[2 * t + 1][i >> 1];
            o[t] = (i & 1) ? ((a >> 16) | (b & 0xffff0000u)) : ((a & 0xffffu) | (b << 16)); }
        *(LAS v4u*)(lds + (8 * dblk + i) * VT_PITCH + key0 * 2) = o; }
}
__device__ __forceinline__ void attn_unit(LAS unsigned char* lds, const bf16* H, bf16* MIX, const float* sink, int gc, int kv, int hp) {
    int tid_ = threadIdx.x; asm volatile("" : "+v"(tid_));
    const int tid = tid_, lane = tid & 63, wave = __builtin_amdgcn_readfirstlane(tid >> 6);
    const int c = gc & 15, fr = lane & 15, fq = lane >> 4, hA = 4 * kv + 2 * hp, hB = hA + 1;
    const int rowq0 = gc * 128, roww0 = rowq0 - 128;
    const bool v0 = (c != 0), v2 = (c != 15);
    const int p0 = wave >> 1;
    __syncthreads();
    {
        const bf16* Kg = H + COL_K + 128 * kv;
#pragma unroll
        for (int it = 0; it < 12; ++it) { const int ch = tid + it * NTHR, row = ch >> 4, cc = ch & 15, kb = row >> 7;
            const int grow = roww0 + row + ((kb == 0 && !v0) ? 128 : 0) - ((kb == 2 && !v2) ? 128 : 0);
            const v4u v = *(const v4u*)(Kg + (size_t)grow * NIN + cc * 8);
            const int g = (((row >> 3) & 3) << 2) | (row & 3);
            *(LAS v4u*)(lds + row * 256 + ((cc ^ g) << 4)) = v; }
    }
    bf16x8 qfA[4], qfB[4];
    { const bf16* Qg = H + (size_t)(rowq0 + 16 * wave + fr) * NIN + 128 * hA + 8 * fq;
#pragma unroll
      for (int ks = 0; ks < 4; ++ks) { qfA[ks] = *(const bf16x8*)(Qg + 32 * ks); qfB[ks] = *(const bf16x8*)(Qg + 128 + 32 * ks); } }
    const int r = tid & 255, sblk = r >> 4, dblk = r & 15;
    v4u vin0[8], vin1[8];
    { const bf16* Vg = H + COL_V + 128 * kv + 8 * dblk;
      const int kb = tid >> 8, key0 = 128 * kb + 8 * sblk, grow = roww0 + key0 + ((kb == 0 && !v0) ? 128 : 0);
#pragma unroll
      for (int jj = 0; jj < 8; ++jj) vin0[jj] = *(const v4u*)(Vg + (size_t)(grow + jj) * NIN);
      if (wave < 4) { const int grow2 = roww0 + 256 + 8 * sblk - (v2 ? 0 : 128);
#pragma unroll
          for (int jj = 0; jj < 8; ++jj) vin1[jj] = *(const v4u*)(Vg + (size_t)(grow2 + jj) * NIN); } }
    __syncthreads();
    const int qi = 16 * wave + fr;
    float rel0f = (float)(32 * p0 + 8 * fq - 128 - qi);
    asm volatile("" : "+v"(rel0f));
    const float pen0 = v0 ? 0.f : -1e30f, pen2 = v2 ? 0.f : -1e30f;
    const LAS unsigned char* kbase = lds + (32 * p0 + 8 * (fr >> 2) + (fr & 3)) * 256;
    const int swz = fq ^ fr;
    v4u pfA[9], pfB[9]; float invA, invB;
    attn_head_scores(kbase, qfA, swz, p0, rel0f, -__builtin_amdgcn_exp2f(-(float)(hA + 1)) * LOG2E, sink[hA] * LOG2E, pen0, pen2, pfA, invA);
    attn_head_scores(kbase, qfB, swz, p0, rel0f, -__builtin_amdgcn_exp2f(-(float)(hB + 1)) * LOG2E, sink[hB] * LOG2E, pen0, pen2, pfB, invB);
    __syncthreads();
    vt_write(lds, vin0, dblk, 128 * (tid >> 8) + 8 * sblk);
    if (wave < 4) vt_write(lds, vin1, dblk, 256 + 8 * sblk);
    __syncthreads();
    const LAS unsigned char* vbase = lds + fr * VT_PITCH + 64 * p0 + 16 * fq;
    bf16* Og = MIX + (size_t)(rowq0 + 16 * wave + fr) * DM + 128 * hA + 4 * fq;
    attn_head_pv(vbase, pfA, invA, Og);
    attn_head_pv(vbase, pfB, invB, Og + 128);
}

constexpr int GT_PITCH = 272, GT_BYTES = 128 * GT_PITCH;
__device__ __forceinline__ void sgu_pair(LAS unsigned char* lds, const bf16* H, bf16* MIX, const float* lng, const float* lnb, const bf16* wsb, const float* b_s, const float* gst, int gc, int gp) {
    int tid_ = threadIdx.x; asm volatile("" : "+v"(tid_));
    const int tid = tid_, lane = tid & 63, wave = __builtin_amdgcn_readfirstlane(tid >> 6);
    const int r0 = gc * 128, fr = lane & 15, fq = lane >> 4;
    __syncthreads();
    { const int gsel = tid >> 8, r = tid & 255, sblk = r >> 4, dblk = r & 15, g = 2 * gp + gsel, ch0 = 128 * g + 8 * dblk;
      const f32x4 ga = *(const f32x4*)(lng + ch0), gb = *(const f32x4*)(lng + ch0 + 4), ba = *(const f32x4*)(lnb + ch0), bb = *(const f32x4*)(lnb + ch0 + 4);
      const float gam[8] = {ga.x, ga.y, ga.z, ga.w, gb.x, gb.y, gb.z, gb.w}, bet[8] = {ba.x, ba.y, ba.z, ba.w, bb.x, bb.y, bb.z, bb.w};
      v4u in[8]; f32x2 st[8];
#pragma unroll
      for (int jj = 0; jj < 8; ++jj) { in[jj] = *(const v4u*)(H + (size_t)(r0 + 8 * sblk + jj) * NIN + COL_GV + ch0); st[jj] = *(const f32x2*)(gst + 2 * (size_t)(r0 + 8 * sblk + jj)); }
#pragma unroll
      for (int jj = 0; jj < 8; ++jj) { const float mean = st[jj].x * (1.f / 1024.f), var = fmaxf(st[jj].y * (1.f / 1024.f) - mean * mean, 0.f); st[jj].x = mean; st[jj].y = 1.f / sqrtf(var + LN_EPS); }
#pragma unroll
      for (int i = 0; i < 8; ++i) { v4u o;
#pragma unroll
          for (int t = 0; t < 4; ++t) { const unsigned a = in[2 * t][i >> 1], b = in[2 * t + 1][i >> 1];
              const float xa = (i & 1) ? bf_hi(a) : bf_lo(a), xb = (i & 1) ? bf_hi(b) : bf_lo(b);
              o[t] = cvt_pk_bf16((xa - st[2 * t].x) * st[2 * t].y * gam[i] + bet[i], (xb - st[2 * t + 1].x) * st[2 * t + 1].y * gam[i] + bet[i]); }
          *(LAS v4u*)(lds + gsel * GT_BYTES + (8 * dblk + i) * GT_PITCH + 16 * sblk) = o; } }
    const int gsel = wave >> 2, tq = wave & 3, g = 2 * gp + gsel;
    bf16x8 wf[2][4];
#pragma unroll
    for (int tt = 0; tt < 2; ++tt)
#pragma unroll
        for (int ks = 0; ks < 4; ++ks) wf[tt][ks] = *(const bf16x8*)(wsb + (size_t)(g * 128 + 32 * tq + 16 * tt + fr) * 128 + 32 * ks + 8 * fq);
    __syncthreads();
    const LAS unsigned char* Gb = lds + gsel * GT_BYTES + fr * GT_PITCH + 16 * fq;
    const float bias0 = b_s[g * 128 + 32 * tq + fr], bias1 = b_s[g * 128 + 32 * tq + 16 + fr];
#pragma unroll
    for (int dt = 0; dt < 8; ++dt) {
        f32x4 a0 = (f32x4){0.f, 0.f, 0.f, 0.f}, a1 = a0;
#pragma unroll
        for (int ks = 0; ks < 4; ++ks) { const bf16x8 gf = *(const LAS bf16x8*)(Gb + 16 * dt * GT_PITCH + 64 * ks);
            a0 = __builtin_amdgcn_mfma_f32_16x16x32_bf16(gf, wf[0][ks], a0, 0, 0, 0);
            a1 = __builtin_amdgcn_mfma_f32_16x16x32_bf16(gf, wf[1][ks], a1, 0, 0, 0); }
#pragma unroll
        for (int tt = 0; tt < 2; ++tt) { const int t = 32 * tq + 16 * tt + fr; const float bias = tt ? bias1 : bias0; const f32x4 a = tt ? a1 : a0;
            const v2u uu = *(const v2u*)(H + (size_t)(r0 + t) * NIN + COL_U + 128 * g + 16 * dt + 4 * fq);
            v2u w; w.x = cvt_pk_bf16(bf_lo(uu.x) * (a[0] + bias), bf_hi(uu.x) * (a[1] + bias)); w.y = cvt_pk_bf16(bf_lo(uu.y) * (a[2] + bias), bf_hi(uu.y) * (a[3] + bias));
            *(v2u*)(MIX + (size_t)(r0 + t) * DM + 1024 + 128 * g + 16 * dt + 4 * fq) = w; }
    }
}

#define XB_TMO      128
#define XB_XCNT(j)  (256  + 64 * (j))
#define XB_XSUB(j)  (1280 + 64 * (j))
#define XB_XGEN(j)  (2304 + 64 * (j))
#define XB_TOP      3328
#define XB_TOPGEN   3392
#define XCD_BAR_WORDS 3456
#define XB_SPIN_CAP (1u << 18)
__device__ __forceinline__ unsigned xb_ld(unsigned* p)              { return __hip_atomic_load(p, __ATOMIC_RELAXED, __HIP_MEMORY_SCOPE_AGENT); }
__device__ __forceinline__ unsigned xb_add(unsigned* p, unsigned v) { return __hip_atomic_fetch_add(p, v, __ATOMIC_RELAXED, __HIP_MEMORY_SCOPE_AGENT); }
__device__ __forceinline__ unsigned xb_xcc_id() { return (unsigned)__builtin_amdgcn_s_getreg((3 << 11) | 20) & 0xFu; }
#define XB_SPIN(cond, bar) do { unsigned _sp = 0; while (cond) { __builtin_amdgcn_s_sleep(1); \
    if ((++_sp & 255u) == 0u) { if (xb_ld(&(bar)[XB_TMO])) break; if (_sp > XB_SPIN_CAP) { atomicAdd(&(bar)[XB_TMO], 1u); break; } } } } while (0)
struct XcdBarrier { unsigned* bar; unsigned x; volatile LAS unsigned* st; };
__device__ __forceinline__ XcdBarrier xcd_barrier_post(unsigned* bar, volatile LAS unsigned* st) {
    XcdBarrier b; b.bar = bar; b.x = xb_xcc_id(); b.st = st;
    if (threadIdx.x == 0) (void)xb_add(&bar[XB_XCNT(b.x)], 1u);
    return b;
}
__device__ __forceinline__ void xcd_barrier_complete(unsigned* bar, unsigned x, unsigned& nloc, unsigned& nx) {
    const unsigned G = gridDim.x * gridDim.y * gridDim.z;
    unsigned sum, cnt, mine, sp = 0u;
    for (;;) {
        sum = 0u; cnt = 0u; mine = 0u;
#pragma unroll
        for (unsigned j = 0; j < 16; ++j) { const unsigned c = xb_ld(&bar[XB_XCNT(j)]); sum += c; cnt += (c > 0u) ? 1u : 0u; mine = (j == x) ? c : mine; }
        if (sum == G) break;
        __builtin_amdgcn_s_sleep(1);
        if ((++sp & 255u) == 0u) { if (xb_ld(&bar[XB_TMO])) break; if (sp > XB_SPIN_CAP) { atomicAdd(&bar[XB_TMO], 1u); break; } }
    }
    nloc = mine > 0u ? mine : 1u; nx = cnt > 0u ? cnt : 1u;
}
__device__ __forceinline__ void xcd_barrier(const XcdBarrier& b) {
    asm volatile("s_waitcnt vmcnt(0)" ::: "memory");
    __syncthreads();
    if (threadIdx.x == 0) {
        unsigned* bar = b.bar;
        __builtin_amdgcn_s_waitcnt(0);
        unsigned nloc = b.st[0], nx = b.st[1];
        if (nloc == 0u) { xcd_barrier_complete(bar, b.x, nloc, nx); b.st[0] = nloc; b.st[1] = nx; }
        const unsigned old = xb_add(&bar[XB_XSUB(b.x)], 1u);
        const unsigned gen = old / nloc;
        if (old + 1u == (gen + 1u) * nloc) {
            __builtin_amdgcn_fence(__ATOMIC_RELEASE, "agent");
            asm volatile("s_waitcnt vmcnt(0)" ::: "memory");
            const unsigned og = xb_add(&bar[XB_TOP], 1u);
            const unsigned tg = og / nx;
            if (og + 1u == (tg + 1u) * nx) xb_add(&bar[XB_TOPGEN], 1u);
            else XB_SPIN(xb_ld(&bar[XB_TOPGEN]) == tg, bar);
            __builtin_amdgcn_fence(__ATOMIC_ACQUIRE, "agent");
            xb_add(&bar[XB_XGEN(b.x)], 1u);
            asm volatile("s_waitcnt vmcnt(0)" ::: "memory");
        } else {
            XB_SPIN(xb_ld(&bar[XB_XGEN(b.x)]) == gen, bar);
            __builtin_amdgcn_fence(__ATOMIC_ACQUIRE, "agent");
            asm volatile("s_waitcnt vmcnt(0)" ::: "memory");
        }
    }
    __syncthreads();
}

#ifndef PH_MASK
#define PH_MASK 0xff
#endif
#ifndef DUP_MASK
#define DUP_MASK 0
#endif
#define GSYNC() xcd_barrier(xbar)
#define REP(k) for (int rep_ = 0; rep_ < (((DUP_MASK >> (k)) & 1) ? 2 : 1); ++rep_, (rep_ < (((DUP_MASK >> (k)) & 1) ? 2 : 1) ? GSYNC() : (void)0))
__global__ void __launch_bounds__(NTHR, 2) fwd_megakernel(Args args) {
    extern __shared__ __attribute__((aligned(16))) unsigned char lds_raw[];
    LAS unsigned char* lds = (LAS unsigned char*)lds_raw;
    const int tid = threadIdx.x, lane = tid & 63, wave = __builtin_amdgcn_readfirstlane(tid >> 6);
    const int G = gridDim.x, bx = blockIdx.x;
    const int vcu = (G % 8 == 0) ? (bx % 8) * (G / 8) + bx / 8 : bx;
    unsigned char* ws = args.ws;
    const float* xp = args.in[0]; const float* xs = args.in[1];
    const float* w_in = args.in[2]; const float* ln_sgu_g = args.in[3]; const float* ln_sgu_b = args.in[4]; const float* w_s = args.in[5]; const float* b_s = args.in[6];
    const float* sink = args.in[7]; const float* w_o = args.in[8]; const float* ln1_g = args.in[9]; const float* ln1_b = args.in[10];
    const float* w_gate = args.in[11]; const float* w_up = args.in[12]; const float* w_down = args.in[13]; const float* ln2_g = args.in[14]; const float* ln2_b = args.in[15];
    float* out = args.out;
    bf16* WIN_T = (bf16*)(ws + WS_WIN); bf16* WO_T = (bf16*)(ws + WS_WO); bf16* W13_T = (bf16*)(ws + WS_W13); bf16* W2_T = (bf16*)(ws + WS_W2);
    bf16* Y1B = (bf16*)out;
    bf16* Y2B = (bf16*)(ws + WS_XB);
    float* ST1 = (float*)(ws + WS_ST1); float* GST = (float*)(ws + WS_GST); bf16* WSB = (bf16*)(ws + WS_WSB);
    bf16* XB = (bf16*)(ws + WS_XB); bf16* Hb = (bf16*)(ws + WS_H); bf16* MIX = (bf16*)(ws + WS_MIX); bf16* HID = (bf16*)(ws + WS_HID);
    const int gw = vcu * NWAVES + wave, NGW = G * NWAVES;
    if (tid < 2) ((volatile LAS unsigned*)(lds + 131072 + 2048))[tid] = 0u;
    __syncthreads();
    const XcdBarrier xbar = xcd_barrier_post((unsigned*)(ws + WS_BAR), (volatile LAS unsigned*)(lds + 131072 + 2048));

    if constexpr ((PH_MASK & 1) != 0) {
        LAS float* scr = (LAS float*)(lds + wave * 16384);
        constexpr int I_IN = (DM / 64) * (NIN / 32);
        for (int it = gw; it < I_IN; it += NGW) { const int nb = it % (NIN / 32), kb = it / (NIN / 32); p0_transpose_item(w_in, DM, NIN, WIN_T, 32 * nb, 64 * kb, 32 * nb, scr, lane); }
        { const int gt = bx * NTHR + tid;
          if (gt < M * 2 / 4) ((f32x4*)GST)[gt] = (f32x4){0.f, 0.f, 0.f, 0.f};
          if (gt < 8 * 128 * 128 / 8) { const f32x4 a = *(const f32x4*)(w_s + 8 * gt), b = *(const f32x4*)(w_s + 8 * gt + 4);
              v4u w; w.x = cvt_pk_bf16(a.x, a.y); w.y = cvt_pk_bf16(a.z, a.w); w.z = cvt_pk_bf16(b.x, b.y); w.w = cvt_pk_bf16(b.z, b.w); *(v4u*)(WSB + 8 * gt) = w; } }
        const size_t n8 = (size_t)M * DM / 8, nthr = (size_t)G * NTHR;
        for (size_t i = (size_t)bx * NTHR + tid; i < n8; i += nthr) { const size_t e = i * 8;
            const float* src = (e < (size_t)MP * DM) ? xp + e : xs + (e - (size_t)MP * DM);
            const f32x4 a = *(const f32x4*)src, b = *(const f32x4*)(src + 4);
            v4u w; w.x = cvt_pk_bf16(a.x, a.y); w.y = cvt_pk_bf16(a.z, a.w); w.z = cvt_pk_bf16(b.x, b.y); w.w = cvt_pk_bf16(b.z, b.w);
            *(v4u*)(XB + e) = w; }
    }
    GSYNC();
    REP(1) if constexpr ((PH_MASK & 2) != 0) { pg8::Gemm g{XB, WIN_T, M, NIN, DM}; pg8::StaticOrder S; S.init(M, NIN, G, bx); EpiH E{Hb, GST};
      pg8::gemm_phase<EpiH, pg8::StaticOrder, true, true>(lds, g, S, E);
      const int nfull = (M / 256) * (NIN / 256) / G, nrem = (M / 256) * (NIN / 256) - nfull * G;
      if (bx >= nrem) {
          LAS float* scr = (LAS float*)(lds + wave * 16384);
          constexpr int I_O = (DM / 64) * (DM / 32), I_G = (DM / 64) * (DFF / 32), I_D = (DFF / 64) * (DM / 32);
          const int cw = (bx - nrem) * NWAVES + wave, NCW = (G - nrem) * NWAVES;
          for (int it = cw; it < I_O + 2 * I_G + I_D; it += NCW) {
              int r = it;
              if (r < I_O) { const int nb = r % (DM / 32), kb = r / (DM / 32); p0_transpose_item(w_o, DM, DM, WO_T, 32 * nb, 64 * kb, 32 * nb, scr, lane); continue; } r -= I_O;
              if (r < 2 * I_G) { const int up = r >= I_G ? 1 : 0; if (up) r -= I_G; const int nb = r % (DFF / 32), kb = r / (DFF / 32), n0 = 32 * nb;
                  p0_transpose_item(up ? w_up : w_gate, DM, DFF, W13_T, (n0 >> 7) * 256 + up * 128 + (n0 & 127), 64 * kb, n0, scr, lane); continue; } r -= 2 * I_G;
              { const int nb = r % (DM / 32), kb = r / (DM / 32); p0_transpose_item(w_down, DFF, DM, W2_T, 32 * nb, 64 * kb, 32 * nb, scr, lane); }
          }
      } }
    GSYNC();
    REP(2) if constexpr ((PH_MASK & 4) != 0) {
      for (int it = vcu; it < NGC * 8; it += G) {
#ifndef NO_ATTN
        if (it < NGC * 4) { attn_unit(lds, Hb, MIX, sink, it >> 2, (it >> 1) & 1, it & 1); if (DUP_MASK & 64) attn_unit(lds, Hb, MIX, sink, it >> 2, (it >> 1) & 1, it & 1); }
#endif
#ifndef NO_SGU
        if (it >= NGC * 4) { const int a = it - NGC * 4; sgu_pair(lds, Hb, MIX, ln_sgu_g, ln_sgu_b, WSB, b_s, GST, a >> 2, a & 3); if (DUP_MASK & 128) sgu_pair(lds, Hb, MIX, ln_sgu_g, ln_sgu_b, WSB, b_s, GST, a >> 2, a & 3); }
#endif
    } }
    GSYNC();
    REP(3) if constexpr ((PH_MASK & 8) != 0) { pg8::Gemm g{MIX, WO_T, M, DM, DM}; pg8::StaticOrder S; S.init(M, DM, G, bx); EpiY1 E{xp, xs, Y1B};
      pg8::gemm_phase<EpiY1, pg8::StaticOrder, true, true>(lds, g, S, E); }
    GSYNC();
    REP(4) if constexpr ((PH_MASK & 16) != 0) ln_rows<false>(Y1B, nullptr, XB, ST1, ln1_g, ln1_b, gw, NGW, lane);
    GSYNC();
    REP(5) if constexpr ((PH_MASK & 32) != 0) { pg8::Gemm g{XB, W13_T, M, 2 * DFF, DM}; pg8::StaticOrder S; S.init(M, 2 * DFF, G, bx); EpiHid E{HID};
      pg8::gemm_phase<EpiHid, pg8::StaticOrder, true, true>(lds, g, S, E); }
    GSYNC();
    if constexpr ((PH_MASK & 64) != 0) { pg8::Gemm g{HID, W2_T, M, DM, DFF}; pg8::StaticOrder S; S.init(M, DM, G, bx); EpiY2 E{Y1B, Y2B, ST1, ln1_g, ln1_b};
      pg8::gemm_phase<EpiY2, pg8::StaticOrder, true, true>(lds, g, S, E); }
    GSYNC();
#ifdef SYNC_PROBE
    for (int i = 0; i < 16; ++i) GSYNC();
#endif
    if constexpr ((PH_MASK & 128) != 0) ln_rows<true>(Y2B, out, nullptr, nullptr, ln2_g, ln2_b, gw, NGW, lane);
}

extern "C" void kernel_launch(void* const* d_in, const int* in_sizes, int n_in, void* d_out, int out_size, void* d_ws, size_t ws_size, hipStream_t stream) {
    static int grid = 0;
    if (grid == 0) {
        if (n_in != 16 || out_size != M * DM || ws_size < WS_END) { fprintf(stderr, "kernel_launch: unexpected shapes (n_in %d, out %d, ws %zu)\n", n_in, out_size, ws_size); grid = -1; return; }
        int dev = 0, cus = 0, per_cu = 0;
        hipGetDevice(&dev);
        hipDeviceGetAttribute(&cus, hipDeviceAttributeMultiprocessorCount, dev);
        if (hipFuncSetAttribute((const void*)fwd_megakernel, hipFuncAttributeMaxDynamicSharedMemorySize, LDS_BYTES) != hipSuccess) { fprintf(stderr, "kernel_launch: hipFuncSetAttribute failed\n"); grid = -1; return; }
        if (hipOccupancyMaxActiveBlocksPerMultiprocessor(&per_cu, (const void*)fwd_megakernel, NTHR, LDS_BYTES) != hipSuccess || per_cu < 1) { fprintf(stderr, "kernel_launch: occupancy query says %d workgroups per CU; nothing launched\n", per_cu); grid = -1; return; }
        grid = cus;
        fprintf(stderr, "kernel_launch: grid %d (cus %d, per_cu %d)\n", grid, cus, per_cu);
    }
    if (grid < 0) return;
    if (hipMemsetAsync((unsigned char*)d_ws + WS_BAR, 0, XCD_BAR_WORDS * 4, stream) != hipSuccess) { fprintf(stderr, "kernel_launch: hipMemsetAsync failed\n"); return; }
    Args a{};
    for (int i = 0; i < 16; ++i) a.in[i] = (const float*)d_in[i];
    a.out = (float*)d_out; a.ws = (unsigned char*)d_ws;
    void* kargs[] = {&a};
    hipError_t e = hipLaunchCooperativeKernel((const void*)fwd_megakernel, dim3(grid), dim3(NTHR), kargs, LDS_BYTES, stream);
    if (e != hipSuccess) fprintf(stderr, "kernel_launch: cooperative launch failed: %s (grid %d)\n", hipGetErrorString(e), grid);
}
```

```cpp
#include <hip/hip_runtime.h>
#include <hip/hip_cooperative_groups.h>
#include <cstdio>
#include <cstdint>
namespace cg = cooperative_groups;

namespace pg8 {
#define PG8_LAS __attribute__((address_space(3)))
typedef unsigned short bf16_t;
typedef short bf16x8 __attribute__((ext_vector_type(8)));
typedef float f32x4 __attribute__((ext_vector_type(4)));
typedef unsigned u32x4 __attribute__((ext_vector_type(4)));
constexpr int BM = 256, BK = 64, HALF = 128, HTB = HALF * BK * 2  , STAGE_BYTES = 8 * HTB, NXCD = 8, WGM = 8;

__host__ __device__ __forceinline__ int lds_byte(int r, int c) { const int st = (r >> 4) * 2 + (c >> 5), rr = r & 15, cc = c & 31, ob = rr * 64 + cc * 2; return st * 1024 + (ob ^ (((ob >> 9) & 1) << 5)); }
__host__ __device__ __forceinline__ void stage_rc(int b, int& R, int& C) { const int st = b / 1024, sb = b % 1024, swz = sb ^ (((sb >> 9) & 1) << 5); R = (st >> 1) * 16 + swz / 64; C = (st & 1) * 32 + (swz % 64) / 2; }
__host__ __device__ __forceinline__ int perm32(int rho) { const int n = rho >> 4, i = rho & 15; return 8 * (i >> 2) + 4 * n + (i & 3); }

struct Unit { int pm, pn; };
struct Gemm { const bf16_t* A; const bf16_t* Bt; int M, N, K; };

struct StaticOrder {
    int nM, nN, nwg, G, c;
    __host__ __device__ void init(int M, int N, int G_, int c_) { nM = M / BM; nN = N / BM; nwg = nM * nN; G = G_; c = c_; }
    __host__ __device__ bool next(int i, Unit& u) const {
        const long L = (long)i * G + c; if (L >= nwg) return false;
        int wgid = (int)L; { const int q = nwg / NXCD, r = nwg % NXCD, xcd = wgid % NXCD, off = wgid / NXCD; wgid = (xcd < r ? xcd * (q + 1) : r * (q + 1) + (xcd - r) * q) + off; }
        const int nig = WGM * nN, gid = wgid / nig, fm = gid * WGM, gsz = (nM - fm) < WGM ? (nM - fm) : WGM;
        u.pm = fm + ((wgid % nig) % gsz); u.pn = (wgid % nig) / gsz; return true;
    }
    __device__ __forceinline__ void a_ready(const Unit&) const {}
    __device__ __forceinline__ void done(const Unit&) const {}
};

__device__ __forceinline__ unsigned cvt_pk_bf16(float lo, float hi) { unsigned r; asm("v_cvt_pk_bf16_f32 %0, %1, %2" : "=v"(r) : "v"(lo), "v"(hi)); return r; }

template <class Epi, class Sched, bool ALIGN_EPI = false, bool SP2 = false>
__device__ __forceinline__ void gemm_phase(PG8_LAS unsigned char* lds, const Gemm g, const Sched& S, const Epi& E) {
    int tid_ = threadIdx.x; asm volatile("" : "+v"(tid_));
    const int tid = tid_, wid = __builtin_amdgcn_readfirstlane(tid >> 6), lane = tid & 63, wr = wid >> 2, wc = wid & 3, fr = lane & 15, fq = lane >> 4;
    const int K = g.K, nt = K / BK;
    unsigned voffA[2], voffB[2];
#pragma unroll
    for (int i = 0; i < 2; ++i) { int R, C; stage_rc(tid * 16 + i * 8192, R, C); const int Rb = Epi::PERM ? ((R & ~31) + perm32(R & 31)) : R;
        voffA[i] = (unsigned)(R * K + C) * 2u; voffB[i] = (unsigned)(Rb * K + C) * 2u; }
    const size_t kstep = (size_t)(BK * 2);
    const size_t hstep = (size_t)HALF * K * 2;
    const size_t tstep = 2 * hstep;
    const unsigned ldsw = (unsigned)wid * 1024u;
    const int aoff = lds_byte(wr * 64 + fr, fq * 8), boff = lds_byte(wc * 32 + fr, fq * 8);
#define PG8_SA(b, h) (((b) * 2 + (h)) * HTB)
#define PG8_SB(b, h) ((4 + (b) * 2 + (h)) * HTB)
#define PG8_STAGE(bufoff, gbase, voff) do { _Pragma("unroll") for (int _i = 0; _i < 2; ++_i) \
        __builtin_amdgcn_global_load_lds((const unsigned*)((const char*)(gbase) + (voff)[_i]), (PG8_LAS unsigned*)(lds + (bufoff) + ldsw + _i * 8192), 16, 0, 0); } while (0)
#define PG8_LDA(dst, b, h) do { _Pragma("unroll") for (int m = 0; m < 4; ++m) _Pragma("unroll") for (int k = 0; k < 2; ++k) dst[m][k] = *(const PG8_LAS bf16x8*)(lds + PG8_SA(b, h) + aoff + m * 2048 + k * 1024); } while (0)
#define PG8_LDB(dst, b, h) do { _Pragma("unroll") for (int n = 0; n < 2; ++n) _Pragma("unroll") for (int k = 0; k < 2; ++k) dst[n][k] = *(const PG8_LAS bf16x8*)(lds + PG8_SB(b, h) + boff + n * 2048 + k * 1024); } while (0)
#define PG8_MMA(ai, bj, At, Bt) do { __builtin_amdgcn_s_setprio(1); _Pragma("unroll") for (int m = 0; m < 4; ++m) _Pragma("unroll") for (int n = 0; n < 2; ++n) _Pragma("unroll") for (int k = 0; k < 2; ++k) \
        acc[ai][bj][m][n] = __builtin_amdgcn_mfma_f32_16x16x32_bf16(Bt[n][k], At[m][k], acc[ai][bj][m][n], 0, 0, 0); __builtin_amdgcn_s_setprio(0); } while (0)
#define PG8_WAIT_V(n) asm volatile("s_waitcnt vmcnt(" #n ")" ::: "memory")
#define PG8_WAIT_L(n) asm volatile("s_waitcnt lgkmcnt(" #n ")" ::: "memory")
#define PG8_BAR __builtin_amdgcn_s_barrier()
#define PG8_SCHED __builtin_amdgcn_sched_barrier(0)
    Unit cur, nxt; int ui = 0;
    if (!S.next(0, cur)) return;
    f32x4 acc[2][2][4][2];
#pragma unroll
    for (int a = 0; a < 2; ++a)
#pragma unroll
        for (int b = 0; b < 2; ++b)
#pragma unroll
            for (int m = 0; m < 4; ++m)
#pragma unroll
                for (int n = 0; n < 2; ++n) acc[a][b][m][n] = (f32x4){0.f, 0.f, 0.f, 0.f};
    bf16x8 At[4][2], B0[2][2], B1[2][2];
    const char* cA = (const char*)g.A + (size_t)cur.pm * tstep; const char* cB = (const char*)g.Bt + (size_t)cur.pn * tstep;
    S.a_ready(cur);
    if constexpr (SP2) {
        PG8_STAGE(PG8_SB(0, 0), cB, voffB); PG8_STAGE(PG8_SB(0, 1), cB + hstep, voffB); PG8_STAGE(PG8_SA(0, 0), cA, voffA); PG8_STAGE(PG8_SA(0, 1), cA + hstep, voffA);
        if (wr == 1) PG8_BAR;
        PG8_WAIT_V(2); PG8_BAR;
        PG8_STAGE(PG8_SB(1, 0), cB + kstep, voffB); PG8_STAGE(PG8_SA(1, 0), cA + kstep, voffA); PG8_STAGE(PG8_SB(1, 1), cB + hstep + kstep, voffB);
        PG8_WAIT_V(6); PG8_BAR;
    } else {
        PG8_STAGE(PG8_SB(0, 0), cB, voffB); PG8_STAGE(PG8_SA(0, 0), cA, voffA); PG8_STAGE(PG8_SB(0, 1), cB + hstep, voffB); PG8_STAGE(PG8_SA(0, 1), cA + hstep, voffA);
        if (wr == 1) PG8_BAR;
        PG8_WAIT_V(4); PG8_BAR;
        PG8_STAGE(PG8_SB(1, 0), cB + kstep, voffB); PG8_STAGE(PG8_SA(1, 0), cA + kstep, voffA); PG8_STAGE(PG8_SB(1, 1), cB + hstep + kstep, voffB);
        PG8_WAIT_V(6); PG8_BAR;
    }
    for (;;) {
        const bool has_next = S.next(ui + 1, nxt);
        const char* nA = has_next ? (const char*)g.A + (size_t)nxt.pm * tstep : cA; const char* nB = has_next ? (const char*)g.Bt + (size_t)nxt.pn * tstep : cB;
        for (int t = 0; t < nt; t += 2) {
            const bool last = (t == nt - 2);
            const char* a1 = cA + (size_t)(t + 1) * kstep;
            const char* a2 = last ? nA : cA + (size_t)(t + 2) * kstep; const char* b2 = last ? nB : cB + (size_t)(t + 2) * kstep;
            const char* a3 = a2 + kstep; const char* b3 = b2 + kstep;
            if (last && has_next) S.a_ready(nxt);
            if constexpr (SP2) {
            PG8_LDB(B0, 0, 0); PG8_LDB(B1, 0, 1); PG8_SCHED; PG8_LDA(At, 0, 0); PG8_STAGE(PG8_SA(1, 1), a1 + hstep, voffA);
            PG8_WAIT_V(8); PG8_WAIT_L(0); PG8_BAR; PG8_MMA(0, 0, At, B0); PG8_MMA(0, 1, At, B1); PG8_BAR; PG8_SCHED;
            PG8_LDA(At, 0, 1); PG8_STAGE(PG8_SB(0, 0), b2, voffB); PG8_STAGE(PG8_SB(0, 1), b2 + hstep, voffB); PG8_STAGE(PG8_SA(0, 0), a2, voffA);
            PG8_WAIT_V(8); PG8_WAIT_L(0); PG8_BAR; PG8_MMA(1, 0, At, B0); PG8_MMA(1, 1, At, B1); PG8_BAR; PG8_SCHED;
            PG8_LDB(B0, 1, 0); PG8_LDB(B1, 1, 1); PG8_SCHED; PG8_LDA(At, 1, 0); PG8_STAGE(PG8_SA(0, 1), a2 + hstep, voffA);
            PG8_WAIT_V(8); PG8_WAIT_L(0); PG8_BAR; PG8_MMA(0, 0, At, B0); PG8_MMA(0, 1, At, B1); PG8_BAR; PG8_SCHED;
            PG8_LDA(At, 1, 1); PG8_STAGE(PG8_SB(1, 0), b3, voffB); PG8_STAGE(PG8_SB(1, 1), b3 + hstep, voffB); PG8_STAGE(PG8_SA(1, 0), a3, voffA);
            PG8_WAIT_V(8); PG8_WAIT_L(0); PG8_BAR; PG8_MMA(1, 0, At, B0); PG8_MMA(1, 1, At, B1); PG8_BAR; PG8_SCHED;
            } else {
            PG8_LDB(B0, 0, 0); PG8_SCHED; PG8_LDA(At, 0, 0); PG8_STAGE(PG8_SA(1, 1), a1 + hstep, voffA);
            PG8_WAIT_L(8); PG8_BAR; PG8_WAIT_L(0); PG8_MMA(0, 0, At, B0); PG8_BAR; PG8_SCHED;
            PG8_LDB(B1, 0, 1); PG8_STAGE(PG8_SB(0, 0), b2, voffB);
            PG8_BAR; PG8_WAIT_L(0); PG8_MMA(0, 1, At, B1); PG8_BAR;
            PG8_LDA(At, 0, 1); PG8_STAGE(PG8_SA(0, 0), a2, voffA);
            PG8_BAR; PG8_WAIT_L(0); PG8_MMA(1, 0, At, B0); PG8_BAR; PG8_SCHED;
            PG8_STAGE(PG8_SB(0, 1), b2 + hstep, voffB);
            PG8_WAIT_V(6); PG8_BAR; PG8_MMA(1, 1, At, B1); PG8_BAR;
            PG8_LDB(B0, 1, 0); PG8_SCHED; PG8_LDA(At, 1, 0); PG8_STAGE(PG8_SA(0, 1), a2 + hstep, voffA);
            PG8_WAIT_L(8); PG8_BAR; PG8_WAIT_L(0); PG8_MMA(0, 0, At, B0); PG8_BAR; PG8_SCHED;
            PG8_LDB(B1, 1, 1); PG8_STAGE(PG8_SB(1, 0), b3, voffB);
            PG8_BAR; PG8_WAIT_L(0); PG8_MMA(0, 1, At, B1); PG8_BAR;
            PG8_LDA(At, 1, 1); PG8_STAGE(PG8_SA(1, 0), a3, voffA);
            PG8_BAR; PG8_WAIT_L(0); PG8_MMA(1, 0, At, B0); PG8_BAR; PG8_SCHED;
            PG8_STAGE(PG8_SB(1, 1), b3 + hstep, voffB);
            PG8_WAIT_V(6); PG8_BAR; PG8_MMA(1, 1, At, B1); PG8_BAR;
            }
        }
        if constexpr (ALIGN_EPI) { if (wr == 0) PG8_BAR; }
        E(acc, cur, wr, wc, fr, fq); S.done(cur);
        if (!has_next) break;
#pragma unroll
        for (int a = 0; a < 2; ++a)
#pragma unroll
            for (int b = 0; b < 2; ++b)
#pragma unroll
                for (int m = 0; m < 4; ++m)
#pragma unroll
                    for (int n = 0; n < 2; ++n) acc[a][b][m][n] = (f32x4){0.f, 0.f, 0.f, 0.f};
        cur = nxt; cA = nA; cB = nB; ++ui;
        if constexpr (ALIGN_EPI) { if (wr == 1) PG8_BAR; }
    }
    PG8_WAIT_V(0);
    if constexpr (!ALIGN_EPI) { if (wr == 0) PG8_BAR; }
    PG8_BAR;
#undef PG8_SA
#undef PG8_SB
#undef PG8_STAGE
#undef PG8_LDA
#undef PG8_LDB
#undef PG8_MMA
#undef PG8_WAIT_V
#undef PG8_WAIT_L
#undef PG8_BAR
#undef PG8_SCHED
}
}

constexpr int NWAVES = 8, NTHR = 512;
constexpr int M = 24576, MP = 16384, DM = 2048, NIN = 3584, DFF = 5632;
constexpr int COL_K = 1024, COL_V = 1280, COL_U = 1536, COL_GV = 2560;
constexpr int NGC = 192;
constexpr float LN_EPS = 1e-5f;
constexpr float ALPHA = 1.189207115002721f;
constexpr float LOG2E = 1.4426950408889634f;

constexpr size_t MiB = 1u << 20;
constexpr size_t WS_WSB = 0, WS_GST = 512 * 1024, WS_BAR = 768 * 1024;
constexpr size_t WS_WIN = 1 * MiB, WS_WO = 15 * MiB, WS_W13 = 23 * MiB, WS_W2 = 67 * MiB, WS_ST1 = 89 * MiB;
constexpr size_t WS_XB = 90 * MiB;
constexpr size_t WS_H = 186 * MiB;
constexpr size_t WS_MIX = 354 * MiB;
constexpr size_t WS_HID = 186 * MiB;
constexpr size_t WS_END = 450 * MiB;
static_assert(WS_H + (size_t)M * NIN * 2 == WS_MIX && WS_MIX + (size_t)M * DM * 2 == WS_END && WS_HID + (size_t)M * DFF * 2 == WS_END, "ws map");

constexpr int LDS_BYTES = 131072 + 4096;

#define GAS __attribute__((address_space(1)))
#define LAS __attribute__((address_space(3)))
typedef unsigned short bf16;
typedef unsigned v4u __attribute__((ext_vector_type(4)));
typedef unsigned v2u __attribute__((ext_vector_type(2)));
typedef float f32x4 __attribute__((ext_vector_type(4)));
typedef float f32x2 __attribute__((ext_vector_type(2)));
typedef short bf16x8 __attribute__((ext_vector_type(8)));
using pg8::cvt_pk_bf16;
#define LDS_WAIT() asm volatile("s_waitcnt lgkmcnt(0)" ::: "memory")
__device__ __forceinline__ float bf_lo(unsigned w) { return __uint_as_float(w << 16); }
__device__ __forceinline__ float bf_hi(unsigned w) { return __uint_as_float(w & 0xffff0000u); }
__device__ __forceinline__ float wave_sum(float v) {
#pragma unroll
    for (int o = 1; o < 64; o <<= 1) v += __shfl_xor(v, o);
    return v;
}
__device__ __forceinline__ float gelu_tanh(float x) {
    const float t = x * (-2.3022082f + (-0.10294324f) * x * x);
    return x * __builtin_amdgcn_rcpf(1.0f + __builtin_amdgcn_exp2f(t));
}
__device__ __forceinline__ float silu_f(float x) { return x * __builtin_amdgcn_rcpf(1.0f + __builtin_amdgcn_exp2f(-LOG2E * x)); }
__device__ __forceinline__ f32x2 gelu_tanh2(f32x2 x) {
    const f32x2 t = x * ((x * x) * (-0.10294324f) + (-2.3022082f));
    f32x2 e; e.x = __builtin_amdgcn_exp2f(t.x); e.y = __builtin_amdgcn_exp2f(t.y);
    const f32x2 d = e + 1.0f; f32x2 r; r.x = __builtin_amdgcn_rcpf(d.x); r.y = __builtin_amdgcn_rcpf(d.y);
    return x * r;
}
__device__ __forceinline__ f32x2 silu_mul2(f32x2 g, f32x2 u) {
    const f32x2 t = g * (-LOG2E);
    f32x2 e; e.x = __builtin_amdgcn_exp2f(t.x); e.y = __builtin_amdgcn_exp2f(t.y);
    const f32x2 d = e + 1.0f; f32x2 r; r.x = __builtin_amdgcn_rcpf(d.x); r.y = __builtin_amdgcn_rcpf(d.y);
    return (g * r) * u;
}

struct EpiH {
    static constexpr bool PERM = true;
    bf16* O; float* gst;
    __device__ __forceinline__ void operator()(const f32x4 (&acc)[2][2][4][2], const pg8::Unit& u, int wr, int wc, int fr, int fq) const {
        const int row0 = u.pm * 256 + wr * 64 + fr, col0 = u.pn * 256 + wc * 32 + 8 * fq;
        const bool act = u.pn >= 6, stat = u.pn >= 10;
#pragma unroll
        for (int ai = 0; ai < 2; ++ai)
#pragma unroll
            for (int m = 0; m < 4; ++m) { bf16* rowp = O + (size_t)(row0 + ai * 128 + m * 16) * NIN + col0;
                float rs = 0.f, rq = 0.f;
#pragma unroll
                for (int bj = 0; bj < 2; ++bj) { f32x4 v0 = acc[ai][bj][m][0], v1 = acc[ai][bj][m][1];
                    if (act) { const f32x2 a = gelu_tanh2((f32x2){v0[0], v0[1]}), b = gelu_tanh2((f32x2){v0[2], v0[3]}), c = gelu_tanh2((f32x2){v1[0], v1[1]}), d = gelu_tanh2((f32x2){v1[2], v1[3]});
                        v0 = (f32x4){a.x, a.y, b.x, b.y}; v1 = (f32x4){c.x, c.y, d.x, d.y}; }
                    v4u w; w.x = cvt_pk_bf16(v0[0], v0[1]); w.y = cvt_pk_bf16(v0[2], v0[3]); w.z = cvt_pk_bf16(v1[0], v1[1]); w.w = cvt_pk_bf16(v1[2], v1[3]);
                    *(v4u*)(rowp + bj * 128) = w;
                    if (stat) {
#pragma unroll
                        for (int t = 0; t < 4; ++t) { const float a = bf_lo(w[t]), b = bf_hi(w[t]); rs += a + b; rq += a * a + b * b; } } }
                if (stat) { rs += __shfl_xor(rs, 16); rs += __shfl_xor(rs, 32); rq += __shfl_xor(rq, 16); rq += __shfl_xor(rq, 32);
                    if (fq == 0) { float* gp = gst + 2 * (size_t)(row0 + ai * 128 + m * 16); __hip_atomic_fetch_add(gp, rs, __ATOMIC_RELAXED, __HIP_MEMORY_SCOPE_AGENT); __hip_atomic_fetch_add(gp + 1, rq, __ATOMIC_RELAXED, __HIP_MEMORY_SCOPE_AGENT); } } }
    }
};
struct EpiY1 {
    static constexpr bool PERM = true;
    const float* xp; const float* xs; bf16* Y;
    __device__ __forceinline__ void operator()(const f32x4 (&acc)[2][2][4][2], const pg8::Unit& u, int wr, int wc, int fr, int fq) const {
        const int row0 = u.pm * 256 + wr * 64 + fr, col0 = u.pn * 256 + wc * 32 + 8 * fq;
        const float* xb = (u.pm < MP / 256) ? xp : xs - (size_t)MP * DM;
#pragma unroll
        for (int ai = 0; ai < 2; ++ai)
#pragma unroll
            for (int m = 0; m < 4; ++m) { const size_t off = (size_t)(row0 + ai * 128 + m * 16) * DM + col0;
#pragma unroll
                for (int bj = 0; bj < 2; ++bj) { const f32x4 x0 = __builtin_nontemporal_load((const f32x4*)(xb + off + bj * 128)), x1 = __builtin_nontemporal_load((const f32x4*)(xb + off + bj * 128 + 4));
                    const f32x4 y0 = x0 * ALPHA + acc[ai][bj][m][0], y1 = x1 * ALPHA + acc[ai][bj][m][1];
                    v4u w; w.x = cvt_pk_bf16(y0[0], y0[1]); w.y = cvt_pk_bf16(y0[2], y0[3]); w.z = cvt_pk_bf16(y1[0], y1[1]); w.w = cvt_pk_bf16(y1[2], y1[3]);
                    *(v4u*)(Y + off + bj * 128) = w; } }
    }
};
struct EpiHid {
    static constexpr bool PERM = true;
    bf16* O;
    __device__ __forceinline__ void operator()(const f32x4 (&acc)[2][2][4][2], const pg8::Unit& u, int wr, int wc, int fr, int fq) const {
        const int row0 = u.pm * 256 + wr * 64 + fr, col0 = u.pn * 128 + wc * 32 + 8 * fq;
#pragma unroll
        for (int ai = 0; ai < 2; ++ai)
#pragma unroll
            for (int m = 0; m < 4; ++m) {
                const f32x4 g0 = acc[ai][0][m][0], g1 = acc[ai][0][m][1], u0 = acc[ai][1][m][0], u1 = acc[ai][1][m][1];
                const f32x2 ha = silu_mul2((f32x2){g0[0], g0[1]}, (f32x2){u0[0], u0[1]}), hb = silu_mul2((f32x2){g0[2], g0[3]}, (f32x2){u0[2], u0[3]});
                const f32x2 hc = silu_mul2((f32x2){g1[0], g1[1]}, (f32x2){u1[0], u1[1]}), hd = silu_mul2((f32x2){g1[2], g1[3]}, (f32x2){u1[2], u1[3]});
                v4u w; w.x = cvt_pk_bf16(ha.x, ha.y); w.y = cvt_pk_bf16(hb.x, hb.y); w.z = cvt_pk_bf16(hc.x, hc.y); w.w = cvt_pk_bf16(hd.x, hd.y);
                *(v4u*)(O + (size_t)(row0 + ai * 128 + m * 16) * DFF + col0) = w; }
    }
};
struct EpiY2 {
    static constexpr bool PERM = true;
    const bf16* Y1; bf16* Y2; const float* st1; const float* g1; const float* b1;
    __device__ __forceinline__ void operator()(const f32x4 (&acc)[2][2][4][2], const pg8::Unit& u, int wr, int wc, int fr, int fq) const {
        const int row0 = u.pm * 256 + wr * 64 + fr, col0 = u.pn * 256 + wc * 32 + 8 * fq;
        f32x4 gv[2][2], bv[2][2];
#pragma unroll
        for (int bj = 0; bj < 2; ++bj)
#pragma unroll
            for (int n = 0; n < 2; ++n) { gv[bj][n] = *(const f32x4*)(g1 + col0 + bj * 128 + n * 4) * ALPHA; bv[bj][n] = *(const f32x4*)(b1 + col0 + bj * 128 + n * 4) * ALPHA; }
#pragma unroll
        for (int ai = 0; ai < 2; ++ai)
#pragma unroll
            for (int m = 0; m < 4; ++m) { const int r = row0 + ai * 128 + m * 16; const size_t off = (size_t)r * DM + col0;
                const f32x2 st = *(const f32x2*)(st1 + 2 * r);
#pragma unroll
                for (int bj = 0; bj < 2; ++bj) { const v4u yw = __builtin_nontemporal_load((const v4u*)(Y1 + off + bj * 128));
                    const f32x4 ya = (f32x4){bf_lo(yw.x), bf_hi(yw.x), bf_lo(yw.y), bf_hi(yw.y)}, yb = (f32x4){bf_lo(yw.z), bf_hi(yw.z), bf_lo(yw.w), bf_hi(yw.w)};
                    const f32x4 o0 = ((ya - st.x) * st.y) * gv[bj][0] + bv[bj][0] + acc[ai][bj][m][0], o1 = ((yb - st.x) * st.y) * gv[bj][1] + bv[bj][1] + acc[ai][bj][m][1];
                    v4u w; w.x = cvt_pk_bf16(o0[0], o0[1]); w.y = cvt_pk_bf16(o0[2], o0[3]); w.z = cvt_pk_bf16(o1[0], o1[1]); w.w = cvt_pk_bf16(o1[2], o1[3]);
                    *(v4u*)(Y2 + off + bj * 128) = w; } }
    }
};

__device__ __forceinline__ void p0_transpose_item(const float* W, int K, int N, bf16* WT, int drow0, int k0, int n0, LAS float* scr, int lane) {
    float v[32];
    const float* wp = W + (size_t)(k0 + (lane >> 5)) * N + n0 + (lane & 31);
#pragma unroll
    for (int i = 0; i < 32; ++i) v[i] = __builtin_nontemporal_load(wp + (size_t)(2 * i) * N);
#pragma unroll
    for (int i = 0; i < 32; ++i) scr[(2 * i + (lane >> 5)) * 33 + (lane & 31)] = v[i];
    LDS_WAIT(); asm volatile("" ::: "memory");
    const int c = lane & 7;
#pragma unroll
    for (int j = 0; j < 4; ++j) { const int n = (lane >> 3) + 8 * j; const LAS float* s = scr + (8 * c) * 33 + n;
        v4u o; o.x = cvt_pk_bf16(s[0 * 33], s[1 * 33]); o.y = cvt_pk_bf16(s[2 * 33], s[3 * 33]); o.z = cvt_pk_bf16(s[4 * 33], s[5 * 33]); o.w = cvt_pk_bf16(s[6 * 33], s[7 * 33]);
        *(v4u*)(WT + (size_t)(drow0 + n) * K + k0 + 8 * c) = o; }
    LDS_WAIT(); asm volatile("" ::: "memory");
}

struct Args { const float* in[16]; float* out; unsigned char* ws; };

template <bool FINAL>
__device__ __forceinline__ void ln_rows(const bf16* src, float* dstf, bf16* dstb, float* stats, const float* g, const float* b, int gw, int NGW, int lane) {
    f32x4 gg[8], bb[8];
#pragma unroll
    for (int j = 0; j < 4; ++j) { gg[2 * j] = ((const f32x4*)g)[2 * (lane + 64 * j)]; gg[2 * j + 1] = ((const f32x4*)g)[2 * (lane + 64 * j) + 1];
        bb[2 * j] = ((const f32x4*)b)[2 * (lane + 64 * j)]; bb[2 * j + 1] = ((const f32x4*)b)[2 * (lane + 64 * j) + 1]; }
    for (int m = gw; m < M; m += NGW) {
        const v4u* xr = (const v4u*)(src + (size_t)m * DM) + lane;
        v4u raw[4];
#pragma unroll
        for (int j = 0; j < 4; ++j) raw[j] = __builtin_nontemporal_load(&xr[64 * j]);
        f32x4 v[8]; float s = 0.f;
#pragma unroll
        for (int j = 0; j < 4; ++j) { v[2 * j] = (f32x4){bf_lo(raw[j].x), bf_hi(raw[j].x), bf_lo(raw[j].y), bf_hi(raw[j].y)}; v[2 * j + 1] = (f32x4){bf_lo(raw[j].z), bf_hi(raw[j].z), bf_lo(raw[j].w), bf_hi(raw[j].w)}; }
#pragma unroll
        for (int j = 0; j < 8; ++j) s += (v[j].x + v[j].y) + (v[j].z + v[j].w);
        const float mean = wave_sum(s) * (1.f / DM); float s2 = 0.f;
#pragma unroll
        for (int j = 0; j < 8; ++j) { v[j] = v[j] - mean; s2 += (v[j].x * v[j].x + v[j].y * v[j].y) + (v[j].z * v[j].z + v[j].w * v[j].w); }
        const float rstd = 1.f / sqrtf(wave_sum(s2) * (1.f / DM) + LN_EPS);
        if (FINAL) {
            f32x4* o = (f32x4*)(dstf + (size_t)m * DM) + 2 * lane;
#pragma unroll
            for (int j = 0; j < 4; ++j) { __builtin_nontemporal_store((v[2 * j] * rstd) * gg[2 * j] + bb[2 * j], &o[128 * j]); __builtin_nontemporal_store((v[2 * j + 1] * rstd) * gg[2 * j + 1] + bb[2 * j + 1], &o[128 * j + 1]); }
        } else {
            v4u* o = (v4u*)(dstb + (size_t)m * DM) + lane;
#pragma unroll
            for (int j = 0; j < 4; ++j) { const f32x4 y0 = (v[2 * j] * rstd) * gg[2 * j] + bb[2 * j], y1 = (v[2 * j + 1] * rstd) * gg[2 * j + 1] + bb[2 * j + 1];
                v4u w; w.x = cvt_pk_bf16(y0.x, y0.y); w.y = cvt_pk_bf16(y0.z, y0.w); w.z = cvt_pk_bf16(y1.x, y1.y); w.w = cvt_pk_bf16(y1.z, y1.w); o[64 * j] = w; }
            if (lane == 0) { stats[2 * m] = mean; stats[2 * m + 1] = rstd; }
        }
    }
}

constexpr int VT_PITCH = 784;
__device__ __forceinline__ void attn_head_scores(const LAS unsigned char* kbase, const bf16x8 (&qf)[4], int swz, int p0, float rel0f, float nslope2, float sink2, float pen0, float pen2, v4u (&pf)[9], float& inv) {
    f32x4 S[18];
#pragma unroll
    for (int j = 0; j < 18; ++j) {
        S[j] = (f32x4){0.f, 0.f, 0.f, 0.f};
#pragma unroll
        for (int ks = 0; ks < 4; ++ks) { const bf16x8 kf = *(const LAS bf16x8*)(kbase + (j >> 1) * 8192 + (j & 1) * 1024 + (((4 * ks) ^ swz) << 4));
            S[j] = __builtin_amdgcn_mfma_f32_16x16x32_bf16(kf, qf[ks], S[j], 0, 0, 0); }
        if (j & 1) __builtin_amdgcn_sched_barrier(0);
    }
    const float sc2 = 0.08838834764831845f * LOG2E;
    float mx = sink2;
    asm volatile("" : "+v"(rel0f));
#pragma unroll
    for (int t = 0; t < 9; ++t) { const int p = p0 + t; const float pen = p < 4 ? pen0 : (p >= 8 ? pen2 : 0.f);
#pragma unroll
        for (int e = 0; e < 2; ++e)
#pragma unroll
            for (int i = 0; i < 4; ++i) { const float relf = rel0f + (float)(32 * t + 4 * e + i);
                float sv = __builtin_fmaf(S[2 * t + e][i], sc2, __builtin_fmaf(__builtin_fabsf(relf), nslope2, pen));
                if (t == 0 || t == 8) sv = (__builtin_fabsf(relf) > 128.f) ? -1e30f : sv;
                S[2 * t + e][i] = sv; mx = fmaxf(mx, sv); } }
    mx = fmaxf(mx, __shfl_xor(mx, 16)); mx = fmaxf(mx, __shfl_xor(mx, 32));
    float sum = 0.f;
#pragma unroll
    for (int j = 0; j < 18; ++j)
#pragma unroll
        for (int i = 0; i < 4; ++i) { const float p = __builtin_amdgcn_exp2f(S[j][i] - mx); S[j][i] = p; sum += p; }
    sum += __shfl_xor(sum, 16); sum += __shfl_xor(sum, 32);
    inv = 1.0f / (sum + __builtin_amdgcn_exp2f(sink2 - mx));
#pragma unroll
    for (int t = 0; t < 9; ++t) { pf[t].x = cvt_pk_bf16(S[2 * t][0], S[2 * t][1]); pf[t].y = cvt_pk_bf16(S[2 * t][2], S[2 * t][3]);
        pf[t].z = cvt_pk_bf16(S[2 * t + 1][0], S[2 * t + 1][1]); pf[t].w = cvt_pk_bf16(S[2 * t + 1][2], S[2 * t + 1][3]); }
}
__device__ __forceinline__ void attn_head_pv(const LAS unsigned char* vbase, const v4u (&pf)[9], float inv, bf16* Og) {
#pragma unroll
    for (int dt = 0; dt < 8; ++dt) {
        f32x4 o = (f32x4){0.f, 0.f, 0.f, 0.f};
#pragma unroll
        for (int t = 0; t < 9; ++t) { const bf16x8 vf = *(const LAS bf16x8*)(vbase + 16 * dt * VT_PITCH + 64 * t);
            o = __builtin_amdgcn_mfma_f32_16x16x32_bf16(vf, __builtin_bit_cast(bf16x8, pf[t]), o, 0, 0, 0); }
        v2u w; w.x = cvt_pk_bf16(o[0] * inv, o[1] * inv); w.y = cvt_pk_bf16(o[2] * inv, o[3] * inv);
        *(v2u*)(Og + 16 * dt) = w;
        __builtin_amdgcn_sched_barrier(0);
    }
}
__device__ __forceinline__ void vt_write(LAS unsigned char* lds, const v4u (&in)[8], int dblk, int key0) {
#pragma unroll
    for (int i = 0; i < 8; ++i) { v4u o;
#pragma unroll
        for (int t = 0; t < 4; ++t) { const unsigned a = in[2 * t][i >> 1], b = in[2 * t + 1][i >> 1];
            o[t] = (i & 1) ? ((a >> 16) | (b & 0xffff0000u)) : ((a & 0xffffu) | (b << 16)); }
        *(LAS v4u*)(lds + (8 * dblk + i) * VT_PITCH + key0 * 2) = o; }
}
__device__ __forceinline__ void attn_unit(LAS unsigned char* lds, const bf16* H, bf16* MIX, const float* sink, int gc, int kv, int hp) {
    int tid_ = threadIdx.x; asm volatile("" : "+v"(tid_));
    const int tid = tid_, lane = tid & 63, wave = __builtin_amdgcn_readfirstlane(tid >> 6);
    const int c = gc & 15, fr = lane & 15, fq = lane >> 4, hA = 4 * kv + 2 * hp, hB = hA + 1;
    const int rowq0 = gc * 128, roww0 = rowq0 - 128;
    const bool v0 = (c != 0), v2 = (c != 15);
    const int p0 = wave >> 1;
    __syncthreads();
    {
        const bf16* Kg = H + COL_K + 128 * kv;
#pragma unroll
        for (int it = 0; it < 12; ++it) { const int ch = tid + it * NTHR, row = ch >> 4, cc = ch & 15, kb = row >> 7;
            const int grow = roww0 + row + ((kb == 0 && !v0) ? 128 : 0) - ((kb == 2 && !v2) ? 128 : 0);
            const v4u v = *(const v4u*)(Kg + (size_t)grow * NIN + cc * 8);
            const int g = (((row >> 3) & 3) << 2) | (row & 3);
            *(LAS v4u*)(lds + row * 256 + ((cc ^ g) << 4)) = v; }
    }
    bf16x8 qfA[4], qfB[4];
    { const bf16* Qg = H + (size_t)(rowq0 + 16 * wave + fr) * NIN + 128 * hA + 8 * fq;
#pragma unroll
      for (int ks = 0; ks < 4; ++ks) { qfA[ks] = *(const bf16x8*)(Qg + 32 * ks); qfB[ks] = *(const bf16x8*)(Qg + 128 + 32 * ks); } }
    const int r = tid & 255, sblk = r >> 4, dblk = r & 15;
    v4u vin0[8], vin1[8];
    { const bf16* Vg = H + COL_V + 128 * kv + 8 * dblk;
      const int kb = tid >> 8, key0 = 128 * kb + 8 * sblk, grow = roww0 + key0 + ((kb == 0 && !v0) ? 128 : 0);
#pragma unroll
      for (int jj = 0; jj < 8; ++jj) vin0[jj] = *(const v4u*)(Vg + (size_t)(grow + jj) * NIN);
      if (wave < 4) { const int grow2 = roww0 + 256 + 8 * sblk - (v2 ? 0 : 128);
#pragma unroll
          for (int jj = 0; jj < 8; ++jj) vin1[jj] = *(const v4u*)(Vg + (size_t)(grow2 + jj) * NIN); } }
    __syncthreads();
    const int qi = 16 * wave + fr;
    float rel0f = (float)(32 * p0 + 8 * fq - 128 - qi);
    asm volatile("" : "+v"(rel0f));
    const float pen0 = v0 ? 0.f : -1e30f, pen2 = v2 ? 0.f : -1e30f;
    const LAS unsigned char* kbase = lds + (32 * p0 + 8 * (fr >> 2) + (fr & 3)) * 256;
    const int swz = fq ^ fr;
    v4u pfA[9], pfB[9]; float invA, invB;
    attn_head_scores(kbase, qfA, swz, p0, rel0f, -__builtin_amdgcn_exp2f(-(float)(hA + 1)) * LOG2E, sink[hA] * LOG2E, pen0, pen2, pfA, invA);
    attn_head_scores(kbase, qfB, swz, p0, rel0f, -__builtin_amdgcn_exp2f(-(float)(hB + 1)) * LOG2E, sink[hB] * LOG2E, pen0, pen2, pfB, invB);
    __syncthreads();
    vt_write(lds, vin0, dblk, 128 * (tid >> 8) + 8 * sblk);
    if (wave < 4) vt_write(lds, vin1, dblk, 256 + 8 * sblk);
    __syncthreads();
    const LAS unsigned char* vbase = lds + fr * VT_PITCH + 64 * p0 + 16 * fq;
    bf16* Og = MIX + (size_t)(rowq0 + 16 * wave + fr) * DM + 128 * hA + 4 * fq;
    attn_head_pv(vbase, pfA, invA, Og);
    attn_head_pv(vbase, pfB, invB, Og + 128);
}

constexpr int GT_PITCH = 272, GT_BYTES = 128 * GT_PITCH;
__device__ __forceinline__ void sgu_pair(LAS unsigned char* lds, const bf16* H, bf16* MIX, const float* lng, const float* lnb, const bf16* wsb, const float* b_s, const float* gst, int gc, int gp) {
    int tid_ = threadIdx.x; asm volatile("" : "+v"(tid_));
    const int tid = tid_, lane = tid & 63, wave = __builtin_amdgcn_readfirstlane(tid >> 6);
    const int r0 = gc * 128, fr = lane & 15, fq = lane >> 4;
    __syncthreads();
    { const int gsel = tid >> 8, r = tid & 255, sblk = r >> 4, dblk = r & 15, g = 2 * gp + gsel, ch0 = 128 * g + 8 * dblk;
      const f32x4 ga = *(const f32x4*)(lng + ch0), gb = *(const f32x4*)(lng + ch0 + 4), ba = *(const f32x4*)(lnb + ch0), bb = *(const f32x4*)(lnb + ch0 + 4);
      const float gam[8] = {ga.x, ga.y, ga.z, ga.w, gb.x, gb.y, gb.z, gb.w}, bet[8] = {ba.x, ba.y, ba.z, ba.w, bb.x, bb.y, bb.z, bb.w};
      v4u in[8]; f32x2 st[8];
#pragma unroll
      for (int jj = 0; jj < 8; ++jj) { in[jj] = *(const v4u*)(H + (size_t)(r0 + 8 * sblk + jj) * NIN + COL_GV + ch0); st[jj] = *(const f32x2*)(gst + 2 * (size_t)(r0 + 8 * sblk + jj)); }
#pragma unroll
      for (int jj = 0; jj < 8; ++jj) { const float mean = st[jj].x * (1.f / 1024.f), var = fmaxf(st[jj].y * (1.f / 1024.f) - mean * mean, 0.f); st[jj].x = mean; st[jj].y = 1.f / sqrtf(var + LN_EPS); }
#pragma unroll
      for (int i = 0; i < 8; ++i) { v4u o;
#pragma unroll
          for (int t = 0; t < 4; ++t) { const unsigned a = in[2 * t][i >> 1], b = in[2 * t + 1][i >> 1];
              const float xa = (i & 1) ? bf_hi(a) : bf_lo(a), xb = (i & 1) ? bf_hi(b) : bf_lo(b);
              o[t] = cvt_pk_bf16((xa - st[2 * t].x) * st[2 * t].y * gam[i] + bet[i], (xb - st[2 * t + 1].x) * st[2 * t + 1].y * gam[i] + bet[i]); }
          *(LAS v4u*)(lds + gsel * GT_BYTES + (8 * dblk + i) * GT_PITCH + 16 * sblk) = o; } }
    const int gsel = wave >> 2, tq = wave & 3, g = 2 * gp + gsel;
    bf16x8 wf[2][4];
#pragma unroll
    for (int tt = 0; tt < 2; ++tt)
#pragma unroll
        for (int ks = 0; ks < 4; ++ks) wf[tt][ks] = *(const bf16x8*)(wsb + (size_t)(g * 128 + 32 * tq + 16 * tt + fr) * 128 + 32 * ks + 8 * fq);
    __syncthreads();
    const LAS unsigned char* Gb = lds + gsel * GT_BYTES + fr * GT_PITCH + 16 * fq;
    const float bias0 = b_s[g * 128 + 32 * tq + fr], bias1 = b_s[g * 128 + 32 * tq + 16 + fr];
#pragma unroll
    for (int dt = 0; dt < 8; ++dt) {
        f32x4 a0 = (f32x4){0.f, 0.f, 0.f, 0.f}, a1 = a0;
#pragma unroll
        for (int ks = 0; ks < 4; ++ks) { const bf16x8 gf = *(const LAS bf16x8*)(Gb + 16 * dt * GT_PITCH + 64 * ks);
            a0 = __builtin_amdgcn_mfma_f32_16x16x32_bf16(gf, wf[0][ks], a0, 0, 0, 0);
            a1 = __builtin_amdgcn_mfma_f32_16x16x32_bf16(gf, wf[1][ks], a1, 0, 0, 0); }
#pragma unroll
        for (int tt = 0; tt < 2; ++tt) { const int t = 32 * tq + 16 * tt + fr; const float bias = tt ? bias1 : bias0; const f32x4 a = tt ? a1 : a0;
            const v2u uu = *(const v2u*)(H + (size_t)(r0 + t) * NIN + COL_U + 128 * g + 16 * dt + 4 * fq);
            v2u w; w.x = cvt_pk_bf16(bf_lo(uu.x) * (a[0] + bias), bf_hi(uu.x) * (a[1] + bias)); w.y = cvt_pk_bf16(bf_lo(uu.y) * (a[2] + bias), bf_hi(uu.y) * (a[3] + bias));
            *(v2u*)(MIX + (size_t)(r0 + t) * DM + 1024 + 128 * g + 16 * dt + 4 * fq) = w; }
    }
}

#define XB_TMO      128
#define XB_XCNT(j)  (256  + 64 * (j))
#define XB_XSUB(j)  (1280 + 64 * (j))
#define XB_XGEN(j)  (2304 + 64 * (j))
#define XB_TOP      3328
#define XB_TOPGEN   3392
#define XCD_BAR_WORDS 3456
#define XB_SPIN_CAP (1u << 18)
__device__ __forceinline__ unsigned xb_ld(unsigned* p)              { return __hip_atomic_load(p, __ATOMIC_RELAXED, __HIP_MEMORY_SCOPE_AGENT); }
__device__ __forceinline__ unsigned xb_add(unsigned* p, unsigned v) { return __hip_atomic_fetch_add(p, v, __ATOMIC_RELAXED, __HIP_MEMORY_SCOPE_AGENT); }
__device__ __forceinline__ unsigned xb_xcc_id() { return (unsigned)__builtin_amdgcn_s_getreg((3 << 11) | 20) & 0xFu; }
#define XB_SPIN(cond, bar) do { unsigned _sp = 0; while (cond) { __builtin_amdgcn_s_sleep(1); \
    if ((++_sp & 255u) == 0u) { if (xb_ld(&(bar)[XB_TMO])) break; if (_sp > XB_SPIN_CAP) { atomicAdd(&(bar)[XB_TMO], 1u); break; } } } } while (0)
struct XcdBarrier { unsigned* bar; unsigned x; volatile LAS unsigned* st; };
__device__ __forceinline__ XcdBarrier xcd_barrier_post(unsigned* bar, volatile LAS unsigned* st) {
    XcdBarrier b; b.bar = bar; b.x = xb_xcc_id(); b.st = st;
    if (threadIdx.x == 0) (void)xb_add(&bar[XB_XCNT(b.x)], 1u);
    return b;
}
__device__ __forceinline__ void xcd_barrier_complete(unsigned* bar, unsigned x, unsigned& nloc, unsigned& nx) {
    const unsigned G = gridDim.x * gridDim.y * gridDim.z;
    unsigned sum, cnt, mine, sp = 0u;
    for (;;) {
        sum = 0u; cnt = 0u; mine = 0u;
#pragma unroll
        for (unsigned j = 0; j < 16; ++j) { const unsigned c = xb_ld(&bar[XB_XCNT(j)]); sum += c; cnt += (c > 0u) ? 1u : 0u; mine = (j == x) ? c : mine; }
        if (sum == G) break;
        __builtin_amdgcn_s_sleep(1);
        if ((++sp & 255u) == 0u) { if (xb_ld(&bar[XB_TMO])) break; if (sp > XB_SPIN_CAP) { atomicAdd(&bar[XB_TMO], 1u); break; } }
    }
    nloc = mine > 0u ? mine : 1u; nx = cnt > 0u ? cnt : 1u;
}
__device__ __forceinline__ void xcd_barrier(const XcdBarrier& b) {
    asm volatile("s_waitcnt vmcnt(0)" ::: "memory");
    __syncthreads();
    if (threadIdx.x == 0) {
        unsigned* bar = b.bar;
        __builtin_amdgcn_s_waitcnt(0);
        unsigned nloc = b.st[0], nx = b.st[1];
        if (nloc == 0u) { xcd_barrier_complete(bar, b.x, nloc, nx); b.st[0] = nloc; b.st[1] = nx; }
        const unsigned old = xb_add(&bar[XB_XSUB(b.x)], 1u);
        const unsigned gen = old / nloc;
        if (old + 1u == (gen + 1u) * nloc) {
            __builtin_amdgcn_fence(__ATOMIC_RELEASE, "agent");
            asm volatile("s_waitcnt vmcnt(0)" ::: "memory");
            const unsigned og = xb_add(&bar[XB_TOP], 1u);
            const unsigned tg = og / nx;
            if (og + 1u == (tg + 1u) * nx) xb_add(&bar[XB_TOPGEN], 1u);
            else XB_SPIN(xb_ld(&bar[XB_TOPGEN]) == tg, bar);
            __builtin_amdgcn_fence(__ATOMIC_ACQUIRE, "agent");
            xb_add(&bar[XB_XGEN(b.x)], 1u);
            asm volatile("s_waitcnt vmcnt(0)" ::: "memory");
        } else {
            XB_SPIN(xb_ld(&bar[XB_XGEN(b.x)]) == gen, bar);
            __builtin_amdgcn_fence(__ATOMIC_ACQUIRE, "agent");
            asm volatile("s_waitcnt vmcnt(0)" ::: "memory");
        }
    }
    __syncthreads();
}

#ifndef PH_MASK
#define PH_MASK 0xff
#endif
#ifndef DUP_MASK
#define DUP_MASK 0
#endif
#define GSYNC() xcd_barrier(xbar)
#define REP(k) for (int rep_ = 0; rep_ < (((DUP_MASK >> (k)) & 1) ? 2 : 1); ++rep_, (rep_ < (((DUP_MASK >> (k)) & 1) ? 2 : 1) ? GSYNC() : (void)0))
__global__ void __launch_bounds__(NTHR, 2) fwd_megakernel(Args args) {
    extern __shared__ __attribute__((aligned(16))) unsigned char lds_raw[];
    LAS unsigned char* lds = (LAS unsigned char*)lds_raw;
    const int tid = threadIdx.x, lane = tid & 63, wave = __builtin_amdgcn_readfirstlane(tid >> 6);
    const int G = gridDim.x, bx = blockIdx.x;
    const int vcu = (G % 8 == 0) ? (bx % 8) * (G / 8) + bx / 8 : bx;
    unsigned char* ws = args.ws;
    const float* xp = args.in[0]; const float* xs = args.in[1];
    const float* w_in = args.in[2]; const float* ln_sgu_g = args.in[3]; const float* ln_sgu_b = args.in[4]; const float* w_s = args.in[5]; const float* b_s = args.in[6];
    const float* sink = args.in[7]; const float* w_o = args.in[8]; const float* ln1_g = args.in[9]; const float* ln1_b = args.in[10];
    const float* w_gate = args.in[11]; const float* w_up = args.in[12]; const float* w_down = args.in[13]; const float* ln2_g = args.in[14]; const float* ln2_b = args.in[15];
    float* out = args.out;
    bf16* WIN_T = (bf16*)(ws + WS_WIN); bf16* WO_T = (bf16*)(ws + WS_WO); bf16* W13_T = (bf16*)(ws + WS_W13); bf16* W2_T = (bf16*)(ws + WS_W2);
    bf16* Y1B = (bf16*)out;
    bf16* Y2B = (bf16*)(ws + WS_XB);
    float* ST1 = (float*)(ws + WS_ST1); float* GST = (float*)(ws + WS_GST); bf16* WSB = (bf16*)(ws + WS_WSB);
    bf16* XB = (bf16*)(ws + WS_XB); bf16* Hb = (bf16*)(ws + WS_H); bf16* MIX = (bf16*)(ws + WS_MIX); bf16* HID = (bf16*)(ws + WS_HID);
    const int gw = vcu * NWAVES + wave, NGW = G * NWAVES;
    if (tid < 2) ((volatile LAS unsigned*)(lds + 131072 + 2048))[tid] = 0u;
    __syncthreads();
    const XcdBarrier xbar = xcd_barrier_post((unsigned*)(ws + WS_BAR), (volatile LAS unsigned*)(lds + 131072 + 2048));

    if constexpr ((PH_MASK & 1) != 0) {
        LAS float* scr = (LAS float*)(lds + wave * 16384);
        constexpr int I_IN = (DM / 64) * (NIN / 32);
        for (int it = gw; it < I_IN; it += NGW) { const int nb = it % (NIN / 32), kb = it / (NIN / 32); p0_transpose_item(w_in, DM, NIN, WIN_T, 32 * nb, 64 * kb, 32 * nb, scr, lane); }
        { const int gt = bx * NTHR + tid;
          if (gt < M * 2 / 4) ((f32x4*)GST)[gt] = (f32x4){0.f, 0.f, 0.f, 0.f};
          if (gt < 8 * 128 * 128 / 8) { const f32x4 a = *(const f32x4*)(w_s + 8 * gt), b = *(const f32x4*)(w_s + 8 * gt + 4);
              v4u w; w.x = cvt_pk_bf16(a.x, a.y); w.y = cvt_pk_bf16(a.z, a.w); w.z = cvt_pk_bf16(b.x, b.y); w.w = cvt_pk_bf16(b.z, b.w); *(v4u*)(WSB + 8 * gt) = w; } }
        const size_t n8 = (size_t)M * DM / 8, nthr = (size_t)G * NTHR;
        for (size_t i = (size_t)bx * NTHR + tid; i < n8; i += nthr) { const size_t e = i * 8;
            const float* src = (e < (size_t)MP * DM) ? xp + e : xs + (e - (size_t)MP * DM);
            const f32x4 a = __builtin_nontemporal_load((const f32x4*)src), b = __builtin_nontemporal_load((const f32x4*)(src + 4));
            v4u w; w.x = cvt_pk_bf16(a.x, a.y); w.y = cvt_pk_bf16(a.z, a.w); w.z = cvt_pk_bf16(b.x, b.y); w.w = cvt_pk_bf16(b.z, b.w);
            *(v4u*)(XB + e) = w; }
    }
    GSYNC();
    REP(1) if constexpr ((PH_MASK & 2) != 0) { pg8::Gemm g{XB, WIN_T, M, NIN, DM}; pg8::StaticOrder S; S.init(M, NIN, G, bx); EpiH E{Hb, GST};
      pg8::gemm_phase<EpiH, pg8::StaticOrder, true, true>(lds, g, S, E);
      const int nfull = (M / 256) * (NIN / 256) / G, nrem = (M / 256) * (NIN / 256) - nfull * G;
      if (bx >= nrem) {
          LAS float* scr = (LAS float*)(lds + wave * 16384);
          constexpr int I_O = (DM / 64) * (DM / 32), I_G = (DM / 64) * (DFF / 32), I_D = (DFF / 64) * (DM / 32);
          const int cw = (bx - nrem) * NWAVES + wave, NCW = (G - nrem) * NWAVES;
          for (int it = cw; it < I_O + 2 * I_G + I_D; it += NCW) {
              int r = it;
              if (r < I_O) { const int nb = r % (DM / 32), kb = r / (DM / 32); p0_transpose_item(w_o, DM, DM, WO_T, 32 * nb, 64 * kb, 32 * nb, scr, lane); continue; } r -= I_O;
              if (r < 2 * I_G) { const int up = r >= I_G ? 1 : 0; if (up) r -= I_G; const int nb = r % (DFF / 32), kb = r / (DFF / 32), n0 = 32 * nb;
                  p0_transpose_item(up ? w_up : w_gate, DM, DFF, W13_T, (n0 >> 7) * 256 + up * 128 + (n0 & 127), 64 * kb, n0, scr, lane); continue; } r -= 2 * I_G;
              { const int nb = r % (DM / 32), kb = r / (DM / 32); p0_transpose_item(w_down, DFF, DM, W2_T, 32 * nb, 64 * kb, 32 * nb, scr, lane); }
          }
      } }
    GSYNC();
    REP(2) if constexpr ((PH_MASK & 4) != 0) {
      for (int it = vcu; it < NGC * 8; it += G) {
#ifndef NO_ATTN
        if (it < NGC * 4) { attn_unit(lds, Hb, MIX, sink, it >> 2, (it >> 1) & 1, it & 1); if (DUP_MASK & 64) attn_unit(lds, Hb, MIX, sink, it >> 2, (it >> 1) & 1, it & 1); }
#endif
#ifndef NO_SGU
        if (it >= NGC * 4) { const int a = it - NGC * 4; sgu_pair(lds, Hb, MIX, ln_sgu_g, ln_sgu_b, WSB, b_s, GST, a >> 2, a & 3); if (DUP_MASK & 128) sgu_pair(lds, Hb, MIX, ln_sgu_g, ln_sgu_b, WSB, b_s, GST, a >> 2, a & 3); }
#endif
    } }
    GSYNC();
    REP(3) if constexpr ((PH_MASK & 8) != 0) { pg8::Gemm g{MIX, WO_T, M, DM, DM}; pg8::StaticOrder S; S.init(M, DM, G, bx); EpiY1 E{xp, xs, Y1B};
      pg8::gemm_phase<EpiY1, pg8::StaticOrder, true, true>(lds, g, S, E); }
    GSYNC();
    REP(4) if constexpr ((PH_MASK & 16) != 0) ln_rows<false>(Y1B, nullptr, XB, ST1, ln1_g, ln1_b, gw, NGW, lane);
    GSYNC();
    REP(5) if constexpr ((PH_MASK & 32) != 0) { pg8::Gemm g{XB, W13_T, M, 2 * DFF, DM}; pg8::StaticOrder S; S.init(M, 2 * DFF, G, bx); EpiHid E{HID};
      pg8::gemm_phase<EpiHid, pg8::StaticOrder, true, true>(lds, g, S, E); }
    GSYNC();
    if constexpr ((PH_MASK & 64) != 0) { pg8::Gemm g{HID, W2_T, M, DM, DFF}; pg8::StaticOrder S; S.init(M, DM, G, bx); EpiY2 E{Y1B, Y2B, ST1, ln1_g, ln1_b};
      pg8::gemm_phase<EpiY2, pg8::StaticOrder, true, true>(lds, g, S, E); }
    GSYNC();
#ifdef SYNC_PROBE
    for (int i = 0; i < 16; ++i) GSYNC();
#endif
    if constexpr ((PH_MASK & 128) != 0) ln_rows<true>(Y2B, out, nullptr, nullptr, ln2_g, ln2_b, gw, NGW, lane);
}

extern "C" void kernel_launch(void* const* d_in, const int* in_sizes, int n_in, void* d_out, int out_size, void* d_ws, size_t ws_size, hipStream_t stream) {
    static int grid = 0;
    if (grid == 0) {
        if (n_in != 16 || out_size != M * DM || ws_size < WS_END) { fprintf(stderr, "kernel_launch: unexpected shapes (n_in %d, out %d, ws %zu)\n", n_in, out_size, ws_size); grid = -1; return; }
        int dev = 0, cus = 0, per_cu = 0;
        hipGetDevice(&dev);
        hipDeviceGetAttribute(&cus, hipDeviceAttributeMultiprocessorCount, dev);
        if (hipFuncSetAttribute((const void*)fwd_megakernel, hipFuncAttributeMaxDynamicSharedMemorySize, LDS_BYTES) != hipSuccess) { fprintf(stderr, "kernel_launch: hipFuncSetAttribute failed\n"); grid = -1; return; }
        if (hipOccupancyMaxActiveBlocksPerMultiprocessor(&per_cu, (const void*)fwd_megakernel, NTHR, LDS_BYTES) != hipSuccess || per_cu < 1) { fprintf(stderr, "kernel_launch: occupancy query says %d workgroups per CU; nothing launched\n", per_cu); grid = -1; return; }
        grid = cus;
        fprintf(stderr, "kernel_launch: grid %d (cus %d, per_cu %d)\n", grid, cus, per_cu);
    }
    if (grid < 0) return;
    if (hipMemsetAsync((unsigned char*)d_ws + WS_BAR, 0, XCD_BAR_WORDS * 4, stream) != hipSuccess) { fprintf(stderr, "kernel_launch: hipMemsetAsync failed\n"); return; }
    Args a{};
    for (int i = 0; i < 16; ++i) a.in[i] = (const float*)d_in[i];
    a.out = (float*)d_out; a.ws = (unsigned char*)d_ws;
    void* kargs[] = {&a};
    hipError_t e = hipLaunchCooperativeKernel((const void*)fwd_megakernel, dim3(grid), dim3(NTHR), kargs, LDS_BYTES, stream);
    if (e != hipSuccess) fprintf(stderr, "kernel_launch: cooperative launch failed: %s (grid %d)\n", hipGetErrorString(e), grid);
}
```

```cpp
#include <hip/hip_runtime.h>
#include <hip/hip_cooperative_groups.h>
#include <cstdio>
#include <cstdint>
namespace cg = cooperative_groups;

namespace pg8 {
#define PG8_LAS __attribute__((address_space(3)))
typedef unsigned short bf16_t;
typedef short bf16x8 __attribute__((ext_vector_type(8)));
typedef float f32x4 __attribute__((ext_vector_type(4)));
typedef unsigned u32x4 __attribute__((ext_vector_type(4)));
constexpr int BM = 256, BK = 64, HALF = 128, HTB = HALF * BK * 2  , STAGE_BYTES = 8 * HTB, NXCD = 8, WGM = 8;

__host__ __device__ __forceinline__ int lds_byte(int r, int c) { const int st = (r >> 4) * 2 + (c >> 5), rr = r & 15, cc = c & 31, ob = rr * 64 + cc * 2; return st * 1024 + (ob ^ (((ob >> 9) & 1) << 5)); }
__host__ __device__ __forceinline__ void stage_rc(int b, int& R, int& C) { const int st = b / 1024, sb = b % 1024, swz = sb ^ (((sb >> 9) & 1) << 5); R = (st >> 1) * 16 + swz / 64; C = (st & 1) * 32 + (swz % 64) / 2; }
__host__ __device__ __forceinline__ int perm32(int rho) { const int n = rho >> 4, i = rho & 15; return 8 * (i >> 2) + 4 * n + (i & 3); }

struct Unit { int pm, pn; };
struct Gemm { const bf16_t* A; const bf16_t* Bt; int M, N, K; };

struct StaticOrder {
    int nM, nN, nwg, G, c;
    __host__ __device__ void init(int M, int N, int G_, int c_) { nM = M / BM; nN = N / BM; nwg = nM * nN; G = G_; c = c_; }
    __host__ __device__ bool next(int i, Unit& u) const {
        const long L = (long)i * G + c; if (L >= nwg) return false;
        int wgid = (int)L; { const int q = nwg / NXCD, r = nwg % NXCD, xcd = wgid % NXCD, off = wgid / NXCD; wgid = (xcd < r ? xcd * (q + 1) : r * (q + 1) + (xcd - r) * q) + off; }
        const int nig = WGM * nN, gid = wgid / nig, fm = gid * WGM, gsz = (nM - fm) < WGM ? (nM - fm) : WGM;
        u.pm = fm + ((wgid % nig) % gsz); u.pn = (wgid % nig) / gsz; return true;
    }
    __device__ __forceinline__ void a_ready(const Unit&) const {}
    __device__ __forceinline__ void done(const Unit&) const {}
};

__device__ __forceinline__ unsigned cvt_pk_bf16(float lo, float hi) { unsigned r; asm("v_cvt_pk_bf16_f32 %0, %1, %2" : "=v"(r) : "v"(lo), "v"(hi)); return r; }

template <class Epi, class Sched, bool ALIGN_EPI = false, bool SP2 = false>
__device__ __forceinline__ void gemm_phase(PG8_LAS unsigned char* lds, const Gemm g, const Sched& S, const Epi& E) {
    int tid_ = threadIdx.x; asm volatile("" : "+v"(tid_));
    const int tid = tid_, wid = __builtin_amdgcn_readfirstlane(tid >> 6), lane = tid & 63, wr = wid >> 2, wc = wid & 3, fr = lane & 15, fq = lane >> 4;
    const int K = g.K, nt = K / BK;
    unsigned voffA[2], voffB[2];
#pragma unroll
    for (int i = 0; i < 2; ++i) { int R, C; stage_rc(tid * 16 + i * 8192, R, C); const int Rb = Epi::PERM ? ((R & ~31) + perm32(R & 31)) : R;
        voffA[i] = (unsigned)(R * K + C) * 2u; voffB[i] = (unsigned)(Rb * K + C) * 2u; }
    const size_t kstep = (size_t)(BK * 2);
    const size_t hstep = (size_t)HALF * K * 2;
    const size_t tstep = 2 * hstep;
    const unsigned ldsw = (unsigned)wid * 1024u;
    const int aoff = lds_byte(wr * 64 + fr, fq * 8), boff = lds_byte(wc * 32 + fr, fq * 8);
#define PG8_SA(b, h) (((b) * 2 + (h)) * HTB)
#define PG8_SB(b, h) ((4 + (b) * 2 + (h)) * HTB)
#define PG8_STAGE(bufoff, gbase, voff) do { _Pragma("unroll") for (int _i = 0; _i < 2; ++_i) \
        __builtin_amdgcn_global_load_lds((const unsigned*)((const char*)(gbase) + (voff)[_i]), (PG8_LAS unsigned*)(lds + (bufoff) + ldsw + _i * 8192), 16, 0, 0); } while (0)
#define PG8_LDA(dst, b, h) do { _Pragma("unroll") for (int m = 0; m < 4; ++m) _Pragma("unroll") for (int k = 0; k < 2; ++k) dst[m][k] = *(const PG8_LAS bf16x8*)(lds + PG8_SA(b, h) + aoff + m * 2048 + k * 1024); } while (0)
#define PG8_LDB(dst, b, h) do { _Pragma("unroll") for (int n = 0; n < 2; ++n) _Pragma("unroll") for (int k = 0; k < 2; ++k) dst[n][k] = *(const PG8_LAS bf16x8*)(lds + PG8_SB(b, h) + boff + n * 2048 + k * 1024); } while (0)
#define PG8_MMA(ai, bj, At, Bt) do { __builtin_amdgcn_s_setprio(1); _Pragma("unroll") for (int m = 0; m < 4; ++m) _Pragma("unroll") for (int n = 0; n < 2; ++n) _Pragma("unroll") for (int k = 0; k < 2; ++k) \
        acc[ai][bj][m][n] = __builtin_amdgcn_mfma_f32_16x16x32_bf16(Bt[n][k], At[m][k], acc[ai][bj][m][n], 0, 0, 0); __builtin_amdgcn_s_setprio(0); } while (0)
#define PG8_WAIT_V(n) asm volatile("s_waitcnt vmcnt(" #n ")" ::: "memory")
#define PG8_WAIT_L(n) asm volatile("s_waitcnt lgkmcnt(" #n ")" ::: "memory")
#define PG8_BAR __builtin_amdgcn_s_barrier()
#define PG8_SCHED __builtin_amdgcn_sched_barrier(0)
    Unit cur, nxt; int ui = 0;
    if (!S.next(0, cur)) return;
    f32x4 acc[2][2][4][2];
#pragma unroll
    for (int a = 0; a < 2; ++a)
#pragma unroll
        for (int b = 0; b < 2; ++b)
#pragma unroll
            for (int m = 0; m < 4; ++m)
#pragma unroll
                for (int n = 0; n < 2; ++n) acc[a][b][m][n] = (f32x4){0.f, 0.f, 0.f, 0.f};
    bf16x8 At[4][2], B0[2][2], B1[2][2];
    const char* cA = (const char*)g.A + (size_t)cur.pm * tstep; const char* cB = (const char*)g.Bt + (size_t)cur.pn * tstep;
    S.a_ready(cur);
    if constexpr (SP2) {
        PG8_STAGE(PG8_SB(0, 0), cB, voffB); PG8_STAGE(PG8_SB(0, 1), cB + hstep, voffB); PG8_STAGE(PG8_SA(0, 0), cA, voffA); PG8_STAGE(PG8_SA(0, 1), cA + hstep, voffA);
        if (wr == 1) PG8_BAR;
        PG8_WAIT_V(2); PG8_BAR;
        PG8_STAGE(PG8_SB(1, 0), cB + kstep, voffB); PG8_STAGE(PG8_SA(1, 0), cA + kstep, voffA); PG8_STAGE(PG8_SB(1, 1), cB + hstep + kstep, voffB);
        PG8_WAIT_V(6); PG8_BAR;
    } else {
        PG8_STAGE(PG8_SB(0, 0), cB, voffB); PG8_STAGE(PG8_SA(0, 0), cA, voffA); PG8_STAGE(PG8_SB(0, 1), cB + hstep, voffB); PG8_STAGE(PG8_SA(0, 1), cA + hstep, voffA);
        if (wr == 1) PG8_BAR;
        PG8_WAIT_V(4); PG8_BAR;
        PG8_STAGE(PG8_SB(1, 0), cB + kstep, voffB); PG8_STAGE(PG8_SA(1, 0), cA + kstep, voffA); PG8_STAGE(PG8_SB(1, 1), cB + hstep + kstep, voffB);
        PG8_WAIT_V(6); PG8_BAR;
    }
    for (;;) {
        const bool has_next = S.next(ui + 1, nxt);
        const char* nA = has_next ? (const char*)g.A + (size_t)nxt.pm * tstep : cA; const char* nB = has_next ? (const char*)g.Bt + (size_t)nxt.pn * tstep : cB;
        for (int t = 0; t < nt; t += 2) {
            const bool last = (t == nt - 2);
            const char* a1 = cA + (size_t)(t + 1) * kstep;
            const char* a2 = last ? nA : cA + (size_t)(t + 2) * kstep; const char* b2 = last ? nB : cB + (size_t)(t + 2) * kstep;
            const char* a3 = a2 + kstep; const char* b3 = b2 + kstep;
            if (last && has_next) S.a_ready(nxt);
            if constexpr (SP2) {
            PG8_LDB(B0, 0, 0); PG8_LDB(B1, 0, 1); PG8_SCHED; PG8_LDA(At, 0, 0); PG8_STAGE(PG8_SA(1, 1), a1 + hstep, voffA);
            PG8_WAIT_V(8); PG8_WAIT_L(0); PG8_BAR; PG8_MMA(0, 0, At, B0); PG8_MMA(0, 1, At, B1); PG8_BAR; PG8_SCHED;
            PG8_LDA(At, 0, 1); PG8_STAGE(PG8_SB(0, 0), b2, voffB); PG8_STAGE(PG8_SB(0, 1), b2 + hstep, voffB); PG8_STAGE(PG8_SA(0, 0), a2, voffA);
            PG8_WAIT_V(8); PG8_WAIT_L(0); PG8_BAR; PG8_MMA(1, 0, At, B0); PG8_MMA(1, 1, At, B1); PG8_BAR; PG8_SCHED;
            PG8_LDB(B0, 1, 0); PG8_LDB(B1, 1, 1); PG8_SCHED; PG8_LDA(At, 1, 0); PG8_STAGE(PG8_SA(0, 1), a2 + hstep, voffA);
            PG8_WAIT_V(8); PG8_WAIT_L(0); PG8_BAR; PG8_MMA(0, 0, At, B0); PG8_MMA(0, 1, At, B1); PG8_BAR; PG8_SCHED;
            PG8_LDA(At, 1, 1); PG8_STAGE(PG8_SB(1, 0), b3, voffB); PG8_STAGE(PG8_SB(1, 1), b3 + hstep, voffB); PG8_STAGE(PG8_SA(1, 0), a3, voffA);
            PG8_WAIT_V(8); PG8_WAIT_L(0); PG8_BAR; PG8_MMA(1, 0, At, B0); PG8_MMA(1, 1, At, B1); PG8_BAR; PG8_SCHED;
            } else {
            PG8_LDB(B0, 0, 0); PG8_SCHED; PG8_LDA(At, 0, 0); PG8_STAGE(PG8_SA(1, 1), a1 + hstep, voffA);
            PG8_WAIT_L(8); PG8_BAR; PG8_WAIT_L(0); PG8_MMA(0, 0, At, B0); PG8_BAR; PG8_SCHED;
            PG8_LDB(B1, 0, 1); PG8_STAGE(PG8_SB(0, 0), b2, voffB);
            PG8_BAR; PG8_WAIT_L(0); PG8_MMA(0, 1, At, B1); PG8_BAR;
            PG8_LDA(At, 0, 1); PG8_STAGE(PG8_SA(0, 0), a2, voffA);
            PG8_BAR; PG8_WAIT_L(0); PG8_MMA(1, 0, At, B0); PG8_BAR; PG8_SCHED;
            PG8_STAGE(PG8_SB(0, 1), b2 + hstep, voffB);
            PG8_WAIT_V(6); PG8_BAR; PG8_MMA(1, 1, At, B1); PG8_BAR;
            PG8_LDB(B0, 1, 0); PG8_SCHED; PG8_LDA(At, 1, 0); PG8_STAGE(PG8_SA(0, 1), a2 + hstep, voffA);
            PG8_WAIT_L(8); PG8_BAR; PG8_WAIT_L(0); PG8_MMA(0, 0, At, B0); PG8_BAR; PG8_SCHED;
            PG8_LDB(B1, 1, 1); PG8_STAGE(PG8_SB(1, 0), b3, voffB);
            PG8_BAR; PG8_WAIT_L(0); PG8_MMA(0, 1, At, B1); PG8_BAR;
            PG8_LDA(At, 1, 1); PG8_STAGE(PG8_SA(1, 0), a3, voffA);
            PG8_BAR; PG8_WAIT_L(0); PG8_MMA(1, 0, At, B0); PG8_BAR; PG8_SCHED;
            PG8_STAGE(PG8_SB(1, 1), b3 + hstep, voffB);
            PG8_WAIT_V(6); PG8_BAR; PG8_MMA(1, 1, At, B1); PG8_BAR;
            }
        }
        if constexpr (ALIGN_EPI) { if (wr == 0) PG8_BAR; }
        E(acc, cur, wr, wc, fr, fq); S.done(cur);
        if (!has_next) break;
#pragma unroll
        for (int a = 0; a < 2; ++a)
#pragma unroll
            for (int b = 0; b < 2; ++b)
#pragma unroll
                for (int m = 0; m < 4; ++m)
#pragma unroll
                    for (int n = 0; n < 2; ++n) acc[a][b][m][n] = (f32x4){0.f, 0.f, 0.f, 0.f};
        cur = nxt; cA = nA; cB = nB; ++ui;
        if constexpr (ALIGN_EPI) { if (wr == 1) PG8_BAR; }
    }
    PG8_WAIT_V(0);
    if constexpr (!ALIGN_EPI) { if (wr == 0) PG8_BAR; }
    PG8_BAR;
#undef PG8_SA
#undef PG8_SB
#undef PG8_STAGE
#undef PG8_LDA
#undef PG8_LDB
#undef PG8_MMA
#undef PG8_WAIT_V
#undef PG8_WAIT_L
#undef PG8_BAR
#undef PG8_SCHED
}
}

constexpr int NWAVES = 8, NTHR = 512;
constexpr int M = 24576, MP = 16384, DM = 2048, NIN = 3584, DFF = 5632;
constexpr int COL_K = 1024, COL_V = 1280, COL_U = 1536, COL_GV = 2560;
constexpr int NGC = 192;
constexpr float LN_EPS = 1e-5f;
constexpr float ALPHA = 1.189207115002721f;
constexpr float LOG2E = 1.4426950408889634f;

constexpr size_t MiB = 1u << 20;
constexpr size_t WS_WSB = 0, WS_GST = 512 * 1024, WS_BAR = 768 * 1024;
constexpr size_t WS_WIN = 1 * MiB, WS_WO = 15 * MiB, WS_W13 = 23 * MiB, WS_W2 = 67 * MiB, WS_ST1 = 89 * MiB;
constexpr size_t WS_XB = 90 * MiB;
constexpr size_t WS_H = 186 * MiB;
constexpr size_t WS_MIX = 354 * MiB;
constexpr size_t WS_HID = 186 * MiB;
constexpr size_t WS_END = 450 * MiB;
static_assert(WS_H + (size_t)M * NIN * 2 == WS_MIX && WS_MIX + (size_t)M * DM * 2 == WS_END && WS_HID + (size_t)M * DFF * 2 == WS_END, "ws map");

constexpr int LDS_BYTES = 131072 + 4096;

#define GAS __attribute__((address_space(1)))
#define LAS __attribute__((address_space(3)))
typedef unsigned short bf16;
typedef unsigned v4u __attribute__((ext_vector_type(4)));
typedef unsigned v2u __attribute__((ext_vector_type(2)));
typedef float f32x4 __attribute__((ext_vector_type(4)));
typedef float f32x2 __attribute__((ext_vector_type(2)));
typedef short bf16x8 __attribute__((ext_vector_type(8)));
using pg8::cvt_pk_bf16;
#define LDS_WAIT() asm volatile("s_waitcnt lgkmcnt(0)" ::: "memory")
__device__ __forceinline__ float bf_lo(unsigned w) { return __uint_as_float(w << 16); }
__device__ __forceinline__ float bf_hi(unsigned w) { return __uint_as_float(w & 0xffff0000u); }
__device__ __forceinline__ float wave_sum(float v) {
#pragma unroll
    for (int o = 1; o < 64; o <<= 1) v += __shfl_xor(v, o);
    return v;
}
__device__ __forceinline__ float gelu_tanh(float x) {
    const float t = x * (-2.3022082f + (-0.10294324f) * x * x);
    return x * __builtin_amdgcn_rcpf(1.0f + __builtin_amdgcn_exp2f(t));
}
__device__ __forceinline__ float silu_f(float x) { return x * __builtin_amdgcn_rcpf(1.0f + __builtin_amdgcn_exp2f(-LOG2E * x)); }
__device__ __forceinline__ f32x2 gelu_tanh2(f32x2 x) {
    const f32x2 t = x * ((x * x) * (-0.10294324f) + (-2.3022082f));
    f32x2 e; e.x = __builtin_amdgcn_exp2f(t.x); e.y = __builtin_amdgcn_exp2f(t.y);
    const f32x2 d = e + 1.0f; f32x2 r; r.x = __builtin_amdgcn_rcpf(d.x); r.y = __builtin_amdgcn_rcpf(d.y);
    return x * r;
}
__device__ __forceinline__ f32x2 silu_mul2(f32x2 g, f32x2 u) {
    const f32x2 t = g * (-LOG2E);
    f32x2 e; e.x = __builtin_amdgcn_exp2f(t.x); e.y = __builtin_amdgcn_exp2f(t.y);
    const f32x2 d = e + 1.0f; f32x2 r; r.x = __builtin_amdgcn_rcpf(d.x); r.y = __builtin_amdgcn_rcpf(d.y);
    return (g * r) * u;
}

struct EpiH {
    static constexpr bool PERM = true;
    bf16* O; float* gst;
    __device__ __forceinline__ void operator()(const f32x4 (&acc)[2][2][4][2], const pg8::Unit& u, int wr, int wc, int fr, int fq) const {
        const int row0 = u.pm * 256 + wr * 64 + fr, col0 = u.pn * 256 + wc * 32 + 8 * fq;
        const bool act = u.pn >= 6, stat = u.pn >= 10;
#pragma unroll
        for (int ai = 0; ai < 2; ++ai)
#pragma unroll
            for (int m = 0; m < 4; ++m) { bf16* rowp = O + (size_t)(row0 + ai * 128 + m * 16) * NIN + col0;
                float rs = 0.f, rq = 0.f;
#pragma unroll
                for (int bj = 0; bj < 2; ++bj) { f32x4 v0 = acc[ai][bj][m][0], v1 = acc[ai][bj][m][1];
                    if (act) { const f32x2 a = gelu_tanh2((f32x2){v0[0], v0[1]}), b = gelu_tanh2((f32x2){v0[2], v0[3]}), c = gelu_tanh2((f32x2){v1[0], v1[1]}), d = gelu_tanh2((f32x2){v1[2], v1[3]});
                        v0 = (f32x4){a.x, a.y, b.x, b.y}; v1 = (f32x4){c.x, c.y, d.x, d.y}; }
                    v4u w; w.x = cvt_pk_bf16(v0[0], v0[1]); w.y = cvt_pk_bf16(v0[2], v0[3]); w.z = cvt_pk_bf16(v1[0], v1[1]); w.w = cvt_pk_bf16(v1[2], v1[3]);
                    *(v4u*)(rowp + bj * 128) = w;
                    if (stat) {
#pragma unroll
                        for (int t = 0; t < 4; ++t) { const float a = bf_lo(w[t]), b = bf_hi(w[t]); rs += a + b; rq += a * a + b * b; } } }
                if (stat) { rs += __shfl_xor(rs, 16); rs += __shfl_xor(rs, 32); rq += __shfl_xor(rq, 16); rq += __shfl_xor(rq, 32);
                    if (fq == 0) { float* gp = gst + 2 * (size_t)(row0 + ai * 128 + m * 16); __hip_atomic_fetch_add(gp, rs, __ATOMIC_RELAXED, __HIP_MEMORY_SCOPE_AGENT); __hip_atomic_fetch_add(gp + 1, rq, __ATOMIC_RELAXED, __HIP_MEMORY_SCOPE_AGENT); } } }
    }
};
struct EpiY1 {
    static constexpr bool PERM = true;
    const bf16* X; bf16* Y;
    __device__ __forceinline__ void operator()(const f32x4 (&acc)[2][2][4][2], const pg8::Unit& u, int wr, int wc, int fr, int fq) const {
        const int row0 = u.pm * 256 + wr * 64 + fr, col0 = u.pn * 256 + wc * 32 + 8 * fq;
#pragma unroll
        for (int ai = 0; ai < 2; ++ai) {
            v4u xv[4][2];
#pragma unroll
            for (int m = 0; m < 4; ++m) { const size_t off = (size_t)(row0 + ai * 128 + m * 16) * DM + col0;
#pragma unroll
                for (int bj = 0; bj < 2; ++bj) xv[m][bj] = __builtin_nontemporal_load((const v4u*)(X + off + bj * 128)); }
            asm volatile("" ::: "memory");
#pragma unroll
            for (int m = 0; m < 4; ++m) { const size_t off = (size_t)(row0 + ai * 128 + m * 16) * DM + col0;
#pragma unroll
                for (int bj = 0; bj < 2; ++bj) { const v4u xw = xv[m][bj];
                    const f32x4 xa = (f32x4){bf_lo(xw.x), bf_hi(xw.x), bf_lo(xw.y), bf_hi(xw.y)}, xb = (f32x4){bf_lo(xw.z), bf_hi(xw.z), bf_lo(xw.w), bf_hi(xw.w)};
                    const f32x4 y0 = xa * ALPHA + acc[ai][bj][m][0], y1 = xb * ALPHA + acc[ai][bj][m][1];
                    v4u w; w.x = cvt_pk_bf16(y0[0], y0[1]); w.y = cvt_pk_bf16(y0[2], y0[3]); w.z = cvt_pk_bf16(y1[0], y1[1]); w.w = cvt_pk_bf16(y1[2], y1[3]);
                    *(v4u*)(Y + off + bj * 128) = w; } }
            asm volatile("" ::: "memory"); }
    }
};
struct EpiHid {
    static constexpr bool PERM = true;
    bf16* O;
    __device__ __forceinline__ void operator()(const f32x4 (&acc)[2][2][4][2], const pg8::Unit& u, int wr, int wc, int fr, int fq) const {
        const int row0 = u.pm * 256 + wr * 64 + fr, col0 = u.pn * 128 + wc * 32 + 8 * fq;
#pragma unroll
        for (int ai = 0; ai < 2; ++ai)
#pragma unroll
            for (int m = 0; m < 4; ++m) {
                const f32x4 g0 = acc[ai][0][m][0], g1 = acc[ai][0][m][1], u0 = acc[ai][1][m][0], u1 = acc[ai][1][m][1];
                const f32x2 ha = silu_mul2((f32x2){g0[0], g0[1]}, (f32x2){u0[0], u0[1]}), hb = silu_mul2((f32x2){g0[2], g0[3]}, (f32x2){u0[2], u0[3]});
                const f32x2 hc = silu_mul2((f32x2){g1[0], g1[1]}, (f32x2){u1[0], u1[1]}), hd = silu_mul2((f32x2){g1[2], g1[3]}, (f32x2){u1[2], u1[3]});
                v4u w; w.x = cvt_pk_bf16(ha.x, ha.y); w.y = cvt_pk_bf16(hb.x, hb.y); w.z = cvt_pk_bf16(hc.x, hc.y); w.w = cvt_pk_bf16(hd.x, hd.y);
                *(v4u*)(O + (size_t)(row0 + ai * 128 + m * 16) * DFF + col0) = w; }
    }
};
struct EpiY2 {
    static constexpr bool PERM = true;
    bf16* X;
    __device__ __forceinline__ void operator()(const f32x4 (&acc)[2][2][4][2], const pg8::Unit& u, int wr, int wc, int fr, int fq) const {
        const int row0 = u.pm * 256 + wr * 64 + fr, col0 = u.pn * 256 + wc * 32 + 8 * fq;
#pragma unroll
        for (int ai = 0; ai < 2; ++ai) {
            v4u xv[4][2];
#pragma unroll
            for (int m = 0; m < 4; ++m) { const size_t off = (size_t)(row0 + ai * 128 + m * 16) * DM + col0;
#pragma unroll
                for (int bj = 0; bj < 2; ++bj) xv[m][bj] = __builtin_nontemporal_load((const v4u*)(X + off + bj * 128)); }
            asm volatile("" ::: "memory");
#pragma unroll
            for (int m = 0; m < 4; ++m) { const size_t off = (size_t)(row0 + ai * 128 + m * 16) * DM + col0;
#pragma unroll
                for (int bj = 0; bj < 2; ++bj) { const v4u xw = xv[m][bj];
                    const f32x4 xa = (f32x4){bf_lo(xw.x), bf_hi(xw.x), bf_lo(xw.y), bf_hi(xw.y)}, xb = (f32x4){bf_lo(xw.z), bf_hi(xw.z), bf_lo(xw.w), bf_hi(xw.w)};
                    const f32x4 o0 = xa * ALPHA + acc[ai][bj][m][0], o1 = xb * ALPHA + acc[ai][bj][m][1];
                    v4u w; w.x = cvt_pk_bf16(o0[0], o0[1]); w.y = cvt_pk_bf16(o0[2], o0[3]); w.z = cvt_pk_bf16(o1[0], o1[1]); w.w = cvt_pk_bf16(o1[2], o1[3]);
                    *(v4u*)(X + off + bj * 128) = w; } }
            asm volatile("" ::: "memory"); }
    }
};

__device__ __forceinline__ void p0_transpose_item(const float* W, int K, int N, bf16* WT, int drow0, int k0, int n0, LAS float* scr, int lane) {
    float v[32];
    const float* wp = W + (size_t)(k0 + (lane >> 5)) * N + n0 + (lane & 31);
#pragma unroll
    for (int i = 0; i < 32; ++i) v[i] = __builtin_nontemporal_load(wp + (size_t)(2 * i) * N);
#pragma unroll
    for (int i = 0; i < 32; ++i) scr[(2 * i + (lane >> 5)) * 33 + (lane & 31)] = v[i];
    LDS_WAIT(); asm volatile("" ::: "memory");
    const int c = lane & 7;
#pragma unroll
    for (int j = 0; j < 4; ++j) { const int n = (lane >> 3) + 8 * j; const LAS float* s = scr + (8 * c) * 33 + n;
        v4u o; o.x = cvt_pk_bf16(s[0 * 33], s[1 * 33]); o.y = cvt_pk_bf16(s[2 * 33], s[3 * 33]); o.z = cvt_pk_bf16(s[4 * 33], s[5 * 33]); o.w = cvt_pk_bf16(s[6 * 33], s[7 * 33]);
        *(v4u*)(WT + (size_t)(drow0 + n) * K + k0 + 8 * c) = o; }
    LDS_WAIT(); asm volatile("" ::: "memory");
}

struct Args { const float* in[16]; float* out; unsigned char* ws; };

template <bool FINAL>
__device__ __forceinline__ void ln_rows(const bf16* src, float* dstf, bf16* dstb, float* stats, const float* g, const float* b, int gw, int NGW, int lane) {
    f32x4 gg[8], bb[8];
#pragma unroll
    for (int j = 0; j < 4; ++j) { gg[2 * j] = ((const f32x4*)g)[2 * (lane + 64 * j)]; gg[2 * j + 1] = ((const f32x4*)g)[2 * (lane + 64 * j) + 1];
        bb[2 * j] = ((const f32x4*)b)[2 * (lane + 64 * j)]; bb[2 * j + 1] = ((const f32x4*)b)[2 * (lane + 64 * j) + 1]; }
    for (int m = gw; m < M; m += NGW) {
        const v4u* xr = (const v4u*)(src + (size_t)m * DM) + lane;
        v4u raw[4];
#pragma unroll
        for (int j = 0; j < 4; ++j) raw[j] = __builtin_nontemporal_load(&xr[64 * j]);
        f32x4 v[8]; float s = 0.f;
#pragma unroll
        for (int j = 0; j < 4; ++j) { v[2 * j] = (f32x4){bf_lo(raw[j].x), bf_hi(raw[j].x), bf_lo(raw[j].y), bf_hi(raw[j].y)}; v[2 * j + 1] = (f32x4){bf_lo(raw[j].z), bf_hi(raw[j].z), bf_lo(raw[j].w), bf_hi(raw[j].w)}; }
#pragma unroll
        for (int j = 0; j < 8; ++j) s += (v[j].x + v[j].y) + (v[j].z + v[j].w);
        const float mean = wave_sum(s) * (1.f / DM); float s2 = 0.f;
#pragma unroll
        for (int j = 0; j < 8; ++j) { v[j] = v[j] - mean; s2 += (v[j].x * v[j].x + v[j].y * v[j].y) + (v[j].z * v[j].z + v[j].w * v[j].w); }
        const float rstd = 1.f / sqrtf(wave_sum(s2) * (1.f / DM) + LN_EPS);
        if (FINAL) {
            f32x4* o = (f32x4*)(dstf + (size_t)m * DM) + 2 * lane;
#pragma unroll
            for (int j = 0; j < 4; ++j) { __builtin_nontemporal_store((v[2 * j] * rstd) * gg[2 * j] + bb[2 * j], &o[128 * j]); __builtin_nontemporal_store((v[2 * j + 1] * rstd) * gg[2 * j + 1] + bb[2 * j + 1], &o[128 * j + 1]); }
        } else {
            v4u* o = (v4u*)(dstb + (size_t)m * DM) + lane;
#pragma unroll
            for (int j = 0; j < 4; ++j) { const f32x4 y0 = (v[2 * j] * rstd) * gg[2 * j] + bb[2 * j], y1 = (v[2 * j + 1] * rstd) * gg[2 * j + 1] + bb[2 * j + 1];
                v4u w; w.x = cvt_pk_bf16(y0.x, y0.y); w.y = cvt_pk_bf16(y0.z, y0.w); w.z = cvt_pk_bf16(y1.x, y1.y); w.w = cvt_pk_bf16(y1.z, y1.w); o[64 * j] = w; }
            if (lane == 0) { stats[2 * m] = mean; stats[2 * m + 1] = rstd; }
        }
    }
}

constexpr int VT_PITCH = 784;
__device__ __forceinline__ void attn_head_scores(const LAS unsigned char* kbase, const bf16x8 (&qf)[4], int swz, int p0, float rel0f, float nslope2, float sink2, float pen0, float pen2, v4u (&pf)[9], float& inv) {
    f32x4 S[18];
#pragma unroll
    for (int j = 0; j < 18; ++j) {
        S[j] = (f32x4){0.f, 0.f, 0.f, 0.f};
#pragma unroll
        for (int ks = 0; ks < 4; ++ks) { const bf16x8 kf = *(const LAS bf16x8*)(kbase + (j >> 1) * 8192 + (j & 1) * 1024 + (((4 * ks) ^ swz) << 4));
            S[j] = __builtin_amdgcn_mfma_f32_16x16x32_bf16(kf, qf[ks], S[j], 0, 0, 0); }
        if (j & 1) __builtin_amdgcn_sched_barrier(0);
    }
    const float sc2 = 0.08838834764831845f * LOG2E;
    float mx = sink2;
    asm volatile("" : "+v"(rel0f));
#pragma unroll
    for (int t = 0; t < 9; ++t) { const int p = p0 + t; const float pen = p < 4 ? pen0 : (p >= 8 ? pen2 : 0.f);
#pragma unroll
        for (int e = 0; e < 2; ++e)
#pragma unroll
            for (int i = 0; i < 4; ++i) { const float relf = rel0f + (float)(32 * t + 4 * e + i);
                float sv = __builtin_fmaf(S[2 * t + e][i], sc2, __builtin_fmaf(__builtin_fabsf(relf), nslope2, pen));
                if (t == 0 || t == 8) sv = (__builtin_fabsf(relf) > 128.f) ? -1e30f : sv;
                S[2 * t + e][i] = sv; mx = fmaxf(mx, sv); } }
    mx = fmaxf(mx, __shfl_xor(mx, 16)); mx = fmaxf(mx, __shfl_xor(mx, 32));
    float sum = 0.f;
#pragma unroll
    for (int j = 0; j < 18; ++j)
#pragma unroll
        for (int i = 0; i < 4; ++i) { const float p = __builtin_amdgcn_exp2f(S[j][i] - mx); S[j][i] = p; sum += p; }
    sum += __shfl_xor(sum, 16); sum += __shfl_xor(sum, 32);
    inv = 1.0f / (sum + __builtin_amdgcn_exp2f(sink2 - mx));
#pragma unroll
    for (int t = 0; t < 9; ++t) { pf[t].x = cvt_pk_bf16(S[2 * t][0], S[2 * t][1]); pf[t].y = cvt_pk_bf16(S[2 * t][2], S[2 * t][3]);
        pf[t].z = cvt_pk_bf16(S[2 * t + 1][0], S[2 * t + 1][1]); pf[t].w = cvt_pk_bf16(S[2 * t + 1][2], S[2 * t + 1][3]); }
}
__device__ __forceinline__ void attn_head_pv(const LAS unsigned char* vbase, const v4u (&pf)[9], float inv, bf16* Og) {
#pragma unroll
    for (int dt = 0; dt < 8; ++dt) {
        f32x4 o = (f32x4){0.f, 0.f, 0.f, 0.f};
#pragma unroll
        for (int t = 0; t < 9; ++t) { const bf16x8 vf = *(const LAS bf16x8*)(vbase + 16 * dt * VT_PITCH + 64 * t);
            o = __builtin_amdgcn_mfma_f32_16x16x32_bf16(vf, __builtin_bit_cast(bf16x8, pf[t]), o, 0, 0, 0); }
        v2u w; w.x = cvt_pk_bf16(o[0] * inv, o[1] * inv); w.y = cvt_pk_bf16(o[2] * inv, o[3] * inv);
        *(v2u*)(Og + 16 * dt) = w;
        __builtin_amdgcn_sched_barrier(0);
    }
}
__device__ __forceinline__ void vt_write(LAS unsigned char* lds, const v4u (&in)[8], int dblk, int key0) {
#pragma unroll
    for (int i = 0; i < 8; ++i) { v4u o;
#pragma unroll
        for (int t = 0; t < 4; ++t) { const unsigned a = in[2 * t][i >> 1], b = in[2 * t + 1][i >> 1];
            o[t] = (i & 1) ? ((a >> 16) | (b & 0xffff0000u)) : ((a & 0xffffu) | (b << 16)); }
        *(LAS v4u*)(lds + (8 * dblk + i) * VT_PITCH + key0 * 2) = o; }
}
__device__ __forceinline__ void attn_unit(LAS unsigned char* lds, const bf16* H, bf16* MIX, const float* sink, int gc, int kv, int hp) {
    int tid_ = threadIdx.x; asm volatile("" : "+v"(tid_));
    const int tid = tid_, lane = tid & 63, wave = __builtin_amdgcn_readfirstlane(tid >> 6);
    const int c = gc & 15, fr = lane & 15, fq = lane >> 4, hA = 4 * kv + 2 * hp, hB = hA + 1;
    const int rowq0 = gc * 128, roww0 = rowq0 - 128;
    const bool v0 = (c != 0), v2 = (c != 15);
    const int p0 = wave >> 1;
    __syncthreads();
    {
        const bf16* Kg = H + COL_K + 128 * kv;
#pragma unroll
        for (int it = 0; it < 12; ++it) { const int ch = tid + it * NTHR, row = ch >> 4, cc = ch & 15, kb = row >> 7;
            const int grow = roww0 + row + ((kb == 0 && !v0) ? 128 : 0) - ((kb == 2 && !v2) ? 128 : 0);
            const v4u v = *(const v4u*)(Kg + (size_t)grow * NIN + cc * 8);
            const int g = (((row >> 3) & 3) << 2) | (row & 3);
            *(LAS v4u*)(lds + row * 256 + ((cc ^ g) << 4)) = v; }
    }
    bf16x8 qfA[4], qfB[4];
    { const bf16* Qg = H + (size_t)(rowq0 + 16 * wave + fr) * NIN + 128 * hA + 8 * fq;
#pragma unroll
      for (int ks = 0; ks < 4; ++ks) { qfA[ks] = *(const bf16x8*)(Qg + 32 * ks); qfB[ks] = *(const bf16x8*)(Qg + 128 + 32 * ks); } }
    const int r = tid & 255, sblk = r >> 4, dblk = r & 15;
    v4u vin0[8], vin1[8];
    { const bf16* Vg = H + COL_V + 128 * kv + 8 * dblk;
      const int kb = tid >> 8, key0 = 128 * kb + 8 * sblk, grow = roww0 + key0 + ((kb == 0 && !v0) ? 128 : 0);
#pragma unroll
      for (int jj = 0; jj < 8; ++jj) vin0[jj] = *(const v4u*)(Vg + (size_t)(grow + jj) * NIN);
      if (wave < 4) { const int grow2 = roww0 + 256 + 8 * sblk - (v2 ? 0 : 128);
#pragma unroll
          for (int jj = 0; jj < 8; ++jj) vin1[jj] = *(const v4u*)(Vg + (size_t)(grow2 + jj) * NIN); } }
    __syncthreads();
    const int qi = 16 * wave + fr;
    float rel0f = (float)(32 * p0 + 8 * fq - 128 - qi);
    asm volatile("" : "+v"(rel0f));
    const float pen0 = v0 ? 0.f : -1e30f, pen2 = v2 ? 0.f : -1e30f;
    const LAS unsigned char* kbase = lds + (32 * p0 + 8 * (fr >> 2) + (fr & 3)) * 256;
    const int swz = fq ^ fr;
    v4u pfA[9], pfB[9]; float invA, invB;
    attn_head_scores(kbase, qfA, swz, p0, rel0f, -__builtin_amdgcn_exp2f(-(float)(hA + 1)) * LOG2E, sink[hA] * LOG2E, pen0, pen2, pfA, invA);
    attn_head_scores(kbase, qfB, swz, p0, rel0f, -__builtin_amdgcn_exp2f(-(float)(hB + 1)) * LOG2E, sink[hB] * LOG2E, pen0, pen2, pfB, invB);
    __syncthreads();
    vt_write(lds, vin0, dblk, 128 * (tid >> 8) + 8 * sblk);
    if (wave < 4) vt_write(lds, vin1, dblk, 256 + 8 * sblk);
    __syncthreads();
    const LAS unsigned char* vbase = lds + fr * VT_PITCH + 64 * p0 + 16 * fq;
    bf16* Og = MIX + (size_t)(rowq0 + 16 * wave + fr) * DM + 128 * hA + 4 * fq;
    attn_head_pv(vbase, pfA, invA, Og);
    attn_head_pv(vbase, pfB, invB, Og + 128);
}

constexpr int GT_PITCH = 272, GT_BYTES = 128 * GT_PITCH;
__device__ __forceinline__ void sgu_pair(LAS unsigned char* lds, const bf16* H, bf16* MIX, const float* lng, const float* lnb, const bf16* wsb, const float* b_s, const float* gst, int gc, int gp) {
    int tid_ = threadIdx.x; asm volatile("" : "+v"(tid_));
    const int tid = tid_, lane = tid & 63, wave = __builtin_amdgcn_readfirstlane(tid >> 6);
    const int r0 = gc * 128, fr = lane & 15, fq = lane >> 4;
    __syncthreads();
    { const int gsel = tid >> 8, r = tid & 255, sblk = r >> 4, dblk = r & 15, g = 2 * gp + gsel, ch0 = 128 * g + 8 * dblk;
      const f32x4 ga = *(const f32x4*)(lng + ch0), gb = *(const f32x4*)(lng + ch0 + 4), ba = *(const f32x4*)(lnb + ch0), bb = *(const f32x4*)(lnb + ch0 + 4);
      const float gam[8] = {ga.x, ga.y, ga.z, ga.w, gb.x, gb.y, gb.z, gb.w}, bet[8] = {ba.x, ba.y, ba.z, ba.w, bb.x, bb.y, bb.z, bb.w};
      v4u in[8]; f32x2 st[8];
#pragma unroll
      for (int jj = 0; jj < 8; ++jj) { in[jj] = *(const v4u*)(H + (size_t)(r0 + 8 * sblk + jj) * NIN + COL_GV + ch0); st[jj] = *(const f32x2*)(gst + 2 * (size_t)(r0 + 8 * sblk + jj)); }
#pragma unroll
      for (int jj = 0; jj < 8; ++jj) { const float mean = st[jj].x * (1.f / 1024.f), var = fmaxf(st[jj].y * (1.f / 1024.f) - mean * mean, 0.f); st[jj].x = mean; st[jj].y = 1.f / sqrtf(var + LN_EPS); }
#pragma unroll
      for (int i = 0; i < 8; ++i) { v4u o;
#pragma unroll
          for (int t = 0; t < 4; ++t) { const unsigned a = in[2 * t][i >> 1], b = in[2 * t + 1][i >> 1];
              const float xa = (i & 1) ? bf_hi(a) : bf_lo(a), xb = (i & 1) ? bf_hi(b) : bf_lo(b);
              o[t] = cvt_pk_bf16((xa - st[2 * t].x) * st[2 * t].y * gam[i] + bet[i], (xb - st[2 * t + 1].x) * st[2 * t + 1].y * gam[i] + bet[i]); }
          *(LAS v4u*)(lds + gsel * GT_BYTES + (8 * dblk + i) * GT_PITCH + 16 * sblk) = o; } }
    const int gsel = wave >> 2, tq = wave & 3, g = 2 * gp + gsel;
    bf16x8 wf[2][4];
#pragma unroll
    for (int tt = 0; tt < 2; ++tt)
#pragma unroll
        for (int ks = 0; ks < 4; ++ks) wf[tt][ks] = *(const bf16x8*)(wsb + (size_t)(g * 128 + 32 * tq + 16 * tt + fr) * 128 + 32 * ks + 8 * fq);
    __syncthreads();
    v2u uv[8][2];
#pragma unroll
    for (int dt = 0; dt < 8; ++dt)
#pragma unroll
        for (int tt = 0; tt < 2; ++tt) uv[dt][tt] = *(const v2u*)(H + (size_t)(r0 + 32 * tq + 16 * tt + fr) * NIN + COL_U + 128 * g + 16 * dt + 4 * fq);
    const LAS unsigned char* Gb = lds + gsel * GT_BYTES + fr * GT_PITCH + 16 * fq;
    const float bias0 = b_s[g * 128 + 32 * tq + fr], bias1 = b_s[g * 128 + 32 * tq + 16 + fr];
#pragma unroll
    for (int dt = 0; dt < 8; ++dt) {
        f32x4 a0 = (f32x4){0.f, 0.f, 0.f, 0.f}, a1 = a0;
#pragma unroll
        for (int ks = 0; ks < 4; ++ks) { const bf16x8 gf = *(const LAS bf16x8*)(Gb + 16 * dt * GT_PITCH + 64 * ks);
            a0 = __builtin_amdgcn_mfma_f32_16x16x32_bf16(gf, wf[0][ks], a0, 0, 0, 0);
            a1 = __builtin_amdgcn_mfma_f32_16x16x32_bf16(gf, wf[1][ks], a1, 0, 0, 0); }
#pragma unroll
        for (int tt = 0; tt < 2; ++tt) { const int t = 32 * tq + 16 * tt + fr; const float bias = tt ? bias1 : bias0; const f32x4 a = tt ? a1 : a0;
            const v2u uu = uv[dt][tt];
            v2u w; w.x = cvt_pk_bf16(bf_lo(uu.x) * (a[0] + bias), bf_hi(uu.x) * (a[1] + bias)); w.y = cvt_pk_bf16(bf_lo(uu.y) * (a[2] + bias), bf_hi(uu.y) * (a[3] + bias));
            *(v2u*)(MIX + (size_t)(r0 + t) * DM + 1024 + 128 * g + 16 * dt + 4 * fq) = w; }
    }
}

#define XB_TMO      128
#define XB_XCNT(j)  (256  + 64 * (j))
#define XB_XSUB(j)  (1280 + 64 * (j))
#define XB_XGEN(j)  (2304 + 64 * (j))
#define XB_TOP      3328
#define XB_TOPGEN   3392
#define XCD_BAR_WORDS 3456
#define XB_SPIN_CAP (1u << 18)
__device__ __forceinline__ unsigned xb_ld(unsigned* p)              { return __hip_atomic_load(p, __ATOMIC_RELAXED, __HIP_MEMORY_SCOPE_AGENT); }
__device__ __forceinline__ unsigned xb_add(unsigned* p, unsigned v) { return __hip_atomic_fetch_add(p, v, __ATOMIC_RELAXED, __HIP_MEMORY_SCOPE_AGENT); }
__device__ __forceinline__ unsigned xb_xcc_id() { return (unsigned)__builtin_amdgcn_s_getreg((3 << 11) | 20) & 0xFu; }
#define XB_SPIN(cond, bar) do { unsigned _sp = 0; while (cond) { __builtin_amdgcn_s_sleep(1); \
    if ((++_sp & 255u) == 0u) { if (xb_ld(&(bar)[XB_TMO])) break; if (_sp > XB_SPIN_CAP) { atomicAdd(&(bar)[XB_TMO], 1u); break; } } } } while (0)
struct XcdBarrier { unsigned* bar; unsigned x; volatile LAS unsigned* st; };
__device__ __forceinline__ XcdBarrier xcd_barrier_post(unsigned* bar, volatile LAS unsigned* st) {
    XcdBarrier b; b.bar = bar; b.x = xb_xcc_id(); b.st = st;
    if (threadIdx.x == 0) (void)xb_add(&bar[XB_XCNT(b.x)], 1u);
    return b;
}
__device__ __forceinline__ void xcd_barrier_complete(unsigned* bar, unsigned x, unsigned& nloc, unsigned& nx) {
    const unsigned G = gridDim.x * gridDim.y * gridDim.z;
    unsigned sum, cnt, mine, sp = 0u;
    for (;;) {
        sum = 0u; cnt = 0u; mine = 0u;
#pragma unroll
        for (unsigned j = 0; j < 16; ++j) { const unsigned c = xb_ld(&bar[XB_XCNT(j)]); sum += c; cnt += (c > 0u) ? 1u : 0u; mine = (j == x) ? c : mine; }
        if (sum == G) break;
        __builtin_amdgcn_s_sleep(1);
        if ((++sp & 255u) == 0u) { if (xb_ld(&bar[XB_TMO])) break; if (sp > XB_SPIN_CAP) { atomicAdd(&bar[XB_TMO], 1u); break; } }
    }
    nloc = mine > 0u ? mine : 1u; nx = cnt > 0u ? cnt : 1u;
}
__device__ __forceinline__ void xcd_barrier(const XcdBarrier& b) {
    asm volatile("s_waitcnt vmcnt(0)" ::: "memory");
    __syncthreads();
    if (threadIdx.x == 0) {
        unsigned* bar = b.bar;
        __builtin_amdgcn_s_waitcnt(0);
        unsigned nloc = b.st[0], nx = b.st[1];
        if (nloc == 0u) { xcd_barrier_complete(bar, b.x, nloc, nx); b.st[0] = nloc; b.st[1] = nx; }
        const unsigned old = xb_add(&bar[XB_XSUB(b.x)], 1u);
        const unsigned gen = old / nloc;
        if (old + 1u == (gen + 1u) * nloc) {
            __builtin_amdgcn_fence(__ATOMIC_RELEASE, "agent");
            asm volatile("s_waitcnt vmcnt(0)" ::: "memory");
            const unsigned og = xb_add(&bar[XB_TOP], 1u);
            const unsigned tg = og / nx;
            if (og + 1u == (tg + 1u) * nx) xb_add(&bar[XB_TOPGEN], 1u);
            else XB_SPIN(xb_ld(&bar[XB_TOPGEN]) == tg, bar);
            __builtin_amdgcn_fence(__ATOMIC_ACQUIRE, "agent");
            xb_add(&bar[XB_XGEN(b.x)], 1u);
            asm volatile("s_waitcnt vmcnt(0)" ::: "memory");
        } else {
            XB_SPIN(xb_ld(&bar[XB_XGEN(b.x)]) == gen, bar);
            __builtin_amdgcn_fence(__ATOMIC_ACQUIRE, "agent");
            asm volatile("s_waitcnt vmcnt(0)" ::: "memory");
        }
    }
    __syncthreads();
}

#ifndef PH_MASK
#define PH_MASK 0xff
#endif
#ifndef DUP_MASK
#define DUP_MASK 0
#endif
#define GSYNC() xcd_barrier(xbar)
#define REP(k) for (int rep_ = 0; rep_ < (((DUP_MASK >> (k)) & 1) ? 2 : 1); ++rep_, (rep_ < (((DUP_MASK >> (k)) & 1) ? 2 : 1) ? GSYNC() : (void)0))
__global__ void __launch_bounds__(NTHR, 2) fwd_megakernel(Args args) {
    extern __shared__ __attribute__((aligned(16))) unsigned char lds_raw[];
    LAS unsigned char* lds = (LAS unsigned char*)lds_raw;
    const int tid = threadIdx.x, lane = tid & 63, wave = __builtin_amdgcn_readfirstlane(tid >> 6);
    const int G = gridDim.x, bx = blockIdx.x;
    const int vcu = (G % 8 == 0) ? (bx % 8) * (G / 8) + bx / 8 : bx;
    unsigned char* ws = args.ws;
    const float* xp = args.in[0]; const float* xs = args.in[1];
    const float* w_in = args.in[2]; const float* ln_sgu_g = args.in[3]; const float* ln_sgu_b = args.in[4]; const float* w_s = args.in[5]; const float* b_s = args.in[6];
    const float* sink = args.in[7]; const float* w_o = args.in[8]; const float* ln1_g = args.in[9]; const float* ln1_b = args.in[10];
    const float* w_gate = args.in[11]; const float* w_up = args.in[12]; const float* w_down = args.in[13]; const float* ln2_g = args.in[14]; const float* ln2_b = args.in[15];
    float* out = args.out;
    bf16* WIN_T = (bf16*)(ws + WS_WIN); bf16* WO_T = (bf16*)(ws + WS_WO); bf16* W13_T = (bf16*)(ws + WS_W13); bf16* W2_T = (bf16*)(ws + WS_W2);
    bf16* Y1B = (bf16*)out;
    bf16* Y2B = (bf16*)(ws + WS_XB);
    float* ST1 = (float*)(ws + WS_ST1); float* GST = (float*)(ws + WS_GST); bf16* WSB = (bf16*)(ws + WS_WSB);
    bf16* XB = (bf16*)(ws + WS_XB); bf16* Hb = (bf16*)(ws + WS_H); bf16* MIX = (bf16*)(ws + WS_MIX); bf16* HID = (bf16*)(ws + WS_HID);
    const int gw = vcu * NWAVES + wave, NGW = G * NWAVES;
    if (tid < 2) ((volatile LAS unsigned*)(lds + 131072 + 2048))[tid] = 0u;
    __syncthreads();
    const XcdBarrier xbar = xcd_barrier_post((unsigned*)(ws + WS_BAR), (volatile LAS unsigned*)(lds + 131072 + 2048));

    if constexpr ((PH_MASK & 1) != 0) {
        LAS float* scr = (LAS float*)(lds + wave * 16384);
        constexpr int I_IN = (DM / 64) * (NIN / 32);
        for (int it = gw; it < I_IN; it += NGW) { const int nb = it % (NIN / 32), kb = it / (NIN / 32); p0_transpose_item(w_in, DM, NIN, WIN_T, 32 * nb, 64 * kb, 32 * nb, scr, lane); }
        { const int gt = bx * NTHR + tid;
          if (gt < M * 2 / 4) ((f32x4*)GST)[gt] = (f32x4){0.f, 0.f, 0.f, 0.f};
          if (gt < 8 * 128 * 128 / 8) { const f32x4 a = *(const f32x4*)(w_s + 8 * gt), b = *(const f32x4*)(w_s + 8 * gt + 4);
              v4u w; w.x = cvt_pk_bf16(a.x, a.y); w.y = cvt_pk_bf16(a.z, a.w); w.z = cvt_pk_bf16(b.x, b.y); w.w = cvt_pk_bf16(b.z, b.w); *(v4u*)(WSB + 8 * gt) = w; } }
        const size_t n8 = (size_t)M * DM / 8, nthr = (size_t)G * NTHR;
        for (size_t i = (size_t)bx * NTHR + tid; i < n8; i += nthr) { const size_t e = i * 8;
            const float* src = (e < (size_t)MP * DM) ? xp + e : xs + (e - (size_t)MP * DM);
            const f32x4 a = __builtin_nontemporal_load((const f32x4*)src), b = __builtin_nontemporal_load((const f32x4*)(src + 4));
            v4u w; w.x = cvt_pk_bf16(a.x, a.y); w.y = cvt_pk_bf16(a.z, a.w); w.z = cvt_pk_bf16(b.x, b.y); w.w = cvt_pk_bf16(b.z, b.w);
            *(v4u*)(XB + e) = w; }
    }
    GSYNC();
    REP(1) if constexpr ((PH_MASK & 2) != 0) { pg8::Gemm g{XB, WIN_T, M, NIN, DM}; pg8::StaticOrder S; S.init(M, NIN, G, bx); EpiH E{Hb, GST};
      pg8::gemm_phase<EpiH, pg8::StaticOrder, true, true>(lds, g, S, E);
      const int nfull = (M / 256) * (NIN / 256) / G, nrem = (M / 256) * (NIN / 256) - nfull * G;
      if (bx >= nrem) {
          LAS float* scr = (LAS float*)(lds + wave * 16384);
          constexpr int I_O = (DM / 64) * (DM / 32), I_G = (DM / 64) * (DFF / 32), I_D = (DFF / 64) * (DM / 32);
          const int cw = (bx - nrem) * NWAVES + wave, NCW = (G - nrem) * NWAVES;
          for (int it = cw; it < I_O + 2 * I_G + I_D; it += NCW) {
              int r = it;
              if (r < I_O) { const int nb = r % (DM / 32), kb = r / (DM / 32); p0_transpose_item(w_o, DM, DM, WO_T, 32 * nb, 64 * kb, 32 * nb, scr, lane); continue; } r -= I_O;
              if (r < 2 * I_G) { const int up = r >= I_G ? 1 : 0; if (up) r -= I_G; const int nb = r % (DFF / 32), kb = r / (DFF / 32), n0 = 32 * nb;
                  p0_transpose_item(up ? w_up : w_gate, DM, DFF, W13_T, (n0 >> 7) * 256 + up * 128 + (n0 & 127), 64 * kb, n0, scr, lane); continue; } r -= 2 * I_G;
              { const int nb = r % (DM / 32), kb = r / (DM / 32); p0_transpose_item(w_down, DFF, DM, W2_T, 32 * nb, 64 * kb, 32 * nb, scr, lane); }
          }
      } }
    GSYNC();
    REP(2) if constexpr ((PH_MASK & 4) != 0) {
      for (int it = vcu; it < NGC * 8; it += G) {
#ifndef NO_ATTN
        if (it < NGC * 4) { attn_unit(lds, Hb, MIX, sink, it >> 2, (it >> 1) & 1, it & 1); if (DUP_MASK & 64) attn_unit(lds, Hb, MIX, sink, it >> 2, (it >> 1) & 1, it & 1); }
#endif
#ifndef NO_SGU
        if (it >= NGC * 4) { const int a = it - NGC * 4; sgu_pair(lds, Hb, MIX, ln_sgu_g, ln_sgu_b, WSB, b_s, GST, a >> 2, a & 3); if (DUP_MASK & 128) sgu_pair(lds, Hb, MIX, ln_sgu_g, ln_sgu_b, WSB, b_s, GST, a >> 2, a & 3); }
#endif
    } }
    GSYNC();
    REP(3) if constexpr ((PH_MASK & 8) != 0) { pg8::Gemm g{MIX, WO_T, M, DM, DM}; pg8::StaticOrder S; S.init(M, DM, G, bx); EpiY1 E{XB, Y1B};
      pg8::gemm_phase<EpiY1, pg8::StaticOrder, true, true>(lds, g, S, E); }
    GSYNC();
    REP(4) if constexpr ((PH_MASK & 16) != 0) ln_rows<false>(Y1B, nullptr, XB, ST1, ln1_g, ln1_b, gw, NGW, lane);
    GSYNC();
    REP(5) if constexpr ((PH_MASK & 32) != 0) { pg8::Gemm g{XB, W13_T, M, 2 * DFF, DM}; pg8::StaticOrder S; S.init(M, 2 * DFF, G, bx); EpiHid E{HID};
      pg8::gemm_phase<EpiHid, pg8::StaticOrder, true, true>(lds, g, S, E); }
    GSYNC();
    if constexpr ((PH_MASK & 64) != 0) { pg8::Gemm g{HID, W2_T, M, DM, DFF}; pg8::StaticOrder S; S.init(M, DM, G, bx); EpiY2 E{XB};
      pg8::gemm_phase<EpiY2, pg8::StaticOrder, true, true>(lds, g, S, E); }
    GSYNC();
#ifdef SYNC_PROBE
    for (int i = 0; i < 16; ++i) GSYNC();
#endif
    if constexpr ((PH_MASK & 128) != 0) ln_rows<true>(Y2B, out, nullptr, nullptr, ln2_g, ln2_b, gw, NGW, lane);
}

extern "C" void kernel_launch(void* const* d_in, const int* in_sizes, int n_in, void* d_out, int out_size, void* d_ws, size_t ws_size, hipStream_t stream) {
    static int grid = 0;
    if (grid == 0) {
        if (n_in != 16 || out_size != M * DM || ws_size < WS_END) { fprintf(stderr, "kernel_launch: unexpected shapes (n_in %d, out %d, ws %zu)\n", n_in, out_size, ws_size); grid = -1; return; }
        int dev = 0, cus = 0, per_cu = 0;
        hipGetDevice(&dev);
        hipDeviceGetAttribute(&cus, hipDeviceAttributeMultiprocessorCount, dev);
        if (hipFuncSetAttribute((const void*)fwd_megakernel, hipFuncAttributeMaxDynamicSharedMemorySize, LDS_BYTES) != hipSuccess) { fprintf(stderr, "kernel_launch: hipFuncSetAttribute failed\n"); grid = -1; return; }
        if (hipOccupancyMaxActiveBlocksPerMultiprocessor(&per_cu, (const void*)fwd_megakernel, NTHR, LDS_BYTES) != hipSuccess || per_cu < 1) { fprintf(stderr, "kernel_launch: occupancy query says %d workgroups per CU; nothing launched\n", per_cu); grid = -1; return; }
        grid = cus;
        fprintf(stderr, "kernel_launch: grid %d (cus %d, per_cu %d)\n", grid, cus, per_cu);
    }
    if (grid < 0) return;
    if (hipMemsetAsync((unsigned char*)d_ws + WS_BAR, 0, XCD_BAR_WORDS * 4, stream) != hipSuccess) { fprintf(stderr, "kernel_launch: hipMemsetAsync failed\n"); return; }
    Args a{};
    for (int i = 0; i < 16; ++i) a.in[i] = (const float*)d_in[i];
    a.out = (float*)d_out; a.ws = (unsigned char*)d_ws;
    void* kargs[] = {&a};
    hipError_t e = hipLaunchCooperativeKernel((const void*)fwd_megakernel, dim3(grid), dim3(NTHR), kargs, LDS_BYTES, stream);
    if (e != hipSuccess) fprintf(stderr, "kernel_launch: cooperative launch failed: %s (grid %d)\n", hipGetErrorString(e), grid);
}
```

```cpp
#include <hip/hip_runtime.h>
#include <hip/hip_cooperative_groups.h>
#include <cstdio>
#include <cstdint>
namespace cg = cooperative_groups;

namespace pg8 {
#define PG8_LAS __attribute__((address_space(3)))
typedef unsigned short bf16_t;
typedef short bf16x8 __attribute__((ext_vector_type(8)));
typedef float f32x4 __attribute__((ext_vector_type(4)));
typedef unsigned u32x4 __attribute__((ext_vector_type(4)));
constexpr int BM = 256, BK = 64, HALF = 128, HTB = HALF * BK * 2  , STAGE_BYTES = 8 * HTB, NXCD = 8, WGM = 8;

__host__ __device__ __forceinline__ int lds_byte(int r, int c) { const int st = (r >> 4) * 2 + (c >> 5), rr = r & 15, cc = c & 31, ob = rr * 64 + cc * 2; return st * 1024 + (ob ^ (((ob >> 9) & 1) << 5)); }
__host__ __device__ __forceinline__ void stage_rc(int b, int& R, int& C) { const int st = b / 1024, sb = b % 1024, swz = sb ^ (((sb >> 9) & 1) << 5); R = (st >> 1) * 16 + swz / 64; C = (st & 1) * 32 + (swz % 64) / 2; }
__host__ __device__ __forceinline__ int perm32(int rho) { const int n = rho >> 4, i = rho & 15; return 8 * (i >> 2) + 4 * n + (i & 3); }

struct Unit { int pm, pn; };
struct Gemm { const bf16_t* A; const bf16_t* Bt; int M, N, K; };

struct StaticOrder {
    int nM, nN, nwg, G, c;
    __host__ __device__ void init(int M, int N, int G_, int c_) { nM = M / BM; nN = N / BM; nwg = nM * nN; G = G_; c = c_; }
    __host__ __device__ bool next(int i, Unit& u) const {
        const long L = (long)i * G + c; if (L >= nwg) return false;
        int wgid = (int)L; { const int q = nwg / NXCD, r = nwg % NXCD, xcd = wgid % NXCD, off = wgid / NXCD; wgid = (xcd < r ? xcd * (q + 1) : r * (q + 1) + (xcd - r) * q) + off; }
        const int nig = WGM * nN, gid = wgid / nig, fm = gid * WGM, gsz = (nM - fm) < WGM ? (nM - fm) : WGM;
        u.pm = fm + ((wgid % nig) % gsz); u.pn = (wgid % nig) / gsz; return true;
    }
    __device__ __forceinline__ void a_ready(const Unit&) const {}
    __device__ __forceinline__ void done(const Unit&) const {}
};

__device__ __forceinline__ unsigned cvt_pk_bf16(float lo, float hi) { unsigned r; asm("v_cvt_pk_bf16_f32 %0, %1, %2" : "=v"(r) : "v"(lo), "v"(hi)); return r; }

template <class Epi, class Sched, bool ALIGN_EPI = false, bool SP2 = false>
__device__ __forceinline__ void gemm_phase(PG8_LAS unsigned char* lds, const Gemm g, const Sched& S, const Epi& E) {
    int tid_ = threadIdx.x; asm volatile("" : "+v"(tid_));
    const int tid = tid_, wid = __builtin_amdgcn_readfirstlane(tid >> 6), lane = tid & 63, wr = wid >> 2, wc = wid & 3, fr = lane & 15, fq = lane >> 4;
    const int K = g.K, nt = K / BK;
    unsigned voffA[2], voffB[2];
#pragma unroll
    for (int i = 0; i < 2; ++i) { int R, C; stage_rc(tid * 16 + i * 8192, R, C); const int Rb = Epi::PERM ? ((R & ~31) + perm32(R & 31)) : R;
        voffA[i] = (unsigned)(R * K + C) * 2u; voffB[i] = (unsigned)(Rb * K + C) * 2u; }
    const size_t kstep = (size_t)(BK * 2);
    const size_t hstep = (size_t)HALF * K * 2;
    const size_t tstep = 2 * hstep;
    const unsigned ldsw = (unsigned)wid * 1024u;
    const int aoff = lds_byte(wr * 64 + fr, fq * 8), boff = lds_byte(wc * 32 + fr, fq * 8);
#define PG8_SA(b, h) (((b) * 2 + (h)) * HTB)
#define PG8_SB(b, h) ((4 + (b) * 2 + (h)) * HTB)
#define PG8_STAGE(bufoff, gbase, voff) do { _Pragma("unroll") for (int _i = 0; _i < 2; ++_i) \
        __builtin_amdgcn_global_load_lds((const unsigned*)((const char*)(gbase) + (voff)[_i]), (PG8_LAS unsigned*)(lds + (bufoff) + ldsw + _i * 8192), 16, 0, 0); } while (0)
#define PG8_LDA(dst, b, h) do { _Pragma("unroll") for (int m = 0; m < 4; ++m) _Pragma("unroll") for (int k = 0; k < 2; ++k) dst[m][k] = *(const PG8_LAS bf16x8*)(lds + PG8_SA(b, h) + aoff + m * 2048 + k * 1024); } while (0)
#define PG8_LDB(dst, b, h) do { _Pragma("unroll") for (int n = 0; n < 2; ++n) _Pragma("unroll") for (int k = 0; k < 2; ++k) dst[n][k] = *(const PG8_LAS bf16x8*)(lds + PG8_SB(b, h) + boff + n * 2048 + k * 1024); } while (0)
#define PG8_MMA(ai, bj, At, Bt) do { __builtin_amdgcn_s_setprio(1); _Pragma("unroll") for (int m = 0; m < 4; ++m) _Pragma("unroll") for (int n = 0; n < 2; ++n) _Pragma("unroll") for (int k = 0; k < 2; ++k) \
        acc[ai][bj][m][n] = __builtin_amdgcn_mfma_f32_16x16x32_bf16(Bt[n][k], At[m][k], acc[ai][bj][m][n], 0, 0, 0); __builtin_amdgcn_s_setprio(0); } while (0)
#define PG8_WAIT_V(n) asm volatile("s_waitcnt vmcnt(" #n ")" ::: "memory")
#define PG8_WAIT_L(n) asm volatile("s_waitcnt lgkmcnt(" #n ")" ::: "memory")
#define PG8_BAR __builtin_amdgcn_s_barrier()
#define PG8_SCHED __builtin_amdgcn_sched_barrier(0)
    Unit cur, nxt; int ui = 0;
    if (!S.next(0, cur)) return;
    f32x4 acc[2][2][4][2];
#pragma unroll
    for (int a = 0; a < 2; ++a)
#pragma unroll
        for (int b = 0; b < 2; ++b)
#pragma unroll
            for (int m = 0; m < 4; ++m)
#pragma unroll
                for (int n = 0; n < 2; ++n) acc[a][b][m][n] = (f32x4){0.f, 0.f, 0.f, 0.f};
    bf16x8 At[4][2], B0[2][2], B1[2][2];
    const char* cA = (const char*)g.A + (size_t)cur.pm * tstep; const char* cB = (const char*)g.Bt + (size_t)cur.pn * tstep;
    S.a_ready(cur);
    if constexpr (SP2) {
        PG8_STAGE(PG8_SB(0, 0), cB, voffB); PG8_STAGE(PG8_SB(0, 1), cB + hstep, voffB); PG8_STAGE(PG8_SA(0, 0), cA, voffA); PG8_STAGE(PG8_SA(0, 1), cA + hstep, voffA);
        if (wr == 1) PG8_BAR;
        PG8_WAIT_V(2); PG8_BAR;
        PG8_STAGE(PG8_SB(1, 0), cB + kstep, voffB); PG8_STAGE(PG8_SA(1, 0), cA + kstep, voffA); PG8_STAGE(PG8_SB(1, 1), cB + hstep + kstep, voffB);
        PG8_WAIT_V(6); PG8_BAR;
    } else {
        PG8_STAGE(PG8_SB(0, 0), cB, voffB); PG8_STAGE(PG8_SA(0, 0), cA, voffA); PG8_STAGE(PG8_SB(0, 1), cB + hstep, voffB); PG8_STAGE(PG8_SA(0, 1), cA + hstep, voffA);
        if (wr == 1) PG8_BAR;
        PG8_WAIT_V(4); PG8_BAR;
        PG8_STAGE(PG8_SB(1, 0), cB + kstep, voffB); PG8_STAGE(PG8_SA(1, 0), cA + kstep, voffA); PG8_STAGE(PG8_SB(1, 1), cB + hstep + kstep, voffB);
        PG8_WAIT_V(6); PG8_BAR;
    }
    for (;;) {
        const bool has_next = S.next(ui + 1, nxt);
        const char* nA = has_next ? (const char*)g.A + (size_t)nxt.pm * tstep : cA; const char* nB = has_next ? (const char*)g.Bt + (size_t)nxt.pn * tstep : cB;
        for (int t = 0; t < nt; t += 2) {
            const bool last = (t == nt - 2);
            const char* a1 = cA + (size_t)(t + 1) * kstep;
            const char* a2 = last ? nA : cA + (size_t)(t + 2) * kstep; const char* b2 = last ? nB : cB + (size_t)(t + 2) * kstep;
            const char* a3 = a2 + kstep; const char* b3 = b2 + kstep;
            if (last && has_next) S.a_ready(nxt);
            if constexpr (SP2) {
            PG8_LDB(B0, 0, 0); PG8_LDB(B1, 0, 1); PG8_SCHED; PG8_LDA(At, 0, 0); PG8_STAGE(PG8_SA(1, 1), a1 + hstep, voffA);
            PG8_WAIT_V(8); PG8_WAIT_L(0); PG8_BAR; PG8_MMA(0, 0, At, B0); PG8_MMA(0, 1, At, B1); PG8_BAR; PG8_SCHED;
            PG8_LDA(At, 0, 1); PG8_STAGE(PG8_SB(0, 0), b2, voffB); PG8_STAGE(PG8_SB(0, 1), b2 + hstep, voffB); PG8_STAGE(PG8_SA(0, 0), a2, voffA);
            PG8_WAIT_V(8); PG8_WAIT_L(0); PG8_BAR; PG8_MMA(1, 0, At, B0); PG8_MMA(1, 1, At, B1); PG8_BAR; PG8_SCHED;
            PG8_LDB(B0, 1, 0); PG8_LDB(B1, 1, 1); PG8_SCHED; PG8_LDA(At, 1, 0); PG8_STAGE(PG8_SA(0, 1), a2 + hstep, voffA);
            PG8_WAIT_V(8); PG8_WAIT_L(0); PG8_BAR; PG8_MMA(0, 0, At, B0); PG8_MMA(0, 1, At, B1); PG8_BAR; PG8_SCHED;
            PG8_LDA(At, 1, 1); PG8_STAGE(PG8_SB(1, 0), b3, voffB); PG8_STAGE(PG8_SB(1, 1), b3 + hstep, voffB); PG8_STAGE(PG8_SA(1, 0), a3, voffA);
            PG8_WAIT_V(8); PG8_WAIT_L(0); PG8_BAR; PG8_MMA(1, 0, At, B0); PG8_MMA(1, 1, At, B1); PG8_BAR; PG8_SCHED;
            } else {
            PG8_LDB(B0, 0, 0); PG8_SCHED; PG8_LDA(At, 0, 0); PG8_STAGE(PG8_SA(1, 1), a1 + hstep, voffA);
            PG8_WAIT_L(8); PG8_BAR; PG8_WAIT_L(0); PG8_MMA(0, 0, At, B0); PG8_BAR; PG8_SCHED;
            PG8_LDB(B1, 0, 1); PG8_STAGE(PG8_SB(0, 0), b2, voffB);
            PG8_BAR; PG8_WAIT_L(0); PG8_MMA(0, 1, At, B1); PG8_BAR;
            PG8_LDA(At, 0, 1); PG8_STAGE(PG8_SA(0, 0), a2, voffA);
            PG8_BAR; PG8_WAIT_L(0); PG8_MMA(1, 0, At, B0); PG8_BAR; PG8_SCHED;
            PG8_STAGE(PG8_SB(0, 1), b2 + hstep, voffB);
            PG8_WAIT_V(6); PG8_BAR; PG8_MMA(1, 1, At, B1); PG8_BAR;
            PG8_LDB(B0, 1, 0); PG8_SCHED; PG8_LDA(At, 1, 0); PG8_STAGE(PG8_SA(0, 1), a2 + hstep, voffA);
            PG8_WAIT_L(8); PG8_BAR; PG8_WAIT_L(0); PG8_MMA(0, 0, At, B0); PG8_BAR; PG8_SCHED;
            PG8_LDB(B1, 1, 1); PG8_STAGE(PG8_SB(1, 0), b3, voffB);
            PG8_BAR; PG8_WAIT_L(0); PG8_MMA(0, 1, At, B1); PG8_BAR;
            PG8_LDA(At, 1, 1); PG8_STAGE(PG8_SA(1, 0), a3, voffA);
            PG8_BAR; PG8_WAIT_L(0); PG8_MMA(1, 0, At, B0); PG8_BAR; PG8_SCHED;
            PG8_STAGE(PG8_SB(1, 1), b3 + hstep, voffB);
            PG8_WAIT_V(6); PG8_BAR; PG8_MMA(1, 1, At, B1); PG8_BAR;
            }
        }
        if constexpr (ALIGN_EPI) { if (wr == 0) PG8_BAR; }
        E(acc, cur, wr, wc, fr, fq); S.done(cur);
        if (!has_next) break;
#pragma unroll
        for (int a = 0; a < 2; ++a)
#pragma unroll
            for (int b = 0; b < 2; ++b)
#pragma unroll
                for (int m = 0; m < 4; ++m)
#pragma unroll
                    for (int n = 0; n < 2; ++n) acc[a][b][m][n] = (f32x4){0.f, 0.f, 0.f, 0.f};
        cur = nxt; cA = nA; cB = nB; ++ui;
        if constexpr (ALIGN_EPI) { if (wr == 1) PG8_BAR; }
    }
    PG8_WAIT_V(0);
    if constexpr (!ALIGN_EPI) { if (wr == 0) PG8_BAR; }
    PG8_BAR;
#undef PG8_SA
#undef PG8_SB
#undef PG8_STAGE
#undef PG8_LDA
#undef PG8_LDB
#undef PG8_MMA
#undef PG8_WAIT_V
#undef PG8_WAIT_L
#undef PG8_BAR
#undef PG8_SCHED
}
}

constexpr int NWAVES = 8, NTHR = 512;
constexpr int M = 24576, MP = 16384, DM = 2048, NIN = 3584, DFF = 5632;
constexpr int COL_K = 1024, COL_V = 1280, COL_U = 1536, COL_GV = 2560;
constexpr int NGC = 192;
constexpr float LN_EPS = 1e-5f;
constexpr float ALPHA = 1.189207115002721f;
constexpr float LOG2E = 1.4426950408889634f;

constexpr size_t MiB = 1u << 20;
constexpr size_t WS_WSB = 0, WS_GST = 512 * 1024, WS_BAR = 768 * 1024;
constexpr size_t WS_WIN = 1 * MiB, WS_WO = 15 * MiB, WS_W13 = 23 * MiB, WS_W2 = 67 * MiB, WS_ST1 = 89 * MiB;
constexpr size_t WS_XB = 90 * MiB;
constexpr size_t WS_H = 186 * MiB;
constexpr size_t WS_MIX = 354 * MiB;
constexpr size_t WS_HID = 186 * MiB;
constexpr size_t WS_END = 450 * MiB;
static_assert(WS_H + (size_t)M * NIN * 2 == WS_MIX && WS_MIX + (size_t)M * DM * 2 == WS_END && WS_HID + (size_t)M * DFF * 2 == WS_END, "ws map");

constexpr int LDS_BYTES = 131072 + 4096;

#define GAS __attribute__((address_space(1)))
#define LAS __attribute__((address_space(3)))
typedef unsigned short bf16;
typedef unsigned v4u __attribute__((ext_vector_type(4)));
typedef unsigned v2u __attribute__((ext_vector_type(2)));
typedef float f32x4 __attribute__((ext_vector_type(4)));
typedef float f32x2 __attribute__((ext_vector_type(2)));
typedef short bf16x8 __attribute__((ext_vector_type(8)));
using pg8::cvt_pk_bf16;
#define LDS_WAIT() asm volatile("s_waitcnt lgkmcnt(0)" ::: "memory")
__device__ __forceinline__ float bf_lo(unsigned w) { return __uint_as_float(w << 16); }
__device__ __forceinline__ float bf_hi(unsigned w) { return __uint_as_float(w & 0xffff0000u); }
__device__ __forceinline__ float wave_sum(float v) {
#pragma unroll
    for (int o = 1; o < 64; o <<= 1) v += __shfl_xor(v, o);
    return v;
}
__device__ __forceinline__ float gelu_tanh(float x) {
    const float t = x * (-2.3022082f + (-0.10294324f) * x * x);
    return x * __builtin_amdgcn_rcpf(1.0f + __builtin_amdgcn_exp2f(t));
}
__device__ __forceinline__ float silu_f(float x) { return x * __builtin_amdgcn_rcpf(1.0f + __builtin_amdgcn_exp2f(-LOG2E * x)); }
__device__ __forceinline__ f32x2 gelu_tanh2(f32x2 x) {
    const f32x2 t = x * ((x * x) * (-0.10294324f) + (-2.3022082f));
    f32x2 e; e.x = __builtin_amdgcn_exp2f(t.x); e.y = __builtin_amdgcn_exp2f(t.y);
    const f32x2 d = e + 1.0f; f32x2 r; r.x = __builtin_amdgcn_rcpf(d.x); r.y = __builtin_amdgcn_rcpf(d.y);
    return x * r;
}
__device__ __forceinline__ f32x2 silu_mul2(f32x2 g, f32x2 u) {
    const f32x2 t = g * (-LOG2E);
    f32x2 e; e.x = __builtin_amdgcn_exp2f(t.x); e.y = __builtin_amdgcn_exp2f(t.y);
    const f32x2 d = e + 1.0f; f32x2 r; r.x = __builtin_amdgcn_rcpf(d.x); r.y = __builtin_amdgcn_rcpf(d.y);
    return (g * r) * u;
}

struct EpiH {
    static constexpr bool PERM = true;
    bf16* O; float* gst;
    __device__ __forceinline__ void operator()(const f32x4 (&acc)[2][2][4][2], const pg8::Unit& u, int wr, int wc, int fr, int fq) const {
        const int row0 = u.pm * 256 + wr * 64 + fr, col0 = u.pn * 256 + wc * 32 + 8 * fq;
        const bool act = u.pn >= 6, stat = u.pn >= 10;
#pragma unroll
        for (int ai = 0; ai < 2; ++ai)
#pragma unroll
            for (int m = 0; m < 4; ++m) { bf16* rowp = O + (size_t)(row0 + ai * 128 + m * 16) * NIN + col0;
                float rs = 0.f, rq = 0.f;
#pragma unroll
                for (int bj = 0; bj < 2; ++bj) { f32x4 v0 = acc[ai][bj][m][0], v1 = acc[ai][bj][m][1];
                    if (act) { const f32x2 a = gelu_tanh2((f32x2){v0[0], v0[1]}), b = gelu_tanh2((f32x2){v0[2], v0[3]}), c = gelu_tanh2((f32x2){v1[0], v1[1]}), d = gelu_tanh2((f32x2){v1[2], v1[3]});
                        v0 = (f32x4){a.x, a.y, b.x, b.y}; v1 = (f32x4){c.x, c.y, d.x, d.y}; }
                    v4u w; w.x = cvt_pk_bf16(v0[0], v0[1]); w.y = cvt_pk_bf16(v0[2], v0[3]); w.z = cvt_pk_bf16(v1[0], v1[1]); w.w = cvt_pk_bf16(v1[2], v1[3]);
                    *(v4u*)(rowp + bj * 128) = w;
                    if (stat) {
#pragma unroll
                        for (int t = 0; t < 4; ++t) { const float a = bf_lo(w[t]), b = bf_hi(w[t]); rs += a + b; rq += a * a + b * b; } } }
                if (stat) { rs += __shfl_xor(rs, 16); rs += __shfl_xor(rs, 32); rq += __shfl_xor(rq, 16); rq += __shfl_xor(rq, 32);
                    if (fq == 0) { float* gp = gst + 2 * (size_t)(row0 + ai * 128 + m * 16); __hip_atomic_fetch_add(gp, rs, __ATOMIC_RELAXED, __HIP_MEMORY_SCOPE_AGENT); __hip_atomic_fetch_add(gp + 1, rq, __ATOMIC_RELAXED, __HIP_MEMORY_SCOPE_AGENT); } } }
    }
};
struct EpiY1 {
    static constexpr bool PERM = true;
    const bf16* X; bf16* Y;
    __device__ __forceinline__ void operator()(const f32x4 (&acc)[2][2][4][2], const pg8::Unit& u, int wr, int wc, int fr, int fq) const {
        const int row0 = u.pm * 256 + wr * 64 + fr, col0 = u.pn * 256 + wc * 32 + 8 * fq;
#pragma unroll
        for (int ai = 0; ai < 2; ++ai) {
            v4u xv[4][2];
#pragma unroll
            for (int m = 0; m < 4; ++m) { const size_t off = (size_t)(row0 + ai * 128 + m * 16) * DM + col0;
#pragma unroll
                for (int bj = 0; bj < 2; ++bj) xv[m][bj] = __builtin_nontemporal_load((const v4u*)(X + off + bj * 128)); }
            asm volatile("" ::: "memory");
#pragma unroll
            for (int m = 0; m < 4; ++m) { const size_t off = (size_t)(row0 + ai * 128 + m * 16) * DM + col0;
#pragma unroll
                for (int bj = 0; bj < 2; ++bj) { const v4u xw = xv[m][bj];
                    const f32x4 xa = (f32x4){bf_lo(xw.x), bf_hi(xw.x), bf_lo(xw.y), bf_hi(xw.y)}, xb = (f32x4){bf_lo(xw.z), bf_hi(xw.z), bf_lo(xw.w), bf_hi(xw.w)};
                    const f32x4 y0 = xa * ALPHA + acc[ai][bj][m][0], y1 = xb * ALPHA + acc[ai][bj][m][1];
                    v4u w; w.x = cvt_pk_bf16(y0[0], y0[1]); w.y = cvt_pk_bf16(y0[2], y0[3]); w.z = cvt_pk_bf16(y1[0], y1[1]); w.w = cvt_pk_bf16(y1[2], y1[3]);
                    *(v4u*)(Y + off + bj * 128) = w; } }
            asm volatile("" ::: "memory"); }
    }
};
struct EpiHid {
    static constexpr bool PERM = true;
    bf16* O;
    __device__ __forceinline__ void operator()(const f32x4 (&acc)[2][2][4][2], const pg8::Unit& u, int wr, int wc, int fr, int fq) const {
        const int row0 = u.pm * 256 + wr * 64 + fr, col0 = u.pn * 128 + wc * 32 + 8 * fq;
#pragma unroll
        for (int ai = 0; ai < 2; ++ai)
#pragma unroll
            for (int m = 0; m < 4; ++m) {
                const f32x4 g0 = acc[ai][0][m][0], g1 = acc[ai][0][m][1], u0 = acc[ai][1][m][0], u1 = acc[ai][1][m][1];
                const f32x2 ha = silu_mul2((f32x2){g0[0], g0[1]}, (f32x2){u0[0], u0[1]}), hb = silu_mul2((f32x2){g0[2], g0[3]}, (f32x2){u0[2], u0[3]});
                const f32x2 hc = silu_mul2((f32x2){g1[0], g1[1]}, (f32x2){u1[0], u1[1]}), hd = silu_mul2((f32x2){g1[2], g1[3]}, (f32x2){u1[2], u1[3]});
                v4u w; w.x = cvt_pk_bf16(ha.x, ha.y); w.y = cvt_pk_bf16(hb.x, hb.y); w.z = cvt_pk_bf16(hc.x, hc.y); w.w = cvt_pk_bf16(hd.x, hd.y);
                *(v4u*)(O + (size_t)(row0 + ai * 128 + m * 16) * DFF + col0) = w; }
    }
};
struct EpiY2 {
    static constexpr bool PERM = true;
    bf16* X;
    __device__ __forceinline__ void operator()(const f32x4 (&acc)[2][2][4][2], const pg8::Unit& u, int wr, int wc, int fr, int fq) const {
        const int row0 = u.pm * 256 + wr * 64 + fr, col0 = u.pn * 256 + wc * 32 + 8 * fq;
#pragma unroll
        for (int ai = 0; ai < 2; ++ai) {
            v4u xv[4][2];
#pragma unroll
            for (int m = 0; m < 4; ++m) { const size_t off = (size_t)(row0 + ai * 128 + m * 16) * DM + col0;
#pragma unroll
                for (int bj = 0; bj < 2; ++bj) xv[m][bj] = __builtin_nontemporal_load((const v4u*)(X + off + bj * 128)); }
            asm volatile("" ::: "memory");
#pragma unroll
            for (int m = 0; m < 4; ++m) { const size_t off = (size_t)(row0 + ai * 128 + m * 16) * DM + col0;
#pragma unroll
                for (int bj = 0; bj < 2; ++bj) { const v4u xw = xv[m][bj];
                    const f32x4 xa = (f32x4){bf_lo(xw.x), bf_hi(xw.x), bf_lo(xw.y), bf_hi(xw.y)}, xb = (f32x4){bf_lo(xw.z), bf_hi(xw.z), bf_lo(xw.w), bf_hi(xw.w)};
                    const f32x4 o0 = xa * ALPHA + acc[ai][bj][m][0], o1 = xb * ALPHA + acc[ai][bj][m][1];
                    v4u w; w.x = cvt_pk_bf16(o0[0], o0[1]); w.y = cvt_pk_bf16(o0[2], o0[3]); w.z = cvt_pk_bf16(o1[0], o1[1]); w.w = cvt_pk_bf16(o1[2], o1[3]);
                    *(v4u*)(X + off + bj * 128) = w; } }
            asm volatile("" ::: "memory"); }
    }
};

__device__ __forceinline__ void p0_transpose_item(const float* W, int K, int N, bf16* WT, int drow0, int k0, int n0, LAS float* scr, int lane) {
    float v[32];
    const float* wp = W + (size_t)(k0 + (lane >> 5)) * N + n0 + (lane & 31);
#pragma unroll
    for (int i = 0; i < 32; ++i) v[i] = __builtin_nontemporal_load(wp + (size_t)(2 * i) * N);
#pragma unroll
    for (int i = 0; i < 32; ++i) scr[(2 * i + (lane >> 5)) * 33 + (lane & 31)] = v[i];
    LDS_WAIT(); asm volatile("" ::: "memory");
    const int c = lane & 7;
#pragma unroll
    for (int j = 0; j < 4; ++j) { const int n = (lane >> 3) + 8 * j; const LAS float* s = scr + (8 * c) * 33 + n;
        v4u o; o.x = cvt_pk_bf16(s[0 * 33], s[1 * 33]); o.y = cvt_pk_bf16(s[2 * 33], s[3 * 33]); o.z = cvt_pk_bf16(s[4 * 33], s[5 * 33]); o.w = cvt_pk_bf16(s[6 * 33], s[7 * 33]);
        *(v4u*)(WT + (size_t)(drow0 + n) * K + k0 + 8 * c) = o; }
    LDS_WAIT(); asm volatile("" ::: "memory");
}

struct Args { const float* in[16]; float* out; unsigned char* ws; };

template <bool FINAL>
__device__ __forceinline__ void ln_rows(const bf16* src, float* dstf, bf16* dstb, const float* g, const float* b, int gw, int NGW, int lane) {
    f32x4 gg[8], bb[8];
#pragma unroll
    for (int j = 0; j < 4; ++j) { gg[2 * j] = ((const f32x4*)g)[2 * (lane + 64 * j)]; gg[2 * j + 1] = ((const f32x4*)g)[2 * (lane + 64 * j) + 1];
        bb[2 * j] = ((const f32x4*)b)[2 * (lane + 64 * j)]; bb[2 * j + 1] = ((const f32x4*)b)[2 * (lane + 64 * j) + 1]; }
    for (int m = 2 * gw; m < M; m += 2 * NGW) {
        const v4u* xr = (const v4u*)(src + (size_t)m * DM) + lane;
        v4u raw[2][4];
#pragma unroll
        for (int r = 0; r < 2; ++r)
#pragma unroll
            for (int j = 0; j < 4; ++j) raw[r][j] = __builtin_nontemporal_load(&xr[r * 256 + 64 * j]);
        f32x4 v[2][8]; float s[2] = {0.f, 0.f};
#pragma unroll
        for (int r = 0; r < 2; ++r)
#pragma unroll
            for (int j = 0; j < 4; ++j) { v[r][2 * j] = (f32x4){bf_lo(raw[r][j].x), bf_hi(raw[r][j].x), bf_lo(raw[r][j].y), bf_hi(raw[r][j].y)}; v[r][2 * j + 1] = (f32x4){bf_lo(raw[r][j].z), bf_hi(raw[r][j].z), bf_lo(raw[r][j].w), bf_hi(raw[r][j].w)}; }
#pragma unroll
        for (int r = 0; r < 2; ++r)
#pragma unroll
            for (int j = 0; j < 8; ++j) s[r] += (v[r][j].x + v[r][j].y) + (v[r][j].z + v[r][j].w);
#pragma unroll
        for (int o = 1; o < 64; o <<= 1) { s[0] += __shfl_xor(s[0], o); s[1] += __shfl_xor(s[1], o); }
        float q[2] = {0.f, 0.f};
#pragma unroll
        for (int r = 0; r < 2; ++r) { const float mean = s[r] * (1.f / DM);
#pragma unroll
            for (int j = 0; j < 8; ++j) { v[r][j] = v[r][j] - mean; q[r] += (v[r][j].x * v[r][j].x + v[r][j].y * v[r][j].y) + (v[r][j].z * v[r][j].z + v[r][j].w * v[r][j].w); } }
#pragma unroll
        for (int o = 1; o < 64; o <<= 1) { q[0] += __shfl_xor(q[0], o); q[1] += __shfl_xor(q[1], o); }
#pragma unroll
        for (int r = 0; r < 2; ++r) { const float rstd = 1.f / sqrtf(q[r] * (1.f / DM) + LN_EPS);
            if (FINAL) {
                f32x4* o = (f32x4*)(dstf + (size_t)(m + r) * DM) + 2 * lane;
#pragma unroll
                for (int j = 0; j < 4; ++j) { __builtin_nontemporal_store((v[r][2 * j] * rstd) * gg[2 * j] + bb[2 * j], &o[128 * j]); __builtin_nontemporal_store((v[r][2 * j + 1] * rstd) * gg[2 * j + 1] + bb[2 * j + 1], &o[128 * j + 1]); }
            } else {
                v4u* o = (v4u*)(dstb + (size_t)(m + r) * DM) + lane;
#pragma unroll
                for (int j = 0; j < 4; ++j) { const f32x4 y0 = (v[r][2 * j] * rstd) * gg[2 * j] + bb[2 * j], y1 = (v[r][2 * j + 1] * rstd) * gg[2 * j + 1] + bb[2 * j + 1];
                    v4u w; w.x = cvt_pk_bf16(y0.x, y0.y); w.y = cvt_pk_bf16(y0.z, y0.w); w.z = cvt_pk_bf16(y1.x, y1.y); w.w = cvt_pk_bf16(y1.z, y1.w); o[64 * j] = w; }
            } }
    }
}

constexpr int VT_PITCH = 784;
__device__ __forceinline__ void attn_head_scores(const LAS unsigned char* kbase, const bf16x8 (&qf)[4], int swz, int p0, float rel0f, float nslope2, float sink2, float pen0, float pen2, v4u (&pf)[9], float& inv) {
    f32x4 S[18];
#pragma unroll
    for (int j = 0; j < 18; ++j) {
        S[j] = (f32x4){0.f, 0.f, 0.f, 0.f};
#pragma unroll
        for (int ks = 0; ks < 4; ++ks) { const bf16x8 kf = *(const LAS bf16x8*)(kbase + (j >> 1) * 8192 + (j & 1) * 1024 + (((4 * ks) ^ swz) << 4));
            S[j] = __builtin_amdgcn_mfma_f32_16x16x32_bf16(kf, qf[ks], S[j], 0, 0, 0); }
        if (j & 1) __builtin_amdgcn_sched_barrier(0);
    }
    const float sc2 = 0.08838834764831845f * LOG2E;
    float mx = sink2;
    asm volatile("" : "+v"(rel0f));
#pragma unroll
    for (int t = 0; t < 9; ++t) { const int p = p0 + t; const float pen = p < 4 ? pen0 : (p >= 8 ? pen2 : 0.f);
#pragma unroll
        for (int e = 0; e < 2; ++e)
#pragma unroll
            for (int i = 0; i < 4; ++i) { const float relf = rel0f + (float)(32 * t + 4 * e + i);
                float sv = __builtin_fmaf(S[2 * t + e][i], sc2, __builtin_fmaf(__builtin_fabsf(relf), nslope2, pen));
                if (t == 0 || t == 8) sv = (__builtin_fabsf(relf) > 128.f) ? -1e30f : sv;
                S[2 * t + e][i] = sv; mx = fmaxf(mx, sv); } }
    mx = fmaxf(mx, __shfl_xor(mx, 16)); mx = fmaxf(mx, __shfl_xor(mx, 32));
    float sum = 0.f;
#pragma unroll
    for (int j = 0; j < 18; ++j)
#pragma unroll
        for (int i = 0; i < 4; ++i) { const float p = __builtin_amdgcn_exp2f(S[j][i] - mx); S[j][i] = p; sum += p; }
    sum += __shfl_xor(sum, 16); sum += __shfl_xor(sum, 32);
    inv = 1.0f / (sum + __builtin_amdgcn_exp2f(sink2 - mx));
#pragma unroll
    for (int t = 0; t < 9; ++t) { pf[t].x = cvt_pk_bf16(S[2 * t][0], S[2 * t][1]); pf[t].y = cvt_pk_bf16(S[2 * t][2], S[2 * t][3]);
        pf[t].z = cvt_pk_bf16(S[2 * t + 1][0], S[2 * t + 1][1]); pf[t].w = cvt_pk_bf16(S[2 * t + 1][2], S[2 * t + 1][3]); }
}
__device__ __forceinline__ void attn_head_pv(const LAS unsigned char* vbase, const v4u (&pf)[9], float inv, bf16* Og) {
#pragma unroll
    for (int dt = 0; dt < 8; ++dt) {
        f32x4 o = (f32x4){0.f, 0.f, 0.f, 0.f};
#pragma unroll
        for (int t = 0; t < 9; ++t) { const bf16x8 vf = *(const LAS bf16x8*)(vbase + 16 * dt * VT_PITCH + 64 * t);
            o = __builtin_amdgcn_mfma_f32_16x16x32_bf16(vf, __builtin_bit_cast(bf16x8, pf[t]), o, 0, 0, 0); }
        v2u w; w.x = cvt_pk_bf16(o[0] * inv, o[1] * inv); w.y = cvt_pk_bf16(o[2] * inv, o[3] * inv);
        *(v2u*)(Og + 16 * dt) = w;
        __builtin_amdgcn_sched_barrier(0);
    }
}
__device__ __forceinline__ void vt_write(LAS unsigned char* lds, const v4u (&in)[8], int dblk, int key0) {
#pragma unroll
    for (int i = 0; i < 8; ++i) { v4u o;
#pragma unroll
        for (int t = 0; t < 4; ++t) { const unsigned a = in[2 * t][i >> 1], b = in[2 * t + 1][i >> 1];
            o[t] = (i & 1) ? ((a >> 16) | (b & 0xffff0000u)) : ((a & 0xffffu) | (b << 16)); }
        *(LAS v4u*)(lds + (8 * dblk + i) * VT_PITCH + key0 * 2) = o; }
}
__device__ __forceinline__ void attn_unit(LAS unsigned char* lds, const bf16* H, bf16* MIX, const float* sink, int gc, int kv, int hp) {
    int tid_ = threadIdx.x; asm volatile("" : "+v"(tid_));
    const int tid = tid_, lane = tid & 63, wave = __builtin_amdgcn_readfirstlane(tid >> 6);
    const int c = gc & 15, fr = lane & 15, fq = lane >> 4, hA = 4 * kv + 2 * hp, hB = hA + 1;
    const int rowq0 = gc * 128, roww0 = rowq0 - 128;
    const bool v0 = (c != 0), v2 = (c != 15);
    const int p0 = wave >> 1;
    __syncthreads();
    {
        const bf16* Kg = H + COL_K + 128 * kv;
#pragma unroll
        for (int it = 0; it < 12; ++it) { const int ch = tid + it * NTHR, row = ch >> 4, cc = ch & 15, kb = row >> 7;
            const int grow = roww0 + row + ((kb == 0 && !v0) ? 128 : 0) - ((kb == 2 && !v2) ? 128 : 0);
            const v4u v = *(const v4u*)(Kg + (size_t)grow * NIN + cc * 8);
            const int g = (((row >> 3) & 3) << 2) | (row & 3);
            *(LAS v4u*)(lds + row * 256 + ((cc ^ g) << 4)) = v; }
    }
    bf16x8 qfA[4], qfB[4];
    { const bf16* Qg = H + (size_t)(rowq0 + 16 * wave + fr) * NIN + 128 * hA + 8 * fq;
#pragma unroll
      for (int ks = 0; ks < 4; ++ks) { qfA[ks] = *(const bf16x8*)(Qg + 32 * ks); qfB[ks] = *(const bf16x8*)(Qg + 128 + 32 * ks); } }
    const int r = tid & 255, sblk = r >> 4, dblk = r & 15;
    v4u vin0[8], vin1[8];
    { const bf16* Vg = H + COL_V + 128 * kv + 8 * dblk;
      const int kb = tid >> 8, key0 = 128 * kb + 8 * sblk, grow = roww0 + key0 + ((kb == 0 && !v0) ? 128 : 0);
#pragma unroll
      for (int jj = 0; jj < 8; ++jj) vin0[jj] = *(const v4u*)(Vg + (size_t)(grow + jj) * NIN);
      if (wave < 4) { const int grow2 = roww0 + 256 + 8 * sblk - (v2 ? 0 : 128);
#pragma unroll
          for (int jj = 0; jj < 8; ++jj) vin1[jj] = *(const v4u*)(Vg + (size_t)(grow2 + jj) * NIN); } }
    __syncthreads();
    const int qi = 16 * wave + fr;
    float rel0f = (float)(32 * p0 + 8 * fq - 128 - qi);
    asm volatile("" : "+v"(rel0f));
    const float pen0 = v0 ? 0.f : -1e30f, pen2 = v2 ? 0.f : -1e30f;
    const LAS unsigned char* kbase = lds + (32 * p0 + 8 * (fr >> 2) + (fr & 3)) * 256;
    const int swz = fq ^ fr;
    v4u pfA[9], pfB[9]; float invA, invB;
    attn_head_scores(kbase, qfA, swz, p0, rel0f, -__builtin_amdgcn_exp2f(-(float)(hA + 1)) * LOG2E, sink[hA] * LOG2E, pen0, pen2, pfA, invA);
    attn_head_scores(kbase, qfB, swz, p0, rel0f, -__builtin_amdgcn_exp2f(-(float)(hB + 1)) * LOG2E, sink[hB] * LOG2E, pen0, pen2, pfB, invB);
    __syncthreads();
    vt_write(lds, vin0, dblk, 128 * (tid >> 8) + 8 * sblk);
    if (wave < 4) vt_write(lds, vin1, dblk, 256 + 8 * sblk);
    __syncthreads();
    const LAS unsigned char* vbase = lds + fr * VT_PITCH + 64 * p0 + 16 * fq;
    bf16* Og = MIX + (size_t)(rowq0 + 16 * wave + fr) * DM + 128 * hA + 4 * fq;
    attn_head_pv(vbase, pfA, invA, Og);
    attn_head_pv(vbase, pfB, invB, Og + 128);
}

constexpr int GT_PITCH = 272, GT_BYTES = 128 * GT_PITCH;
__device__ __forceinline__ void sgu_pair(LAS unsigned char* lds, const bf16* H, bf16* MIX, const float* lng, const float* lnb, const bf16* wsb, const float* b_s, const float* gst, int gc, int gp) {
    int tid_ = threadIdx.x; asm volatile("" : "+v"(tid_));
    const int tid = tid_, lane = tid & 63, wave = __builtin_amdgcn_readfirstlane(tid >> 6);
    const int r0 = gc * 128, fr = lane & 15, fq = lane >> 4;
    __syncthreads();
    { const int gsel = tid >> 8, r = tid & 255, sblk = r >> 4, dblk = r & 15, g = 2 * gp + gsel, ch0 = 128 * g + 8 * dblk;
      const f32x4 ga = *(const f32x4*)(lng + ch0), gb = *(const f32x4*)(lng + ch0 + 4), ba = *(const f32x4*)(lnb + ch0), bb = *(const f32x4*)(lnb + ch0 + 4);
      const float gam[8] = {ga.x, ga.y, ga.z, ga.w, gb.x, gb.y, gb.z, gb.w}, bet[8] = {ba.x, ba.y, ba.z, ba.w, bb.x, bb.y, bb.z, bb.w};
      v4u in[8]; f32x2 st[8];
#pragma unroll
      for (int jj = 0; jj < 8; ++jj) { in[jj] = *(const v4u*)(H + (size_t)(r0 + 8 * sblk + jj) * NIN + COL_GV + ch0); st[jj] = *(const f32x2*)(gst + 2 * (size_t)(r0 + 8 * sblk + jj)); }
#pragma unroll
      for (int jj = 0; jj < 8; ++jj) { const float mean = st[jj].x * (1.f / 1024.f), var = fmaxf(st[jj].y * (1.f / 1024.f) - mean * mean, 0.f); st[jj].x = mean; st[jj].y = 1.f / sqrtf(var + LN_EPS); }
#pragma unroll
      for (int i = 0; i < 8; ++i) { v4u o;
#pragma unroll
          for (int t = 0; t < 4; ++t) { const unsigned a = in[2 * t][i >> 1], b = in[2 * t + 1][i >> 1];
              const float xa = (i & 1) ? bf_hi(a) : bf_lo(a), xb = (i & 1) ? bf_hi(b) : bf_lo(b);
              o[t] = cvt_pk_bf16((xa - st[2 * t].x) * st[2 * t].y * gam[i] + bet[i], (xb - st[2 * t + 1].x) * st[2 * t + 1].y * gam[i] + bet[i]); }
          *(LAS v4u*)(lds + gsel * GT_BYTES + (8 * dblk + i) * GT_PITCH + 16 * sblk) = o; } }
    const int gsel = wave >> 2, tq = wave & 3, g = 2 * gp + gsel;
    bf16x8 wf[2][4];
#pragma unroll
    for (int tt = 0; tt < 2; ++tt)
#pragma unroll
        for (int ks = 0; ks < 4; ++ks) wf[tt][ks] = *(const bf16x8*)(wsb + (size_t)(g * 128 + 32 * tq + 16 * tt + fr) * 128 + 32 * ks + 8 * fq);
    __syncthreads();
    v2u uv[8][2];
#pragma unroll
    for (int dt = 0; dt < 8; ++dt)
#pragma unroll
        for (int tt = 0; tt < 2; ++tt) uv[dt][tt] = *(const v2u*)(H + (size_t)(r0 + 32 * tq + 16 * tt + fr) * NIN + COL_U + 128 * g + 16 * dt + 4 * fq);
    const LAS unsigned char* Gb = lds + gsel * GT_BYTES + fr * GT_PITCH + 16 * fq;
    const float bias0 = b_s[g * 128 + 32 * tq + fr], bias1 = b_s[g * 128 + 32 * tq + 16 + fr];
#pragma unroll
    for (int dt = 0; dt < 8; ++dt) {
        f32x4 a0 = (f32x4){0.f, 0.f, 0.f, 0.f}, a1 = a0;
#pragma unroll
        for (int ks = 0; ks < 4; ++ks) { const bf16x8 gf = *(const LAS bf16x8*)(Gb + 16 * dt * GT_PITCH + 64 * ks);
            a0 = __builtin_amdgcn_mfma_f32_16x16x32_bf16(gf, wf[0][ks], a0, 0, 0, 0);
            a1 = __builtin_amdgcn_mfma_f32_16x16x32_bf16(gf, wf[1][ks], a1, 0, 0, 0); }
#pragma unroll
        for (int tt = 0; tt < 2; ++tt) { const int t = 32 * tq + 16 * tt + fr; const float bias = tt ? bias1 : bias0; const f32x4 a = tt ? a1 : a0;
            const v2u uu = uv[dt][tt];
            v2u w; w.x = cvt_pk_bf16(bf_lo(uu.x) * (a[0] + bias), bf_hi(uu.x) * (a[1] + bias)); w.y = cvt_pk_bf16(bf_lo(uu.y) * (a[2] + bias), bf_hi(uu.y) * (a[3] + bias));
            *(v2u*)(MIX + (size_t)(r0 + t) * DM + 1024 + 128 * g + 16 * dt + 4 * fq) = w; }
    }
}

#define XB_TMO      128
#define XB_XCNT(j)  (256  + 64 * (j))
#define XB_XSUB(j)  (1280 + 64 * (j))
#define XB_XGEN(j)  (2304 + 64 * (j))
#define XB_TOP      3328
#define XB_TOPGEN   3392
#define XCD_BAR_WORDS 3456
#define XB_SPIN_CAP (1u << 18)
__device__ __forceinline__ unsigned xb_ld(unsigned* p)              { return __hip_atomic_load(p, __ATOMIC_RELAXED, __HIP_MEMORY_SCOPE_AGENT); }
__device__ __forceinline__ unsigned xb_add(unsigned* p, unsigned v) { return __hip_atomic_fetch_add(p, v, __ATOMIC_RELAXED, __HIP_MEMORY_SCOPE_AGENT); }
__device__ __forceinline__ unsigned xb_xcc_id() { return (unsigned)__builtin_amdgcn_s_getreg((3 << 11) | 20) & 0xFu; }
#define XB_SPIN(cond, bar) do { unsigned _sp = 0; while (cond) { __builtin_amdgcn_s_sleep(1); \
    if ((++_sp & 255u) == 0u) { if (xb_ld(&(bar)[XB_TMO])) break; if (_sp > XB_SPIN_CAP) { atomicAdd(&(bar)[XB_TMO], 1u); break; } } } } while (0)
struct XcdBarrier { unsigned* bar; unsigned x; volatile LAS unsigned* st; };
__device__ __forceinline__ XcdBarrier xcd_barrier_post(unsigned* bar, volatile LAS unsigned* st) {
    XcdBarrier b; b.bar = bar; b.x = xb_xcc_id(); b.st = st;
    if (threadIdx.x == 0) (void)xb_add(&bar[XB_XCNT(b.x)], 1u);
    return b;
}
__device__ __forceinline__ void xcd_barrier_complete(unsigned* bar, unsigned x, unsigned& nloc, unsigned& nx) {
    const unsigned G = gridDim.x * gridDim.y * gridDim.z;
    unsigned sum, cnt, mine, sp = 0u;
    for (;;) {
        sum = 0u; cnt = 0u; mine = 0u;
#pragma unroll
        for (unsigned j = 0; j < 16; ++j) { const unsigned c = xb_ld(&bar[XB_XCNT(j)]); sum += c; cnt += (c > 0u) ? 1u : 0u; mine = (j == x) ? c : mine; }
        if (sum == G) break;
        __builtin_amdgcn_s_sleep(1);
        if ((++sp & 255u) == 0u) { if (xb_ld(&bar[XB_TMO])) break; if (sp > XB_SPIN_CAP) { atomicAdd(&bar[XB_TMO], 1u); break; } }
    }
    nloc = mine > 0u ? mine : 1u; nx = cnt > 0u ? cnt : 1u;
}
__device__ __forceinline__ void xcd_barrier(const XcdBarrier& b) {
    asm volatile("s_waitcnt vmcnt(0)" ::: "memory");
    __syncthreads();
    if (threadIdx.x == 0) {
        unsigned* bar = b.bar;
        __builtin_amdgcn_s_waitcnt(0);
        unsigned nloc = b.st[0], nx = b.st[1];
        if (nloc == 0u) { xcd_barrier_complete(bar, b.x, nloc, nx); b.st[0] = nloc; b.st[1] = nx; }
        const unsigned old = xb_add(&bar[XB_XSUB(b.x)], 1u);
        const unsigned gen = old / nloc;
        if (old + 1u == (gen + 1u) * nloc) {
            __builtin_amdgcn_fence(__ATOMIC_RELEASE, "agent");
            asm volatile("s_waitcnt vmcnt(0)" ::: "memory");
            const unsigned og = xb_add(&bar[XB_TOP], 1u);
            const unsigned tg = og / nx;
            if (og + 1u == (tg + 1u) * nx) xb_add(&bar[XB_TOPGEN], 1u);
            else XB_SPIN(xb_ld(&bar[XB_TOPGEN]) == tg, bar);
            __builtin_amdgcn_fence(__ATOMIC_ACQUIRE, "agent");
            xb_add(&bar[XB_XGEN(b.x)], 1u);
            asm volatile("s_waitcnt vmcnt(0)" ::: "memory");
        } else {
            XB_SPIN(xb_ld(&bar[XB_XGEN(b.x)]) == gen, bar);
            __builtin_amdgcn_fence(__ATOMIC_ACQUIRE, "agent");
            asm volatile("s_waitcnt vmcnt(0)" ::: "memory");
        }
    }
    __syncthreads();
}

#ifndef PH_MASK
#define PH_MASK 0xff
#endif
#ifndef DUP_MASK
#define DUP_MASK 0
#endif
#define GSYNC() xcd_barrier(xbar)
#define REP(k) for (int rep_ = 0; rep_ < (((DUP_MASK >> (k)) & 1) ? 2 : 1); ++rep_, (rep_ < (((DUP_MASK >> (k)) & 1) ? 2 : 1) ? GSYNC() : (void)0))
__global__ void __launch_bounds__(NTHR, 2) fwd_megakernel(Args args) {
    extern __shared__ __attribute__((aligned(16))) unsigned char lds_raw[];
    LAS unsigned char* lds = (LAS unsigned char*)lds_raw;
    const int tid = threadIdx.x, lane = tid & 63, wave = __builtin_amdgcn_readfirstlane(tid >> 6);
    const int G = gridDim.x, bx = blockIdx.x;
    const int vcu = (G % 8 == 0) ? (bx % 8) * (G / 8) + bx / 8 : bx;
    unsigned char* ws = args.ws;
    const float* xp = args.in[0]; const float* xs = args.in[1];
    const float* w_in = args.in[2]; const float* ln_sgu_g = args.in[3]; const float* ln_sgu_b = args.in[4]; const float* w_s = args.in[5]; const float* b_s = args.in[6];
    const float* sink = args.in[7]; const float* w_o = args.in[8]; const float* ln1_g = args.in[9]; const float* ln1_b = args.in[10];
    const float* w_gate = args.in[11]; const float* w_up = args.in[12]; const float* w_down = args.in[13]; const float* ln2_g = args.in[14]; const float* ln2_b = args.in[15];
    float* out = args.out;
    bf16* WIN_T = (bf16*)(ws + WS_WIN); bf16* WO_T = (bf16*)(ws + WS_WO); bf16* W13_T = (bf16*)(ws + WS_W13); bf16* W2_T = (bf16*)(ws + WS_W2);
    bf16* Y1B = (bf16*)out;
    bf16* Y2B = (bf16*)(ws + WS_XB);
    float* ST1 = (float*)(ws + WS_ST1); float* GST = (float*)(ws + WS_GST); bf16* WSB = (bf16*)(ws + WS_WSB);
    bf16* XB = (bf16*)(ws + WS_XB); bf16* Hb = (bf16*)(ws + WS_H); bf16* MIX = (bf16*)(ws + WS_MIX); bf16* HID = (bf16*)(ws + WS_HID);
    const int gw = vcu * NWAVES + wave, NGW = G * NWAVES;
    if (tid < 2) ((volatile LAS unsigned*)(lds + 131072 + 2048))[tid] = 0u;
    __syncthreads();
    const XcdBarrier xbar = xcd_barrier_post((unsigned*)(ws + WS_BAR), (volatile LAS unsigned*)(lds + 131072 + 2048));

    if constexpr ((PH_MASK & 1) != 0) {
        LAS float* scr = (LAS float*)(lds + wave * 16384);
        constexpr int I_IN = (DM / 64) * (NIN / 32);
        for (int it = gw; it < I_IN; it += NGW) { const int nb = it % (NIN / 32), kb = it / (NIN / 32); p0_transpose_item(w_in, DM, NIN, WIN_T, 32 * nb, 64 * kb, 32 * nb, scr, lane); }
        { const int gt = bx * NTHR + tid;
          if (gt < M * 2 / 4) ((f32x4*)GST)[gt] = (f32x4){0.f, 0.f, 0.f, 0.f};
          if (gt < 8 * 128 * 128 / 8) { const f32x4 a = *(const f32x4*)(w_s + 8 * gt), b = *(const f32x4*)(w_s + 8 * gt + 4);
              v4u w; w.x = cvt_pk_bf16(a.x, a.y); w.y = cvt_pk_bf16(a.z, a.w); w.z = cvt_pk_bf16(b.x, b.y); w.w = cvt_pk_bf16(b.z, b.w); *(v4u*)(WSB + 8 * gt) = w; } }
        const size_t n8 = (size_t)M * DM / 8, nthr = (size_t)G * NTHR;
        for (size_t i = (size_t)bx * NTHR + tid; i < n8; i += nthr) { const size_t e = i * 8;
            const float* src = (e < (size_t)MP * DM) ? xp + e : xs + (e - (size_t)MP * DM);
            const f32x4 a = __builtin_nontemporal_load((const f32x4*)src), b = __builtin_nontemporal_load((const f32x4*)(src + 4));
            v4u w; w.x = cvt_pk_bf16(a.x, a.y); w.y = cvt_pk_bf16(a.z, a.w); w.z = cvt_pk_bf16(b.x, b.y); w.w = cvt_pk_bf16(b.z, b.w);
            *(v4u*)(XB + e) = w; }
    }
    GSYNC();
    REP(1) if constexpr ((PH_MASK & 2) != 0) { pg8::Gemm g{XB, WIN_T, M, NIN, DM}; pg8::StaticOrder S; S.init(M, NIN, G, bx); EpiH E{Hb, GST};
      pg8::gemm_phase<EpiH, pg8::StaticOrder, true, true>(lds, g, S, E);
      const int nfull = (M / 256) * (NIN / 256) / G, nrem = (M / 256) * (NIN / 256) - nfull * G;
      if (bx >= nrem) {
          LAS float* scr = (LAS float*)(lds + wave * 16384);
          constexpr int I_O = (DM / 64) * (DM / 32), I_G = (DM / 64) * (DFF / 32);
          const int cw = (bx - nrem) * NWAVES + wave, NCW = (G - nrem) * NWAVES;
          for (int it = cw; it < I_O + 2 * I_G; it += NCW) {
              int r = it;
              if (r < I_O) { const int nb = r % (DM / 32), kb = r / (DM / 32); p0_transpose_item(w_o, DM, DM, WO_T, 32 * nb, 64 * kb, 32 * nb, scr, lane); continue; } r -= I_O;
              if (r < 2 * I_G) { const int up = r >= I_G ? 1 : 0; if (up) r -= I_G; const int nb = r % (DFF / 32), kb = r / (DFF / 32), n0 = 32 * nb;
                  p0_transpose_item(up ? w_up : w_gate, DM, DFF, W13_T, (n0 >> 7) * 256 + up * 128 + (n0 & 127), 64 * kb, n0, scr, lane); }
          }
      } }
    GSYNC();
    REP(2) if constexpr ((PH_MASK & 4) != 0) {
      for (int it = vcu; it < NGC * 8; it += G) {
#ifndef NO_ATTN
        if (it < NGC * 4) { attn_unit(lds, Hb, MIX, sink, it >> 2, (it >> 1) & 1, it & 1); if (DUP_MASK & 64) attn_unit(lds, Hb, MIX, sink, it >> 2, (it >> 1) & 1, it & 1); }
#endif
#ifndef NO_SGU
        if (it >= NGC * 4) { const int a = it - NGC * 4; sgu_pair(lds, Hb, MIX, ln_sgu_g, ln_sgu_b, WSB, b_s, GST, a >> 2, a & 3); if (DUP_MASK & 128) sgu_pair(lds, Hb, MIX, ln_sgu_g, ln_sgu_b, WSB, b_s, GST, a >> 2, a & 3); }
#endif
    } }
    GSYNC();
    REP(3) if constexpr ((PH_MASK & 8) != 0) { pg8::Gemm g{MIX, WO_T, M, DM, DM}; pg8::StaticOrder S; S.init(M, DM, G, bx); EpiY1 E{XB, Y1B};
      pg8::gemm_phase<EpiY1, pg8::StaticOrder, true, true>(lds, g, S, E); }
    GSYNC();
    REP(4) if constexpr ((PH_MASK & 16) != 0) ln_rows<false>(Y1B, nullptr, XB, ln1_g, ln1_b, gw, NGW, lane);
    GSYNC();
    REP(5) if constexpr ((PH_MASK & 32) != 0) { pg8::Gemm g{XB, W13_T, M, 2 * DFF, DM}; pg8::StaticOrder S; S.init(M, 2 * DFF, G, bx); EpiHid E{HID};
      pg8::gemm_phase<EpiHid, pg8::StaticOrder, true, true>(lds, g, S, E);
      const int units4 = (M / 256) * (2 * DFF / 256), nrem4 = units4 - (units4 / G) * G;
      if (bx >= nrem4) {
          LAS float* scr = (LAS float*)(lds + wave * 16384);
          constexpr int I_D = (DFF / 64) * (DM / 32);
          const int cw = (bx - nrem4) * NWAVES + wave, NCW = (G - nrem4) * NWAVES;
          for (int it = cw; it < I_D; it += NCW) { const int nb = it % (DM / 32), kb = it / (DM / 32); p0_transpose_item(w_down, DFF, DM, W2_T, 32 * nb, 64 * kb, 32 * nb, scr, lane); }
      } }
    GSYNC();
    if constexpr ((PH_MASK & 64) != 0) { pg8::Gemm g{HID, W2_T, M, DM, DFF}; pg8::StaticOrder S; S.init(M, DM, G, bx); EpiY2 E{XB};
      pg8::gemm_phase<EpiY2, pg8::StaticOrder, true, true>(lds, g, S, E); }
    GSYNC();
#ifdef SYNC_PROBE
    for (int i = 0; i < 16; ++i) GSYNC();
#endif
    if constexpr ((PH_MASK & 128) != 0) ln_rows<true>(Y2B, out, nullptr, ln2_g, ln2_b, gw, NGW, lane);
}

extern "C" void kernel_launch(void* const* d_in, const int* in_sizes, int n_in, void* d_out, int out_size, void* d_ws, size_t ws_size, hipStream_t stream) {
    static int grid = 0;
    if (grid == 0) {
        if (n_in != 16 || out_size != M * DM || ws_size < WS_END) { fprintf(stderr, "kernel_launch: unexpected shapes (n_in %d, out %d, ws %zu)\n", n_in, out_size, ws_size); grid = -1; return; }
        int dev = 0, cus = 0, per_cu = 0;
        hipGetDevice(&dev);
        hipDeviceGetAttribute(&cus, hipDeviceAttributeMultiprocessorCount, dev);
        if (hipFuncSetAttribute((const void*)fwd_megakernel, hipFuncAttributeMaxDynamicSharedMemorySize, LDS_BYTES) != hipSuccess) { fprintf(stderr, "kernel_launch: hipFuncSetAttribute failed\n"); grid = -1; return; }
        if (hipOccupancyMaxActiveBlocksPerMultiprocessor(&per_cu, (const void*)fwd_megakernel, NTHR, LDS_BYTES) != hipSuccess || per_cu < 1) { fprintf(stderr, "kernel_launch: occupancy query says %d workgroups per CU; nothing launched\n", per_cu); grid = -1; return; }
        grid = cus;
        fprintf(stderr, "kernel_launch: grid %d (cus %d, per_cu %d)\n", grid, cus, per_cu);
    }
    if (grid < 0) return;
    if (hipMemsetAsync((unsigned char*)d_ws + WS_BAR, 0, XCD_BAR_WORDS * 4, stream) != hipSuccess) { fprintf(stderr, "kernel_launch: hipMemsetAsync failed\n"); return; }
    Args a{};
    for (int i = 0; i < 16; ++i) a.in[i] = (const float*)d_in[i];
    a.out = (float*)d_out; a.ws = (unsigned char*)d_ws;
    void* kargs[] = {&a};
    hipError_t e = hipLaunchCooperativeKernel((const void*)fwd_megakernel, dim3(grid), dim3(NTHR), kargs, LDS_BYTES, stream);
    if (e != hipSuccess) fprintf(stderr, "kernel_launch: cooperative launch failed: %s (grid %d)\n", hipGetErrorString(e), grid);
}
```

```cpp
#include <hip/hip_runtime.h>
#include <hip/hip_cooperative_groups.h>
#include <cstdio>
#include <cstdint>
namespace cg = cooperative_groups;

namespace pg8 {
#define PG8_LAS __attribute__((address_space(3)))
typedef unsigned short bf16_t;
typedef short bf16x8 __attribute__((ext_vector_type(8)));
typedef float f32x4 __attribute__((ext_vector_type(4)));
typedef unsigned u32x4 __attribute__((ext_vector_type(4)));
constexpr int BM = 256, BK = 64, HALF = 128, HTB = HALF * BK * 2  , STAGE_BYTES = 8 * HTB, NXCD = 8, WGM = 8;

__host__ __device__ __forceinline__ int lds_byte(int r, int c) { const int st = (r >> 4) * 2 + (c >> 5), rr = r & 15, cc = c & 31, ob = rr * 64 + cc * 2; return st * 1024 + (ob ^ (((ob >> 9) & 1) << 5)); }
__host__ __device__ __forceinline__ void stage_rc(int b, int& R, int& C) { const int st = b / 1024, sb = b % 1024, swz = sb ^ (((sb >> 9) & 1) << 5); R = (st >> 1) * 16 + swz / 64; C = (st & 1) * 32 + (swz % 64) / 2; }
__host__ __device__ __forceinline__ int perm32(int rho) { const int n = rho >> 4, i = rho & 15; return 8 * (i >> 2) + 4 * n + (i & 3); }

struct Unit { int pm, pn; };
struct Gemm { const bf16_t* A; const bf16_t* Bt; int M, N, K; };

struct StaticOrder {
    int nM, nN, nwg, G, c;
    __host__ __device__ void init(int M, int N, int G_, int c_) { nM = M / BM; nN = N / BM; nwg = nM * nN; G = G_; c = c_; }
    __host__ __device__ bool next(int i, Unit& u) const {
        const long L = (long)i * G + c; if (L >= nwg) return false;
        int wgid = (int)L; { const int q = nwg / NXCD, r = nwg % NXCD, xcd = wgid % NXCD, off = wgid / NXCD; wgid = (xcd < r ? xcd * (q + 1) : r * (q + 1) + (xcd - r) * q) + off; }
        const int nig = WGM * nN, gid = wgid / nig, fm = gid * WGM, gsz = (nM - fm) < WGM ? (nM - fm) : WGM;
        u.pm = fm + ((wgid % nig) % gsz); u.pn = (wgid % nig) / gsz; return true;
    }
    __device__ __forceinline__ void a_ready(const Unit&) const {}
    __device__ __forceinline__ void done(const Unit&) const {}
};

__device__ __forceinline__ unsigned cvt_pk_bf16(float lo, float hi) { unsigned r; asm("v_cvt_pk_bf16_f32 %0, %1, %2" : "=v"(r) : "v"(lo), "v"(hi)); return r; }

template <class Epi, class Sched, bool ALIGN_EPI = false, bool SP2 = false>
__device__ __forceinline__ void gemm_phase(PG8_LAS unsigned char* lds, const Gemm g, const Sched& S, const Epi& E) {
    int tid_ = threadIdx.x; asm volatile("" : "+v"(tid_));
    const int tid = tid_, wid = __builtin_amdgcn_readfirstlane(tid >> 6), lane = tid & 63, wr = wid >> 2, wc = wid & 3, fr = lane & 15, fq = lane >> 4;
    const int K = g.K, nt = K / BK;
    unsigned voffA[2], voffB[2];
#pragma unroll
    for (int i = 0; i < 2; ++i) { int R, C; stage_rc(tid * 16 + i * 8192, R, C); const int Rb = Epi::PERM ? ((R & ~31) + perm32(R & 31)) : R;
        voffA[i] = (unsigned)(R * K + C) * 2u; voffB[i] = (unsigned)(Rb * K + C) * 2u; }
    const size_t kstep = (size_t)(BK * 2);
    const size_t hstep = (size_t)HALF * K * 2;
    const size_t tstep = 2 * hstep;
    const unsigned ldsw = (unsigned)wid * 1024u;
    const int aoff = lds_byte(wr * 64 + fr, fq * 8), boff = lds_byte(wc * 32 + fr, fq * 8);
#define PG8_SA(b, h) (((b) * 2 + (h)) * HTB)
#define PG8_SB(b, h) ((4 + (b) * 2 + (h)) * HTB)
#define PG8_STAGE(bufoff, gbase, voff) do { _Pragma("unroll") for (int _i = 0; _i < 2; ++_i) \
        __builtin_amdgcn_global_load_lds((const unsigned*)((const char*)(gbase) + (voff)[_i]), (PG8_LAS unsigned*)(lds + (bufoff) + ldsw + _i * 8192), 16, 0, 0); } while (0)
#define PG8_LDA(dst, b, h) do { _Pragma("unroll") for (int m = 0; m < 4; ++m) _Pragma("unroll") for (int k = 0; k < 2; ++k) dst[m][k] = *(const PG8_LAS bf16x8*)(lds + PG8_SA(b, h) + aoff + m * 2048 + k * 1024); } while (0)
#define PG8_LDB(dst, b, h) do { _Pragma("unroll") for (int n = 0; n < 2; ++n) _Pragma("unroll") for (int k = 0; k < 2; ++k) dst[n][k] = *(const PG8_LAS bf16x8*)(lds + PG8_SB(b, h) + boff + n * 2048 + k * 1024); } while (0)
#define PG8_MMA(ai, bj, At, Bt) do { __builtin_amdgcn_s_setprio(1); _Pragma("unroll") for (int m = 0; m < 4; ++m) _Pragma("unroll") for (int n = 0; n < 2; ++n) _Pragma("unroll") for (int k = 0; k < 2; ++k) \
        acc[ai][bj][m][n] = __builtin_amdgcn_mfma_f32_16x16x32_bf16(Bt[n][k], At[m][k], acc[ai][bj][m][n], 0, 0, 0); __builtin_amdgcn_s_setprio(0); } while (0)
#define PG8_WAIT_V(n) asm volatile("s_waitcnt vmcnt(" #n ")" ::: "memory")
#define PG8_WAIT_L(n) asm volatile("s_waitcnt lgkmcnt(" #n ")" ::: "memory")
#define PG8_BAR __builtin_amdgcn_s_barrier()
#define PG8_SCHED __builtin_amdgcn_sched_barrier(0)
    Unit cur, nxt; int ui = 0;
    if (!S.next(0, cur)) return;
    f32x4 acc[2][2][4][2];
#pragma unroll
    for (int a = 0; a < 2; ++a)
#pragma unroll
        for (int b = 0; b < 2; ++b)
#pragma unroll
            for (int m = 0; m < 4; ++m)
#pragma unroll
                for (int n = 0; n < 2; ++n) acc[a][b][m][n] = (f32x4){0.f, 0.f, 0.f, 0.f};
    bf16x8 At[4][2], B0[2][2], B1[2][2];
    const char* cA = (const char*)g.A + (size_t)cur.pm * tstep; const char* cB = (const char*)g.Bt + (size_t)cur.pn * tstep;
    S.a_ready(cur);
    if constexpr (SP2) {
        PG8_STAGE(PG8_SB(0, 0), cB, voffB); PG8_STAGE(PG8_SB(0, 1), cB + hstep, voffB); PG8_STAGE(PG8_SA(0, 0), cA, voffA); PG8_STAGE(PG8_SA(0, 1), cA + hstep, voffA);
        if (wr == 1) PG8_BAR;
        PG8_WAIT_V(2); PG8_BAR;
        PG8_STAGE(PG8_SB(1, 0), cB + kstep, voffB); PG8_STAGE(PG8_SA(1, 0), cA + kstep, voffA); PG8_STAGE(PG8_SB(1, 1), cB + hstep + kstep, voffB);
        PG8_WAIT_V(6); PG8_BAR;
    } else {
        PG8_STAGE(PG8_SB(0, 0), cB, voffB); PG8_STAGE(PG8_SA(0, 0), cA, voffA); PG8_STAGE(PG8_SB(0, 1), cB + hstep, voffB); PG8_STAGE(PG8_SA(0, 1), cA + hstep, voffA);
        if (wr == 1) PG8_BAR;
        PG8_WAIT_V(4); PG8_BAR;
        PG8_STAGE(PG8_SB(1, 0), cB + kstep, voffB); PG8_STAGE(PG8_SA(1, 0), cA + kstep, voffA); PG8_STAGE(PG8_SB(1, 1), cB + hstep + kstep, voffB);
        PG8_WAIT_V(6); PG8_BAR;
    }
    for (;;) {
        const bool has_next = S.next(ui + 1, nxt);
        const char* nA = has_next ? (const char*)g.A + (size_t)nxt.pm * tstep : cA; const char* nB = has_next ? (const char*)g.Bt + (size_t)nxt.pn * tstep : cB;
        for (int t = 0; t < nt; t += 2) {
            const bool last = (t == nt - 2);
            const char* a1 = cA + (size_t)(t + 1) * kstep;
            const char* a2 = last ? nA : cA + (size_t)(t + 2) * kstep; const char* b2 = last ? nB : cB + (size_t)(t + 2) * kstep;
            const char* a3 = a2 + kstep; const char* b3 = b2 + kstep;
            if (last && has_next) S.a_ready(nxt);
            if constexpr (SP2) {
            PG8_LDB(B0, 0, 0); PG8_LDB(B1, 0, 1); PG8_SCHED; PG8_LDA(At, 0, 0); PG8_STAGE(PG8_SA(1, 1), a1 + hstep, voffA);
            PG8_WAIT_V(8); PG8_WAIT_L(0); PG8_BAR; PG8_MMA(0, 0, At, B0); PG8_MMA(0, 1, At, B1); PG8_BAR; PG8_SCHED;
            PG8_LDA(At, 0, 1); PG8_STAGE(PG8_SB(0, 0), b2, voffB); PG8_STAGE(PG8_SB(0, 1), b2 + hstep, voffB); PG8_STAGE(PG8_SA(0, 0), a2, voffA);
            PG8_WAIT_V(8); PG8_WAIT_L(0); PG8_BAR; PG8_MMA(1, 0, At, B0); PG8_MMA(1, 1, At, B1); PG8_BAR; PG8_SCHED;
            PG8_LDB(B0, 1, 0); PG8_LDB(B1, 1, 1); PG8_SCHED; PG8_LDA(At, 1, 0); PG8_STAGE(PG8_SA(0, 1), a2 + hstep, voffA);
            PG8_WAIT_V(8); PG8_WAIT_L(0); PG8_BAR; PG8_MMA(0, 0, At, B0); PG8_MMA(0, 1, At, B1); PG8_BAR; PG8_SCHED;
            PG8_LDA(At, 1, 1); PG8_STAGE(PG8_SB(1, 0), b3, voffB); PG8_STAGE(PG8_SB(1, 1), b3 + hstep, voffB); PG8_STAGE(PG8_SA(1, 0), a3, voffA);
            PG8_WAIT_V(8); PG8_WAIT_L(0); PG8_BAR; PG8_MMA(1, 0, At, B0); PG8_MMA(1, 1, At, B1); PG8_BAR; PG8_SCHED;
            } else {
            PG8_LDB(B0, 0, 0); PG8_SCHED; PG8_LDA(At, 0, 0); PG8_STAGE(PG8_SA(1, 1), a1 + hstep, voffA);
            PG8_WAIT_L(8); PG8_BAR; PG8_WAIT_L(0); PG8_MMA(0, 0, At, B0); PG8_BAR; PG8_SCHED;
            PG8_LDB(B1, 0, 1); PG8_STAGE(PG8_SB(0, 0), b2, voffB);
            PG8_BAR; PG8_WAIT_L(0); PG8_MMA(0, 1, At, B1); PG8_BAR;
            PG8_LDA(At, 0, 1); PG8_STAGE(PG8_SA(0, 0), a2, voffA);
            PG8_BAR; PG8_WAIT_L(0); PG8_MMA(1, 0, At, B0); PG8_BAR; PG8_SCHED;
            PG8_STAGE(PG8_SB(0, 1), b2 + hstep, voffB);
            PG8_WAIT_V(6); PG8_BAR; PG8_MMA(1, 1, At, B1); PG8_BAR;
            PG8_LDB(B0, 1, 0); PG8_SCHED; PG8_LDA(At, 1, 0); PG8_STAGE(PG8_SA(0, 1), a2 + hstep, voffA);
            PG8_WAIT_L(8); PG8_BAR; PG8_WAIT_L(0); PG8_MMA(0, 0, At, B0); PG8_BAR; PG8_SCHED;
            PG8_LDB(B1, 1, 1); PG8_STAGE(PG8_SB(1, 0), b3, voffB);
            PG8_BAR; PG8_WAIT_L(0); PG8_MMA(0, 1, At, B1); PG8_BAR;
            PG8_LDA(At, 1, 1); PG8_STAGE(PG8_SA(1, 0), a3, voffA);
            PG8_BAR; PG8_WAIT_L(0); PG8_MMA(1, 0, At, B0); PG8_BAR; PG8_SCHED;
            PG8_STAGE(PG8_SB(1, 1), b3 + hstep, voffB);
            PG8_WAIT_V(6); PG8_BAR; PG8_MMA(1, 1, At, B1); PG8_BAR;
            }
        }
        if constexpr (ALIGN_EPI) { if (wr == 0) PG8_BAR; }
        E(acc, cur, wr, wc, fr, fq); S.done(cur);
        if (!has_next) break;
#pragma unroll
        for (int a = 0; a < 2; ++a)
#pragma unroll
            for (int b = 0; b < 2; ++b)
#pragma unroll
                for (int m = 0; m < 4; ++m)
#pragma unroll
                    for (int n = 0; n < 2; ++n) acc[a][b][m][n] = (f32x4){0.f, 0.f, 0.f, 0.f};
        cur = nxt; cA = nA; cB = nB; ++ui;
        if constexpr (ALIGN_EPI) { if (wr == 1) PG8_BAR; }
    }
    PG8_WAIT_V(0);
    if constexpr (!ALIGN_EPI) { if (wr == 0) PG8_BAR; }
    PG8_BAR;
#undef PG8_SA
#undef PG8_SB
#undef PG8_STAGE
#undef PG8_LDA
#undef PG8_LDB
#undef PG8_MMA
#undef PG8_WAIT_V
#undef PG8_WAIT_L
#undef PG8_BAR
#undef PG8_SCHED
}
}

constexpr int NWAVES = 8, NTHR = 512;
constexpr int M = 24576, MP = 16384, DM = 2048, NIN = 3584, DFF = 5632;
constexpr int COL_K = 1024, COL_V = 1280, COL_U = 1536, COL_GV = 2560;
constexpr int NGC = 192;
constexpr float LN_EPS = 1e-5f;
constexpr float ALPHA = 1.189207115002721f;
constexpr float LOG2E = 1.4426950408889634f;

constexpr size_t MiB = 1u << 20;
constexpr size_t WS_WSB = 0, WS_GST = 512 * 1024, WS_BAR = 768 * 1024;
constexpr size_t WS_WIN = 1 * MiB, WS_WO = 15 * MiB, WS_W13 = 23 * MiB, WS_W2 = 67 * MiB, WS_ST1 = 89 * MiB;
constexpr size_t WS_XB = 90 * MiB;
constexpr size_t WS_H = 186 * MiB;
constexpr size_t WS_MIX = 354 * MiB;
constexpr size_t WS_HID = 186 * MiB;
constexpr size_t WS_END = 450 * MiB;
static_assert(WS_H + (size_t)M * NIN * 2 == WS_MIX && WS_MIX + (size_t)M * DM * 2 == WS_END && WS_HID + (size_t)M * DFF * 2 == WS_END, "ws map");

constexpr int LDS_BYTES = 131072 + 4096;

#define GAS __attribute__((address_space(1)))
#define LAS __attribute__((address_space(3)))
typedef unsigned short bf16;
typedef unsigned v4u __attribute__((ext_vector_type(4)));
typedef unsigned v2u __attribute__((ext_vector_type(2)));
typedef float f32x4 __attribute__((ext_vector_type(4)));
typedef float f32x2 __attribute__((ext_vector_type(2)));
typedef short bf16x8 __attribute__((ext_vector_type(8)));
using pg8::cvt_pk_bf16;
#define LDS_WAIT() asm volatile("s_waitcnt lgkmcnt(0)" ::: "memory")
__device__ __forceinline__ float bf_lo(unsigned w) { return __uint_as_float(w << 16); }
__device__ __forceinline__ float bf_hi(unsigned w) { return __uint_as_float(w & 0xffff0000u); }
__device__ __forceinline__ float wave_sum(float v) {
#pragma unroll
    for (int o = 1; o < 64; o <<= 1) v += __shfl_xor(v, o);
    return v;
}
__device__ __forceinline__ float gelu_tanh(float x) {
    const float t = x * (-2.3022082f + (-0.10294324f) * x * x);
    return x * __builtin_amdgcn_rcpf(1.0f + __builtin_amdgcn_exp2f(t));
}
__device__ __forceinline__ float silu_f(float x) { return x * __builtin_amdgcn_rcpf(1.0f + __builtin_amdgcn_exp2f(-LOG2E * x)); }
__device__ __forceinline__ f32x2 gelu_tanh2(f32x2 x) {
    const f32x2 t = x * ((x * x) * (-0.10294324f) + (-2.3022082f));
    f32x2 e; e.x = __builtin_amdgcn_exp2f(t.x); e.y = __builtin_amdgcn_exp2f(t.y);
    const f32x2 d = e + 1.0f; f32x2 r; r.x = __builtin_amdgcn_rcpf(d.x); r.y = __builtin_amdgcn_rcpf(d.y);
    return x * r;
}
__device__ __forceinline__ f32x2 silu_mul2(f32x2 g, f32x2 u) {
    const f32x2 t = g * (-LOG2E);
    f32x2 e; e.x = __builtin_amdgcn_exp2f(t.x); e.y = __builtin_amdgcn_exp2f(t.y);
    const f32x2 d = e + 1.0f; f32x2 r; r.x = __builtin_amdgcn_rcpf(d.x); r.y = __builtin_amdgcn_rcpf(d.y);
    return (g * r) * u;
}

struct EpiH {
    static constexpr bool PERM = true;
    bf16* O; float* gst;
    __device__ __forceinline__ void operator()(const f32x4 (&acc)[2][2][4][2], const pg8::Unit& u, int wr, int wc, int fr, int fq) const {
        const int row0 = u.pm * 256 + wr * 64 + fr, col0 = u.pn * 256 + wc * 32 + 8 * fq;
        const bool act = u.pn >= 6, stat = u.pn >= 10;
#pragma unroll
        for (int ai = 0; ai < 2; ++ai)
#pragma unroll
            for (int m = 0; m < 4; ++m) { bf16* rowp = O + (size_t)(row0 + ai * 128 + m * 16) * NIN + col0;
                float rs = 0.f, rq = 0.f;
#pragma unroll
                for (int bj = 0; bj < 2; ++bj) { f32x4 v0 = acc[ai][bj][m][0], v1 = acc[ai][bj][m][1];
                    if (act) { const f32x2 a = gelu_tanh2((f32x2){v0[0], v0[1]}), b = gelu_tanh2((f32x2){v0[2], v0[3]}), c = gelu_tanh2((f32x2){v1[0], v1[1]}), d = gelu_tanh2((f32x2){v1[2], v1[3]});
                        v0 = (f32x4){a.x, a.y, b.x, b.y}; v1 = (f32x4){c.x, c.y, d.x, d.y}; }
                    v4u w; w.x = cvt_pk_bf16(v0[0], v0[1]); w.y = cvt_pk_bf16(v0[2], v0[3]); w.z = cvt_pk_bf16(v1[0], v1[1]); w.w = cvt_pk_bf16(v1[2], v1[3]);
                    *(v4u*)(rowp + bj * 128) = w;
                    if (stat) {
#pragma unroll
                        for (int t = 0; t < 4; ++t) { const float a = bf_lo(w[t]), b = bf_hi(w[t]); rs += a + b; rq += a * a + b * b; } } }
                if (stat) { rs += __shfl_xor(rs, 16); rs += __shfl_xor(rs, 32); rq += __shfl_xor(rq, 16); rq += __shfl_xor(rq, 32);
                    if (fq == 0) { float* gp = gst + 2 * (size_t)(row0 + ai * 128 + m * 16); __hip_atomic_fetch_add(gp, rs, __ATOMIC_RELAXED, __HIP_MEMORY_SCOPE_AGENT); __hip_atomic_fetch_add(gp + 1, rq, __ATOMIC_RELAXED, __HIP_MEMORY_SCOPE_AGENT); } } }
    }
};
struct EpiY1 {
    static constexpr bool PERM = true;
    const bf16* X; bf16* Y;
    __device__ __forceinline__ void operator()(const f32x4 (&acc)[2][2][4][2], const pg8::Unit& u, int wr, int wc, int fr, int fq) const {
        const int row0 = u.pm * 256 + wr * 64 + fr, col0 = u.pn * 256 + wc * 32 + 8 * fq;
#pragma unroll
        for (int ai = 0; ai < 2; ++ai) {
            v4u xv[4][2];
#pragma unroll
            for (int m = 0; m < 4; ++m) { const size_t off = (size_t)(row0 + ai * 128 + m * 16) * DM + col0;
#pragma unroll
                for (int bj = 0; bj < 2; ++bj) xv[m][bj] = __builtin_nontemporal_load((const v4u*)(X + off + bj * 128)); }
            asm volatile("" ::: "memory");
#pragma unroll
            for (int m = 0; m < 4; ++m) { const size_t off = (size_t)(row0 + ai * 128 + m * 16) * DM + col0;
#pragma unroll
                for (int bj = 0; bj < 2; ++bj) { const v4u xw = xv[m][bj];
                    const f32x4 xa = (f32x4){bf_lo(xw.x), bf_hi(xw.x), bf_lo(xw.y), bf_hi(xw.y)}, xb = (f32x4){bf_lo(xw.z), bf_hi(xw.z), bf_lo(xw.w), bf_hi(xw.w)};
                    const f32x4 y0 = xa * ALPHA + acc[ai][bj][m][0], y1 = xb * ALPHA + acc[ai][bj][m][1];
                    v4u w; w.x = cvt_pk_bf16(y0[0], y0[1]); w.y = cvt_pk_bf16(y0[2], y0[3]); w.z = cvt_pk_bf16(y1[0], y1[1]); w.w = cvt_pk_bf16(y1[2], y1[3]);
                    *(v4u*)(Y + off + bj * 128) = w; } }
            asm volatile("" ::: "memory"); }
    }
};
struct EpiHid {
    static constexpr bool PERM = true;
    bf16* O;
    __device__ __forceinline__ void operator()(const f32x4 (&acc)[2][2][4][2], const pg8::Unit& u, int wr, int wc, int fr, int fq) const {
        const int row0 = u.pm * 256 + wr * 64 + fr, col0 = u.pn * 128 + wc * 32 + 8 * fq;
#pragma unroll
        for (int ai = 0; ai < 2; ++ai)
#pragma unroll
            for (int m = 0; m < 4; ++m) {
                const f32x4 g0 = acc[ai][0][m][0], g1 = acc[ai][0][m][1], u0 = acc[ai][1][m][0], u1 = acc[ai][1][m][1];
                const f32x2 ha = silu_mul2((f32x2){g0[0], g0[1]}, (f32x2){u0[0], u0[1]}), hb = silu_mul2((f32x2){g0[2], g0[3]}, (f32x2){u0[2], u0[3]});
                const f32x2 hc = silu_mul2((f32x2){g1[0], g1[1]}, (f32x2){u1[0], u1[1]}), hd = silu_mul2((f32x2){g1[2], g1[3]}, (f32x2){u1[2], u1[3]});
                v4u w; w.x = cvt_pk_bf16(ha.x, ha.y); w.y = cvt_pk_bf16(hb.x, hb.y); w.z = cvt_pk_bf16(hc.x, hc.y); w.w = cvt_pk_bf16(hd.x, hd.y);
                *(v4u*)(O + (size_t)(row0 + ai * 128 + m * 16) * DFF + col0) = w; }
    }
};
struct EpiY2 {
    static constexpr bool PERM = true;
    bf16* X;
    __device__ __forceinline__ void operator()(const f32x4 (&acc)[2][2][4][2], const pg8::Unit& u, int wr, int wc, int fr, int fq) const {
        const int row0 = u.pm * 256 + wr * 64 + fr, col0 = u.pn * 256 + wc * 32 + 8 * fq;
#pragma unroll
        for (int ai = 0; ai < 2; ++ai) {
            v4u xv[4][2];
#pragma unroll
            for (int m = 0; m < 4; ++m) { const size_t off = (size_t)(row0 + ai * 128 + m * 16) * DM + col0;
#pragma unroll
                for (int bj = 0; bj < 2; ++bj) xv[m][bj] = __builtin_nontemporal_load((const v4u*)(X + off + bj * 128)); }
            asm volatile("" ::: "memory");
#pragma unroll
            for (int m = 0; m < 4; ++m) { const size_t off = (size_t)(row0 + ai * 128 + m * 16) * DM + col0;
#pragma unroll
                for (int bj = 0; bj < 2; ++bj) { const v4u xw = xv[m][bj];
                    const f32x4 xa = (f32x4){bf_lo(xw.x), bf_hi(xw.x), bf_lo(xw.y), bf_hi(xw.y)}, xb = (f32x4){bf_lo(xw.z), bf_hi(xw.z), bf_lo(xw.w), bf_hi(xw.w)};
                    const f32x4 o0 = xa * ALPHA + acc[ai][bj][m][0], o1 = xb * ALPHA + acc[ai][bj][m][1];
                    v4u w; w.x = cvt_pk_bf16(o0[0], o0[1]); w.y = cvt_pk_bf16(o0[2], o0[3]); w.z = cvt_pk_bf16(o1[0], o1[1]); w.w = cvt_pk_bf16(o1[2], o1[3]);
                    *(v4u*)(X + off + bj * 128) = w; } }
            asm volatile("" ::: "memory"); }
    }
};

__device__ __forceinline__ void p0_transpose_item(const float* W, int K, int N, bf16* WT, int drow0, int k0, int n0, LAS float* scr, int lane) {
    float v[32];
    const float* wp = W + (size_t)(k0 + (lane >> 5)) * N + n0 + (lane & 31);
#pragma unroll
    for (int i = 0; i < 32; ++i) v[i] = __builtin_nontemporal_load(wp + (size_t)(2 * i) * N);
#pragma unroll
    for (int i = 0; i < 32; ++i) scr[(2 * i + (lane >> 5)) * 33 + (lane & 31)] = v[i];
    LDS_WAIT(); asm volatile("" ::: "memory");
    const int c = lane & 7;
#pragma unroll
    for (int j = 0; j < 4; ++j) { const int n = (lane >> 3) + 8 * j; const LAS float* s = scr + (8 * c) * 33 + n;
        v4u o; o.x = cvt_pk_bf16(s[0 * 33], s[1 * 33]); o.y = cvt_pk_bf16(s[2 * 33], s[3 * 33]); o.z = cvt_pk_bf16(s[4 * 33], s[5 * 33]); o.w = cvt_pk_bf16(s[6 * 33], s[7 * 33]);
        *(v4u*)(WT + (size_t)(drow0 + n) * K + k0 + 8 * c) = o; }
    LDS_WAIT(); asm volatile("" ::: "memory");
}

struct Args { const float* in[16]; float* out; unsigned char* ws; };

template <bool FINAL>
__device__ __forceinline__ void ln_rows(const bf16* src, float* dstf, bf16* dstb, const float* g, const float* b, int gw, int NGW, int lane) {
    f32x4 gg[8], bb[8];
#pragma unroll
    for (int j = 0; j < 4; ++j) { gg[2 * j] = ((const f32x4*)g)[2 * (lane + 64 * j)]; gg[2 * j + 1] = ((const f32x4*)g)[2 * (lane + 64 * j) + 1];
        bb[2 * j] = ((const f32x4*)b)[2 * (lane + 64 * j)]; bb[2 * j + 1] = ((const f32x4*)b)[2 * (lane + 64 * j) + 1]; }
    for (int m = 2 * gw; m < M; m += 2 * NGW) {
        const v4u* xr = (const v4u*)(src + (size_t)m * DM) + lane;
        v4u raw[2][4];
#pragma unroll
        for (int r = 0; r < 2; ++r)
#pragma unroll
            for (int j = 0; j < 4; ++j) raw[r][j] = __builtin_nontemporal_load(&xr[r * 256 + 64 * j]);
        f32x4 v[2][8]; float s[2] = {0.f, 0.f};
#pragma unroll
        for (int r = 0; r < 2; ++r)
#pragma unroll
            for (int j = 0; j < 4; ++j) { v[r][2 * j] = (f32x4){bf_lo(raw[r][j].x), bf_hi(raw[r][j].x), bf_lo(raw[r][j].y), bf_hi(raw[r][j].y)}; v[r][2 * j + 1] = (f32x4){bf_lo(raw[r][j].z), bf_hi(raw[r][j].z), bf_lo(raw[r][j].w), bf_hi(raw[r][j].w)}; }
#pragma unroll
        for (int r = 0; r < 2; ++r)
#pragma unroll
            for (int j = 0; j < 8; ++j) s[r] += (v[r][j].x + v[r][j].y) + (v[r][j].z + v[r][j].w);
#pragma unroll
        for (int o = 1; o < 64; o <<= 1) { s[0] += __shfl_xor(s[0], o); s[1] += __shfl_xor(s[1], o); }
        float q[2] = {0.f, 0.f};
#pragma unroll
        for (int r = 0; r < 2; ++r) { const float mean = s[r] * (1.f / DM);
#pragma unroll
            for (int j = 0; j < 8; ++j) { v[r][j] = v[r][j] - mean; q[r] += (v[r][j].x * v[r][j].x + v[r][j].y * v[r][j].y) + (v[r][j].z * v[r][j].z + v[r][j].w * v[r][j].w); } }
#pragma unroll
        for (int o = 1; o < 64; o <<= 1) { q[0] += __shfl_xor(q[0], o); q[1] += __shfl_xor(q[1], o); }
#pragma unroll
        for (int r = 0; r < 2; ++r) { const float rstd = 1.f / sqrtf(q[r] * (1.f / DM) + LN_EPS);
            if (FINAL) {
                f32x4* o = (f32x4*)(dstf + (size_t)(m + r) * DM) + 2 * lane;
#pragma unroll
                for (int j = 0; j < 4; ++j) { __builtin_nontemporal_store((v[r][2 * j] * rstd) * gg[2 * j] + bb[2 * j], &o[128 * j]); __builtin_nontemporal_store((v[r][2 * j + 1] * rstd) * gg[2 * j + 1] + bb[2 * j + 1], &o[128 * j + 1]); }
            } else {
                v4u* o = (v4u*)(dstb + (size_t)(m + r) * DM) + lane;
#pragma unroll
                for (int j = 0; j < 4; ++j) { const f32x4 y0 = (v[r][2 * j] * rstd) * gg[2 * j] + bb[2 * j], y1 = (v[r][2 * j + 1] * rstd) * gg[2 * j + 1] + bb[2 * j + 1];
                    v4u w; w.x = cvt_pk_bf16(y0.x, y0.y); w.y = cvt_pk_bf16(y0.z, y0.w); w.z = cvt_pk_bf16(y1.x, y1.y); w.w = cvt_pk_bf16(y1.z, y1.w); o[64 * j] = w; }
            } }
    }
}

constexpr int VT_PITCH = 784;
__device__ __forceinline__ void attn_head_scores(const LAS unsigned char* kbase, const bf16x8 (&qf)[4], int swz, int p0, float rel0f, float nslope2, float sink2, float pen0, float pen2, v4u (&pf)[9], float& inv) {
    f32x4 S[18];
#pragma unroll
    for (int j = 0; j < 18; ++j) {
        S[j] = (f32x4){0.f, 0.f, 0.f, 0.f};
#pragma unroll
        for (int ks = 0; ks < 4; ++ks) { const bf16x8 kf = *(const LAS bf16x8*)(kbase + (j >> 1) * 8192 + (j & 1) * 1024 + (((4 * ks) ^ swz) << 4));
            S[j] = __builtin_amdgcn_mfma_f32_16x16x32_bf16(kf, qf[ks], S[j], 0, 0, 0); }
        if (j & 1) __builtin_amdgcn_sched_barrier(0);
    }
    const float sc2 = 0.08838834764831845f * LOG2E;
    float mx = sink2;
    asm volatile("" : "+v"(rel0f));
#pragma unroll
    for (int t = 0; t < 9; ++t) { const int p = p0 + t; const float pen = p < 4 ? pen0 : (p >= 8 ? pen2 : 0.f);
#pragma unroll
        for (int e = 0; e < 2; ++e)
#pragma unroll
            for (int i = 0; i < 4; ++i) { const float relf = rel0f + (float)(32 * t + 4 * e + i);
                float sv = __builtin_fmaf(S[2 * t + e][i], sc2, __builtin_fmaf(__builtin_fabsf(relf), nslope2, pen));
                if (t == 0 || t == 8) sv = (__builtin_fabsf(relf) > 128.f) ? -1e30f : sv;
                S[2 * t + e][i] = sv; mx = fmaxf(mx, sv); } }
    mx = fmaxf(mx, __shfl_xor(mx, 16)); mx = fmaxf(mx, __shfl_xor(mx, 32));
    float sum = 0.f;
#pragma unroll
    for (int j = 0; j < 18; ++j)
#pragma unroll
        for (int i = 0; i < 4; ++i) { const float p = __builtin_amdgcn_exp2f(S[j][i] - mx); S[j][i] = p; sum += p; }
    sum += __shfl_xor(sum, 16); sum += __shfl_xor(sum, 32);
    inv = 1.0f / (sum + __builtin_amdgcn_exp2f(sink2 - mx));
#pragma unroll
    for (int t = 0; t < 9; ++t) { pf[t].x = cvt_pk_bf16(S[2 * t][0], S[2 * t][1]); pf[t].y = cvt_pk_bf16(S[2 * t][2], S[2 * t][3]);
        pf[t].z = cvt_pk_bf16(S[2 * t + 1][0], S[2 * t + 1][1]); pf[t].w = cvt_pk_bf16(S[2 * t + 1][2], S[2 * t + 1][3]); }
}
__device__ __forceinline__ void attn_head_pv(const LAS unsigned char* vbase, const v4u (&pf)[9], float inv, bf16* Og) {
#pragma unroll
    for (int dt = 0; dt < 8; ++dt) {
        f32x4 o = (f32x4){0.f, 0.f, 0.f, 0.f};
#pragma unroll
        for (int t = 0; t < 9; ++t) { const bf16x8 vf = *(const LAS bf16x8*)(vbase + 16 * dt * VT_PITCH + 64 * t);
            o = __builtin_amdgcn_mfma_f32_16x16x32_bf16(vf, __builtin_bit_cast(bf16x8, pf[t]), o, 0, 0, 0); }
        v2u w; w.x = cvt_pk_bf16(o[0] * inv, o[1] * inv); w.y = cvt_pk_bf16(o[2] * inv, o[3] * inv);
        *(v2u*)(Og + 16 * dt) = w;
        __builtin_amdgcn_sched_barrier(0);
    }
}
__device__ __forceinline__ void vt_write(LAS unsigned char* lds, const v4u (&in)[8], int dblk, int key0) {
#pragma unroll
    for (int i = 0; i < 8; ++i) { v4u o;
#pragma unroll
        for (int t = 0; t < 4; ++t) { const unsigned a = in[2 * t][i >> 1], b = in[2 * t + 1][i >> 1];
            o[t] = (i & 1) ? ((a >> 16) | (b & 0xffff0000u)) : ((a & 0xffffu) | (b << 16)); }
        *(LAS v4u*)(lds + (8 * dblk + i) * VT_PITCH + key0 * 2) = o; }
}
__device__ __forceinline__ void attn_unit(LAS unsigned char* lds, const bf16* H, bf16* MIX, const float* sink, int gc, int kv, int hp) {
    int tid_ = threadIdx.x; asm volatile("" : "+v"(tid_));
    const int tid = tid_, lane = tid & 63, wave = __builtin_amdgcn_readfirstlane(tid >> 6);
    const int c = gc & 15, fr = lane & 15, fq = lane >> 4, hA = 4 * kv + 2 * hp, hB = hA + 1;
    const int rowq0 = gc * 128, roww0 = rowq0 - 128;
    const bool v0 = (c != 0), v2 = (c != 15);
    const int p0 = wave >> 1;
    __syncthreads();
    {
        const bf16* Kg = H + COL_K + 128 * kv;
#pragma unroll
        for (int it = 0; it < 12; ++it) { const int ch = tid + it * NTHR, row = ch >> 4, cc = ch & 15, kb = row >> 7;
            const int grow = roww0 + row + ((kb == 0 && !v0) ? 128 : 0) - ((kb == 2 && !v2) ? 128 : 0);
            const v4u v = *(const v4u*)(Kg + (size_t)grow * NIN + cc * 8);
            const int g = (((row >> 3) & 3) << 2) | (row & 3);
            *(LAS v4u*)(lds + row * 256 + ((cc ^ g) << 4)) = v; }
    }
    bf16x8 qfA[4], qfB[4];
    { const bf16* Qg = H + (size_t)(rowq0 + 16 * wave + fr) * NIN + 128 * hA + 8 * fq;
#pragma unroll
      for (int ks = 0; ks < 4; ++ks) { qfA[ks] = *(const bf16x8*)(Qg + 32 * ks); qfB[ks] = *(const bf16x8*)(Qg + 128 + 32 * ks); } }
    const int r = tid & 255, sblk = r >> 4, dblk = r & 15;
    v4u vin0[8], vin1[8];
    { const bf16* Vg = H + COL_V + 128 * kv + 8 * dblk;
      const int kb = tid >> 8, key0 = 128 * kb + 8 * sblk, grow = roww0 + key0 + ((kb == 0 && !v0) ? 128 : 0);
#pragma unroll
      for (int jj = 0; jj < 8; ++jj) vin0[jj] = *(const v4u*)(Vg + (size_t)(grow + jj) * NIN);
      if (wave < 4) { const int grow2 = roww0 + 256 + 8 * sblk - (v2 ? 0 : 128);
#pragma unroll
          for (int jj = 0; jj < 8; ++jj) vin1[jj] = *(const v4u*)(Vg + (size_t)(grow2 + jj) * NIN); } }
    __syncthreads();
    const int qi = 16 * wave + fr;
    float rel0f = (float)(32 * p0 + 8 * fq - 128 - qi);
    asm volatile("" : "+v"(rel0f));
    const float pen0 = v0 ? 0.f : -1e30f, pen2 = v2 ? 0.f : -1e30f;
    const LAS unsigned char* kbase = lds + (32 * p0 + 8 * (fr >> 2) + (fr & 3)) * 256;
    const int swz = fq ^ fr;
    v4u pfA[9], pfB[9]; float invA, invB;
    attn_head_scores(kbase, qfA, swz, p0, rel0f, -__builtin_amdgcn_exp2f(-(float)(hA + 1)) * LOG2E, sink[hA] * LOG2E, pen0, pen2, pfA, invA);
    attn_head_scores(kbase, qfB, swz, p0, rel0f, -__builtin_amdgcn_exp2f(-(float)(hB + 1)) * LOG2E, sink[hB] * LOG2E, pen0, pen2, pfB, invB);
    __syncthreads();
    vt_write(lds, vin0, dblk, 128 * (tid >> 8) + 8 * sblk);
    if (wave < 4) vt_write(lds, vin1, dblk, 256 + 8 * sblk);
    __syncthreads();
    const LAS unsigned char* vbase = lds + fr * VT_PITCH + 64 * p0 + 16 * fq;
    bf16* Og = MIX + (size_t)(rowq0 + 16 * wave + fr) * DM + 128 * hA + 4 * fq;
    attn_head_pv(vbase, pfA, invA, Og);
    attn_head_pv(vbase, pfB, invB, Og + 128);
}

constexpr int GT_PITCH = 272, GT_BYTES = 128 * GT_PITCH;
__device__ __forceinline__ void sgu_pair(LAS unsigned char* lds, const bf16* H, bf16* MIX, const float* lng, const float* lnb, const bf16* wsb, const float* b_s, const float* gst, int gc, int gp) {
    int tid_ = threadIdx.x; asm volatile("" : "+v"(tid_));
    const int tid = tid_, lane = tid & 63, wave = __builtin_amdgcn_readfirstlane(tid >> 6);
    const int r0 = gc * 128, fr = lane & 15, fq = lane >> 4;
    __syncthreads();
    { const int gsel = tid >> 8, r = tid & 255, sblk = r >> 4, dblk = r & 15, g = 2 * gp + gsel, ch0 = 128 * g + 8 * dblk;
      const f32x4 ga = *(const f32x4*)(lng + ch0), gb = *(const f32x4*)(lng + ch0 + 4), ba = *(const f32x4*)(lnb + ch0), bb = *(const f32x4*)(lnb + ch0 + 4);
      const float gam[8] = {ga.x, ga.y, ga.z, ga.w, gb.x, gb.y, gb.z, gb.w}, bet[8] = {ba.x, ba.y, ba.z, ba.w, bb.x, bb.y, bb.z, bb.w};
      v4u in[8]; f32x2 st[8];
#pragma unroll
      for (int jj = 0; jj < 8; ++jj) { in[jj] = *(const v4u*)(H + (size_t)(r0 + 8 * sblk + jj) * NIN + COL_GV + ch0); st[jj] = *(const f32x2*)(gst + 2 * (size_t)(r0 + 8 * sblk + jj)); }
#pragma unroll
      for (int jj = 0; jj < 8; ++jj) { const float mean = st[jj].x * (1.f / 1024.f), var = fmaxf(st[jj].y * (1.f / 1024.f) - mean * mean, 0.f); st[jj].x = mean; st[jj].y = 1.f / sqrtf(var + LN_EPS); }
#pragma unroll
      for (int i = 0; i < 8; ++i) { v4u o;
#pragma unroll
          for (int t = 0; t < 4; ++t) { const unsigned a = in[2 * t][i >> 1], b = in[2 * t + 1][i >> 1];
              const float xa = (i & 1) ? bf_hi(a) : bf_lo(a), xb = (i & 1) ? bf_hi(b) : bf_lo(b);
              o[t] = cvt_pk_bf16((xa - st[2 * t].x) * st[2 * t].y * gam[i] + bet[i], (xb - st[2 * t + 1].x) * st[2 * t + 1].y * gam[i] + bet[i]); }
          *(LAS v4u*)(lds + gsel * GT_BYTES + (8 * dblk + i) * GT_PITCH + 16 * sblk) = o; } }
    const int gsel = wave >> 2, tq = wave & 3, g = 2 * gp + gsel;
    bf16x8 wf[2][4];
#pragma unroll
    for (int tt = 0; tt < 2; ++tt)
#pragma unroll
        for (int ks = 0; ks < 4; ++ks) wf[tt][ks] = *(const bf16x8*)(wsb + (size_t)(g * 128 + 32 * tq + 16 * tt + fr) * 128 + 32 * ks + 8 * fq);
    v2u uv[8][2];
#pragma unroll
    for (int dt = 0; dt < 8; ++dt)
#pragma unroll
        for (int tt = 0; tt < 2; ++tt) uv[dt][tt] = *(const v2u*)(H + (size_t)(r0 + 32 * tq + 16 * tt + fr) * NIN + COL_U + 128 * g + 16 * dt + 4 * fq);
    __syncthreads();
    const LAS unsigned char* Gb = lds + gsel * GT_BYTES + fr * GT_PITCH + 16 * fq;
    const float bias0 = b_s[g * 128 + 32 * tq + fr], bias1 = b_s[g * 128 + 32 * tq + 16 + fr];
#pragma unroll
    for (int dt = 0; dt < 8; ++dt) {
        f32x4 a0 = (f32x4){0.f, 0.f, 0.f, 0.f}, a1 = a0;
#pragma unroll
        for (int ks = 0; ks < 4; ++ks) { const bf16x8 gf = *(const LAS bf16x8*)(Gb + 16 * dt * GT_PITCH + 64 * ks);
            a0 = __builtin_amdgcn_mfma_f32_16x16x32_bf16(gf, wf[0][ks], a0, 0, 0, 0);
            a1 = __builtin_amdgcn_mfma_f32_16x16x32_bf16(gf, wf[1][ks], a1, 0, 0, 0); }
#pragma unroll
        for (int tt = 0; tt < 2; ++tt) { const int t = 32 * tq + 16 * tt + fr; const float bias = tt ? bias1 : bias0; const f32x4 a = tt ? a1 : a0;
            const v2u uu = uv[dt][tt];
            v2u w; w.x = cvt_pk_bf16(bf_lo(uu.x) * (a[0] + bias), bf_hi(uu.x) * (a[1] + bias)); w.y = cvt_pk_bf16(bf_lo(uu.y) * (a[2] + bias), bf_hi(uu.y) * (a[3] + bias));
            *(v2u*)(MIX + (size_t)(r0 + t) * DM + 1024 + 128 * g + 16 * dt + 4 * fq) = w; }
    }
}

#define XB_TMO      128
#define XB_XCNT(j)  (256  + 64 * (j))
#define XB_XSUB(j)  (1280 + 64 * (j))
#define XB_XGEN(j)  (2304 + 64 * (j))
#define XB_TOP      3328
#define XB_TOPGEN   3392
#define XCD_BAR_WORDS 3456
#define XB_SPIN_CAP (1u << 18)
__device__ __forceinline__ unsigned xb_ld(unsigned* p)              { return __hip_atomic_load(p, __ATOMIC_RELAXED, __HIP_MEMORY_SCOPE_AGENT); }
__device__ __forceinline__ unsigned xb_add(unsigned* p, unsigned v) { return __hip_atomic_fetch_add(p, v, __ATOMIC_RELAXED, __HIP_MEMORY_SCOPE_AGENT); }
__device__ __forceinline__ unsigned xb_xcc_id() { return (unsigned)__builtin_amdgcn_s_getreg((3 << 11) | 20) & 0xFu; }
#define XB_SPIN(cond, bar) do { unsigned _sp = 0; while (cond) { __builtin_amdgcn_s_sleep(1); \
    if ((++_sp & 255u) == 0u) { if (xb_ld(&(bar)[XB_TMO])) break; if (_sp > XB_SPIN_CAP) { atomicAdd(&(bar)[XB_TMO], 1u); break; } } } } while (0)
struct XcdBarrier { unsigned* bar; unsigned x; volatile LAS unsigned* st; };
__device__ __forceinline__ XcdBarrier xcd_barrier_post(unsigned* bar, volatile LAS unsigned* st) {
    XcdBarrier b; b.bar = bar; b.x = xb_xcc_id(); b.st = st;
    if (threadIdx.x == 0) (void)xb_add(&bar[XB_XCNT(b.x)], 1u);
    return b;
}
__device__ __forceinline__ void xcd_barrier_complete(unsigned* bar, unsigned x, unsigned& nloc, unsigned& nx) {
    const unsigned G = gridDim.x * gridDim.y * gridDim.z;
    unsigned sum, cnt, mine, sp = 0u;
    for (;;) {
        sum = 0u; cnt = 0u; mine = 0u;
#pragma unroll
        for (unsigned j = 0; j < 16; ++j) { const unsigned c = xb_ld(&bar[XB_XCNT(j)]); sum += c; cnt += (c > 0u) ? 1u : 0u; mine = (j == x) ? c : mine; }
        if (sum == G) break;
        __builtin_amdgcn_s_sleep(1);
        if ((++sp & 255u) == 0u) { if (xb_ld(&bar[XB_TMO])) break; if (sp > XB_SPIN_CAP) { atomicAdd(&bar[XB_TMO], 1u); break; } }
    }
    nloc = mine > 0u ? mine : 1u; nx = cnt > 0u ? cnt : 1u;
}
__device__ __forceinline__ void xcd_barrier(const XcdBarrier& b) {
    asm volatile("s_waitcnt vmcnt(0)" ::: "memory");
    __syncthreads();
    if (threadIdx.x == 0) {
        unsigned* bar = b.bar;
        __builtin_amdgcn_s_waitcnt(0);
        unsigned nloc = b.st[0], nx = b.st[1];
        if (nloc == 0u) { xcd_barrier_complete(bar, b.x, nloc, nx); b.st[0] = nloc; b.st[1] = nx; }
        const unsigned old = xb_add(&bar[XB_XSUB(b.x)], 1u);
        const unsigned gen = old / nloc;
        if (old + 1u == (gen + 1u) * nloc) {
            __builtin_amdgcn_fence(__ATOMIC_RELEASE, "agent");
            asm volatile("s_waitcnt vmcnt(0)" ::: "memory");
            const unsigned og = xb_add(&bar[XB_TOP], 1u);
            const unsigned tg = og / nx;
            if (og + 1u == (tg + 1u) * nx) xb_add(&bar[XB_TOPGEN], 1u);
            else XB_SPIN(xb_ld(&bar[XB_TOPGEN]) == tg, bar);
            __builtin_amdgcn_fence(__ATOMIC_ACQUIRE, "agent");
            xb_add(&bar[XB_XGEN(b.x)], 1u);
            asm volatile("s_waitcnt vmcnt(0)" ::: "memory");
        } else {
            XB_SPIN(xb_ld(&bar[XB_XGEN(b.x)]) == gen, bar);
            __builtin_amdgcn_fence(__ATOMIC_ACQUIRE, "agent");
            asm volatile("s_waitcnt vmcnt(0)" ::: "memory");
        }
    }
    __syncthreads();
}

#ifndef PH_MASK
#define PH_MASK 0xff
#endif
#ifndef DUP_MASK
#define DUP_MASK 0
#endif
#define GSYNC() xcd_barrier(xbar)
#define REP(k) for (int rep_ = 0; rep_ < (((DUP_MASK >> (k)) & 1) ? 2 : 1); ++rep_, (rep_ < (((DUP_MASK >> (k)) & 1) ? 2 : 1) ? GSYNC() : (void)0))
__global__ void __launch_bounds__(NTHR, 2) fwd_megakernel(Args args) {
    extern __shared__ __attribute__((aligned(16))) unsigned char lds_raw[];
    LAS unsigned char* lds = (LAS unsigned char*)lds_raw;
    const int tid = threadIdx.x, lane = tid & 63, wave = __builtin_amdgcn_readfirstlane(tid >> 6);
    const int G = gridDim.x, bx = blockIdx.x;
    const int vcu = (G % 8 == 0) ? (bx % 8) * (G / 8) + bx / 8 : bx;
    unsigned char* ws = args.ws;
    const float* xp = args.in[0]; const float* xs = args.in[1];
    const float* w_in = args.in[2]; const float* ln_sgu_g = args.in[3]; const float* ln_sgu_b = args.in[4]; const float* w_s = args.in[5]; const float* b_s = args.in[6];
    const float* sink = args.in[7]; const float* w_o = args.in[8]; const float* ln1_g = args.in[9]; const float* ln1_b = args.in[10];
    const float* w_gate = args.in[11]; const float* w_up = args.in[12]; const float* w_down = args.in[13]; const float* ln2_g = args.in[14]; const float* ln2_b = args.in[15];
    float* out = args.out;
    bf16* WIN_T = (bf16*)(ws + WS_WIN); bf16* WO_T = (bf16*)(ws + WS_WO); bf16* W13_T = (bf16*)(ws + WS_W13); bf16* W2_T = (bf16*)(ws + WS_W2);
    bf16* Y1B = (bf16*)out;
    bf16* Y2B = (bf16*)(ws + WS_XB);
    float* ST1 = (float*)(ws + WS_ST1); float* GST = (float*)(ws + WS_GST); bf16* WSB = (bf16*)(ws + WS_WSB);
    bf16* XB = (bf16*)(ws + WS_XB); bf16* Hb = (bf16*)(ws + WS_H); bf16* MIX = (bf16*)(ws + WS_MIX); bf16* HID = (bf16*)(ws + WS_HID);
    const int gw = vcu * NWAVES + wave, NGW = G * NWAVES;
    if (tid < 2) ((volatile LAS unsigned*)(lds + 131072 + 2048))[tid] = 0u;
    __syncthreads();
    const XcdBarrier xbar = xcd_barrier_post((unsigned*)(ws + WS_BAR), (volatile LAS unsigned*)(lds + 131072 + 2048));

    if constexpr ((PH_MASK & 1) != 0) {
        LAS float* scr = (LAS float*)(lds + wave * 16384);
        constexpr int I_IN = (DM / 64) * (NIN / 32);
        for (int it = gw; it < I_IN; it += NGW) { const int nb = it % (NIN / 32), kb = it / (NIN / 32); p0_transpose_item(w_in, DM, NIN, WIN_T, 32 * nb, 64 * kb, 32 * nb, scr, lane); }
        { const int gt = bx * NTHR + tid;
          if (gt < M * 2 / 4) ((f32x4*)GST)[gt] = (f32x4){0.f, 0.f, 0.f, 0.f};
          if (gt < 8 * 128 * 128 / 8) { const f32x4 a = *(const f32x4*)(w_s + 8 * gt), b = *(const f32x4*)(w_s + 8 * gt + 4);
              v4u w; w.x = cvt_pk_bf16(a.x, a.y); w.y = cvt_pk_bf16(a.z, a.w); w.z = cvt_pk_bf16(b.x, b.y); w.w = cvt_pk_bf16(b.z, b.w); *(v4u*)(WSB + 8 * gt) = w; } }
        const size_t n8 = (size_t)M * DM / 8, nthr = (size_t)G * NTHR;
        for (size_t i = (size_t)bx * NTHR + tid; i < n8; i += nthr) { const size_t e = i * 8;
            const float* src = (e < (size_t)MP * DM) ? xp + e : xs + (e - (size_t)MP * DM);
            const f32x4 a = __builtin_nontemporal_load((const f32x4*)src), b = __builtin_nontemporal_load((const f32x4*)(src + 4));
            v4u w; w.x = cvt_pk_bf16(a.x, a.y); w.y = cvt_pk_bf16(a.z, a.w); w.z = cvt_pk_bf16(b.x, b.y); w.w = cvt_pk_bf16(b.z, b.w);
            *(v4u*)(XB + e) = w; }
    }
    GSYNC();
    REP(1) if constexpr ((PH_MASK & 2) != 0) { pg8::Gemm g{XB, WIN_T, M, NIN, DM}; pg8::StaticOrder S; S.init(M, NIN, G, bx); EpiH E{Hb, GST};
      pg8::gemm_phase<EpiH, pg8::StaticOrder, true, true>(lds, g, S, E);
      const int nfull = (M / 256) * (NIN / 256) / G, nrem = (M / 256) * (NIN / 256) - nfull * G;
      if (bx >= nrem) {
          LAS float* scr = (LAS float*)(lds + wave * 16384);
          constexpr int I_O = (DM / 64) * (DM / 32), I_G = (DM / 64) * (DFF / 32);
          const int cw = (bx - nrem) * NWAVES + wave, NCW = (G - nrem) * NWAVES;
          for (int it = cw; it < I_O + 2 * I_G; it += NCW) {
              int r = it;
              if (r < I_O) { const int nb = r % (DM / 32), kb = r / (DM / 32); p0_transpose_item(w_o, DM, DM, WO_T, 32 * nb, 64 * kb, 32 * nb, scr, lane); continue; } r -= I_O;
              if (r < 2 * I_G) { const int up = r >= I_G ? 1 : 0; if (up) r -= I_G; const int nb = r % (DFF / 32), kb = r / (DFF / 32), n0 = 32 * nb;
                  p0_transpose_item(up ? w_up : w_gate, DM, DFF, W13_T, (n0 >> 7) * 256 + up * 128 + (n0 & 127), 64 * kb, n0, scr, lane); }
          }
      } }
    GSYNC();
    REP(2) if constexpr ((PH_MASK & 4) != 0) {
      for (int it = vcu; it < NGC * 8; it += G) {
#ifndef NO_ATTN
        if (it < NGC * 4) { attn_unit(lds, Hb, MIX, sink, it >> 2, (it >> 1) & 1, it & 1); if (DUP_MASK & 64) attn_unit(lds, Hb, MIX, sink, it >> 2, (it >> 1) & 1, it & 1); }
#endif
#ifndef NO_SGU
        if (it >= NGC * 4) { const int a = it - NGC * 4; sgu_pair(lds, Hb, MIX, ln_sgu_g, ln_sgu_b, WSB, b_s, GST, a >> 2, a & 3); if (DUP_MASK & 128) sgu_pair(lds, Hb, MIX, ln_sgu_g, ln_sgu_b, WSB, b_s, GST, a >> 2, a & 3); }
#endif
    } }
    GSYNC();
    REP(3) if constexpr ((PH_MASK & 8) != 0) { pg8::Gemm g{MIX, WO_T, M, DM, DM}; pg8::StaticOrder S; S.init(M, DM, G, bx); EpiY1 E{XB, Y1B};
      pg8::gemm_phase<EpiY1, pg8::StaticOrder, true, true>(lds, g, S, E); }
    GSYNC();
    REP(4) if constexpr ((PH_MASK & 16) != 0) ln_rows<false>(Y1B, nullptr, XB, ln1_g, ln1_b, gw, NGW, lane);
    GSYNC();
    REP(5) if constexpr ((PH_MASK & 32) != 0) { pg8::Gemm g{XB, W13_T, M, 2 * DFF, DM}; pg8::StaticOrder S; S.init(M, 2 * DFF, G, bx); EpiHid E{HID};
      pg8::gemm_phase<EpiHid, pg8::StaticOrder, true, true>(lds, g, S, E);
      const int units4 = (M / 256) * (2 * DFF / 256), nrem4 = units4 - (units4 / G) * G;
      if (bx >= nrem4) {
          LAS float* scr = (LAS float*)(lds + wave * 16384);
          constexpr int I_D = (DFF / 64) * (DM / 32);
          const int cw = (bx - nrem4) * NWAVES + wave, NCW = (G - nrem4) * NWAVES;
          for (int it = cw; it < I_D; it += NCW) { const int nb = it % (DM / 32), kb = it / (DM / 32); p0_transpose_item(w_down, DFF, DM, W2_T, 32 * nb, 64 * kb, 32 * nb, scr, lane); }
      } }
    GSYNC();
    if constexpr ((PH_MASK & 64) != 0) { pg8::Gemm g{HID, W2_T, M, DM, DFF}; pg8::StaticOrder S; S.init(M, DM, G, bx); EpiY2 E{XB};
      pg8::gemm_phase<EpiY2, pg8::StaticOrder, true, true>(lds, g, S, E); }
    GSYNC();
#ifdef SYNC_PROBE
    for (int i = 0; i < 16; ++i) GSYNC();
#endif
    if constexpr ((PH_MASK & 128) != 0) ln_rows<true>(Y2B, out, nullptr, ln2_g, ln2_b, gw, NGW, lane);
}

extern "C" void kernel_launch(void* const* d_in, const int* in_sizes, int n_in, void* d_out, int out_size, void* d_ws, size_t ws_size, hipStream_t stream) {
    static int grid = 0;
    if (grid == 0) {
        if (n_in != 16 || out_size != M * DM || ws_size < WS_END) { fprintf(stderr, "kernel_launch: unexpected shapes (n_in %d, out %d, ws %zu)\n", n_in, out_size, ws_size); grid = -1; return; }
        int dev = 0, cus = 0, per_cu = 0;
        hipGetDevice(&dev);
        hipDeviceGetAttribute(&cus, hipDeviceAttributeMultiprocessorCount, dev);
        if (hipFuncSetAttribute((const void*)fwd_megakernel, hipFuncAttributeMaxDynamicSharedMemorySize, LDS_BYTES) != hipSuccess) { fprintf(stderr, "kernel_launch: hipFuncSetAttribute failed\n"); grid = -1; return; }
        if (hipOccupancyMaxActiveBlocksPerMultiprocessor(&per_cu, (const void*)fwd_megakernel, NTHR, LDS_BYTES) != hipSuccess || per_cu < 1) { fprintf(stderr, "kernel_launch: occupancy query says %d workgroups per CU; nothing launched\n", per_cu); grid = -1; return; }
        grid = cus;
        fprintf(stderr, "kernel_launch: grid %d (cus %d, per_cu %d)\n", grid, cus, per_cu);
    }
    if (grid < 0) return;
    if (hipMemsetAsync((unsigned char*)d_ws + WS_BAR, 0, XCD_BAR_WORDS * 4, stream) != hipSuccess) { fprintf(stderr, "kernel_launch: hipMemsetAsync failed\n"); return; }
    Args a{};
    for (int i = 0; i < 16; ++i) a.in[i] = (const float*)d_in[i];
    a.out = (float*)d_out; a.ws = (unsigned char*)d_ws;
    void* kargs[] = {&a};
    hipError_t e = hipLaunchCooperativeKernel((const void*)fwd_megakernel, dim3(grid), dim3(NTHR), kargs, LDS_BYTES, stream);
    if (e != hipSuccess) fprintf(stderr, "kernel_launch: cooperative launch failed: %s (grid %d)\n", hipGetErrorString(e), grid);
}
```
